# Optimizing an MI355X kernel written in HIP

```python
import jax, jax.numpy as jnp
from jax import lax
import numpy as np

D_MODEL = 2048
BATCH = 2
SEQ = 8192
DEPTH = 4

N_MIXERS = 3
BLOCK = 128
EPS = 1e-6

FOX_HEADS = 16
FOX_HEAD_DIM = D_MODEL // FOX_HEADS
FOX_FORGET_BIAS = 2.0

SGU_WIDTH = D_MODEL
SGU_GROUPS = 16
SGU_GROUP_DIM = SGU_WIDTH // SGU_GROUPS
SGU_CHUNK = 128

SWA_HEAD_DIM = 64
SWA_Q_HEADS = D_MODEL // SWA_HEAD_DIM
SWA_KV_HEADS = 8
SWA_WINDOW = 128
ROPE_DIM = SWA_HEAD_DIM // 4
ROPE_THETA = 500000.0

D_FF = ((8 * D_MODEL + 3 * 256 - 1) // (3 * 256)) * 256

N_FOX = (DEPTH + 2) // 3
N_SGU = (DEPTH + 1) // 3
N_SWA = DEPTH // 3

kernel_name = "hybrid_fox_gmlp_swa_sink_adaln"

F32 = jnp.float32


def rmsnorm(x, g):
    xf = x.astype(F32)
    y = xf * lax.rsqrt(jnp.mean(xf * xf, axis=-1, keepdims=True) + EPS)
    return (y * g.astype(F32)).astype(x.dtype)


def layernorm(x, g, b):
    xf = x.astype(F32)
    mu = jnp.mean(xf, axis=-1, keepdims=True)
    var = jnp.mean(jnp.square(xf - mu), axis=-1, keepdims=True)
    y = (xf - mu) * lax.rsqrt(var + EPS)
    return (y * g.astype(F32) + b.astype(F32)).astype(x.dtype)


def modulate(h, shift, scale):
    return h * (1 + scale[:, None, :]) + shift[:, None, :]


def rope_tables(positions):
    inv = ROPE_THETA ** (-jnp.arange(0, ROPE_DIM, 2, dtype=F32) / ROPE_DIM)
    ang = positions.astype(F32)[..., None] * inv
    return jnp.cos(ang), jnp.sin(ang)


def apply_partial_rope(x, cos, sin):
    half = ROPE_DIM // 2
    x1 = x[..., :half]
    x2 = x[..., half:ROPE_DIM]
    rest = x[..., ROPE_DIM:]
    c = cos[:, :, None, :].astype(x.dtype)
    s = sin[:, :, None, :].astype(x.dtype)
    return jnp.concatenate([x1 * c - x2 * s, x2 * c + x1 * s, rest], axis=-1)


def fox_attention(h, w_in, b_f, w_out):
    B, S, _ = h.shape
    H, Dh = FOX_HEADS, FOX_HEAD_DIM
    proj = h @ w_in
    q, k, v, fg = jnp.split(proj, [H * Dh, 2 * H * Dh, 3 * H * Dh], axis=-1)
    q = q.reshape(B, S, H, Dh)
    k = k.reshape(B, S, H, Dh)
    v = v.reshape(B, S, H, Dh)
    log_f = jax.nn.log_sigmoid((fg + b_f).astype(F32))
    cum = lax.cumsum(log_f, axis=1)
    cum_t = cum.transpose(0, 2, 1)
    nb = S // BLOCK
    qb = q.reshape(B, nb, BLOCK, H, Dh).transpose(1, 0, 2, 3, 4)
    fq = cum.reshape(B, nb, BLOCK, H).transpose(1, 0, 3, 2)
    kpos = jnp.arange(S)
    scale = Dh ** -0.5

    def block_fn(args):
        i, q_i, f_i = args
        s = jnp.einsum('bqhd,bkhd->bhqk', q_i, k, preferred_element_type=F32) * scale
        s = s + f_i[..., None] - cum_t[:, :, None, :]
        qpos = i * BLOCK + jnp.arange(BLOCK)
        mask = kpos[None, :] <= qpos[:, None]
        s = jnp.where(mask, s, -jnp.inf)
        p = jax.nn.softmax(s, axis=-1)
        return jnp.einsum('bhqk,bkhd->bqhd', p.astype(v.dtype), v)

    out = lax.map(block_fn, (jnp.arange(nb), qb, fq))
    out = out.transpose(1, 0, 2, 3, 4).reshape(B, S, H * Dh)
    return out @ w_out


def gmlp_sgu(h, w_in, ln_g, ln_b, w_s, b_s, w_out):
    B, S, _ = h.shape
    z = jax.nn.gelu(h @ w_in)
    u, v = jnp.split(z, 2, axis=-1)
    v = layernorm(v, ln_g, ln_b)
    nc = S // SGU_CHUNK
    vg = v.reshape(B, nc, SGU_CHUNK, SGU_GROUPS, SGU_GROUP_DIM)
    causal = jnp.tril(jnp.ones((SGU_CHUNK, SGU_CHUNK), dtype=bool))
    ws = jnp.where(causal[None], w_s, jnp.zeros_like(w_s))
    f = jnp.einsum('gts,bcsgd->bctgd', ws, vg)
    f = f + b_s.T[None, None, :, :, None]
    gated = u * f.reshape(B, S, SGU_WIDTH)
    return gated @ w_out


def swa_sink_attention(h, w_in, sinks, w_out, cos, sin):
    B, S, _ = h.shape
    Hq, Hk, Dh = SWA_Q_HEADS, SWA_KV_HEADS, SWA_HEAD_DIM
    G = Hq // Hk
    proj = h @ w_in
    q, k, v = jnp.split(proj, [Hq * Dh, (Hq + Hk) * Dh], axis=-1)
    q = apply_partial_rope(q.reshape(B, S, Hq, Dh), cos, sin)
    k = apply_partial_rope(k.reshape(B, S, Hk, Dh), cos, sin)
    v = v.reshape(B, S, Hk, Dh)
    nb = S // BLOCK
    qb = q.reshape(B, nb, BLOCK, Hk, G, Dh)
    kb = k.reshape(B, nb, BLOCK, Hk, Dh)
    vb = v.reshape(B, nb, BLOCK, Hk, Dh)
    pad = ((0, 0), (1, 0), (0, 0), (0, 0), (0, 0))
    kband = jnp.concatenate([jnp.pad(kb[:, :-1], pad), kb], axis=2)
    vband = jnp.concatenate([jnp.pad(vb[:, :-1], pad), vb], axis=2)
    s = jnp.einsum('bnqhgd,bnkhd->bnhgqk', qb, kband, preferred_element_type=F32) * (Dh ** -0.5)
    qi = jnp.arange(BLOCK)[:, None]
    ki = jnp.arange(2 * BLOCK)[None, :] - BLOCK
    rel = qi - ki
    valid = (rel >= 0) & (rel < SWA_WINDOW)
    in_seq = (jnp.arange(nb)[:, None, None] * BLOCK + ki[None]) >= 0
    mask = valid[None] & in_seq
    s = jnp.where(mask[None, :, None, None], s, -jnp.inf)
    sink = sinks.astype(F32).reshape(Hk, G)[None, None, :, :, None, None]
    m = jnp.maximum(jnp.max(s, axis=-1, keepdims=True), sink)
    p = jnp.exp(s - m)
    p = p / (jnp.sum(p, axis=-1, keepdims=True) + jnp.exp(sink - m))
    o = jnp.einsum('bnhgqk,bnkhd->bnqhgd', p.astype(v.dtype), vband)
    return o.reshape(B, S, Hq * Dh) @ w_out


def swiglu(h, w_gu, w_down):
    g, u = jnp.split(h @ w_gu, 2, axis=-1)
    return (jax.nn.silu(g) * u) @ w_down


def setup_inputs(seed: int = 0) -> dict:
    key = jax.random.key(seed)
    ks = jax.random.split(key, 32)
    D = D_MODEL
    nrm = lambda k, shape, fan_in, mult=1.0: jax.random.normal(k, shape, F32) * (mult * fan_in ** -0.5)
    fox_in = 3 * FOX_HEADS * FOX_HEAD_DIM + FOX_HEADS
    swa_in = (SWA_Q_HEADS + 2 * SWA_KV_HEADS) * SWA_HEAD_DIM
    x = jax.random.normal(ks[0], (BATCH, SEQ, D), F32)
    c = jax.random.normal(ks[1], (BATCH, D), F32)
    offset = jax.random.randint(ks[2], (BATCH, 1), 0, 4096, dtype=jnp.int32)
    positions = offset + jnp.arange(SEQ, dtype=jnp.int32)[None, :]
    gain = lambda k, shape: 1.0 + 0.02 * jax.random.normal(k, shape, F32)
    return {
        "x": x,
        "c": c,
        "positions": positions,
        "ada_w": nrm(ks[3], (DEPTH, D, 6 * D), D, 0.5),
        "ada_b": 0.01 * jax.random.normal(ks[4], (DEPTH, 6 * D), F32),
        "mix_pre_g": gain(ks[5], (DEPTH, D)),
        "mix_post_g": gain(ks[6], (DEPTH, D)),
        "ffn_pre_g": gain(ks[7], (DEPTH, D)),
        "ffn_post_g": gain(ks[8], (DEPTH, D)),
        "ffn_w_gu": nrm(ks[9], (DEPTH, D, 2 * D_FF), D),
        "ffn_w_down": nrm(ks[10], (DEPTH, D_FF, D), D_FF),
        "fox_w_in": nrm(ks[11], (N_FOX, D, fox_in), D),
        "fox_b_f": FOX_FORGET_BIAS + 0.5 * jax.random.normal(ks[12], (N_FOX, FOX_HEADS), F32),
        "fox_w_out": nrm(ks[13], (N_FOX, FOX_HEADS * FOX_HEAD_DIM, D), FOX_HEADS * FOX_HEAD_DIM),
        "sgu_w_in": nrm(ks[14], (N_SGU, D, 2 * SGU_WIDTH), D),
        "sgu_ln_g": gain(ks[15], (N_SGU, SGU_WIDTH)),
        "sgu_ln_b": 0.01 * jax.random.normal(ks[16], (N_SGU, SGU_WIDTH), F32),
        "sgu_w_s": nrm(ks[17], (N_SGU, SGU_GROUPS, SGU_CHUNK, SGU_CHUNK), SGU_CHUNK),
        "sgu_b_s": 1.0 + 0.02 * jax.random.normal(ks[18], (N_SGU, SGU_GROUPS, SGU_CHUNK), F32),
        "sgu_w_out": nrm(ks[19], (N_SGU, SGU_WIDTH, D), SGU_WIDTH),
        "swa_w_in": nrm(ks[20], (N_SWA, D, swa_in), D),
        "swa_sinks": 0.5 * jax.random.normal(ks[21], (N_SWA, SWA_Q_HEADS), F32),
        "swa_w_out": nrm(ks[22], (N_SWA, SWA_Q_HEADS * SWA_HEAD_DIM, D), SWA_Q_HEADS * SWA_HEAD_DIM),
    }


def reference(x, c, positions, ada_w, ada_b, mix_pre_g, mix_post_g, ffn_pre_g, ffn_post_g,
              ffn_w_gu, ffn_w_down, fox_w_in, fox_b_f, fox_w_out, sgu_w_in, sgu_ln_g,
              sgu_ln_b, sgu_w_s, sgu_b_s, sgu_w_out, swa_w_in, swa_sinks, swa_w_out):
    cos, sin = rope_tables(positions)
    c_act = jax.nn.silu(c)
    for i in range(DEPTH):
        mod = c_act @ ada_w[i] + ada_b[i]
        sh_m, sc_m, g_m, sh_f, sc_f, g_f = jnp.split(mod, 6, axis=-1)
        h = modulate(rmsnorm(x, mix_pre_g[i]), sh_m, sc_m)
        kind, j = i % N_MIXERS, i // N_MIXERS
        if kind == 0:
            y = fox_attention(h, fox_w_in[j], fox_b_f[j], fox_w_out[j])
        elif kind == 1:
            y = gmlp_sgu(h, sgu_w_in[j], sgu_ln_g[j], sgu_ln_b[j], sgu_w_s[j], sgu_b_s[j], sgu_w_out[j])
        else:
            y = swa_sink_attention(h, swa_w_in[j], swa_sinks[j], swa_w_out[j], cos, sin)
        x = x + g_m[:, None, :] * rmsnorm(y, mix_post_g[i])
        h = modulate(rmsnorm(x, ffn_pre_g[i]), sh_f, sc_f)
        y = swiglu(h, ffn_w_gu[i], ffn_w_down[i])
        x = x + g_f[:, None, :] * rmsnorm(y, ffn_post_g[i])
    return x
```

```cpp
#include <hip/hip_runtime.h>
#include <cstdio>
#include <cstdint>
#include <cmath>

#ifndef DBG
#define DBG 0
#endif

namespace pg8 {
#define PG8_LAS __attribute__((address_space(3)))
typedef unsigned short bf16_t;
typedef short bf16x8 __attribute__((ext_vector_type(8)));
typedef float f32x4 __attribute__((ext_vector_type(4)));
typedef unsigned u32x4 __attribute__((ext_vector_type(4)));
constexpr int BM = 256, BK = 64, HALF = 128, HTB = HALF * BK * 2  , STAGE_BYTES = 8 * HTB, NXCD = 8, WGM = 8;

__host__ __device__ __forceinline__ int lds_byte(int r, int c) { const int st = (r >> 4) * 2 + (c >> 5), rr = r & 15, cc = c & 31, ob = rr * 64 + cc * 2; return st * 1024 + (ob ^ (((ob >> 9) & 1) << 5)); }
__host__ __device__ __forceinline__ void stage_rc(int b, int& R, int& C) { const int st = b / 1024, sb = b % 1024, swz = sb ^ (((sb >> 9) & 1) << 5); R = (st >> 1) * 16 + swz / 64; C = (st & 1) * 32 + (swz % 64) / 2; }
__host__ __device__ __forceinline__ int perm32(int rho) { const int n = rho >> 4, i = rho & 15; return 8 * (i >> 2) + 4 * n + (i & 3); }

struct Unit { int pm, pn; };
struct Gemm { const bf16_t* A; const bf16_t* Bt; int M, N, K; };

struct StaticOrder {
    int nM, nN, nwg, G, c;
    __host__ __device__ void init(int M, int N, int G_, int c_) { nM = M / BM; nN = N / BM; nwg = nM * nN; G = G_; c = c_; }
    __host__ __device__ bool next(int i, Unit& u) const {
        const long L = (long)i * G + c; if (L >= nwg) return false;
        int wgid = (int)L; { const int q = nwg / NXCD, r = nwg % NXCD, xcd = wgid % NXCD, off = wgid / NXCD; wgid = (xcd < r ? xcd * (q + 1) : r * (q + 1) + (xcd - r) * q) + off; }
        const int nig = WGM * nN, gid = wgid / nig, fm = gid * WGM, gsz = (nM - fm) < WGM ? (nM - fm) : WGM;
        u.pm = fm + ((wgid % nig) % gsz); u.pn = (wgid % nig) / gsz; return true;
    }
    __device__ __forceinline__ void a_ready(const Unit&) const {}
    __device__ __forceinline__ void done(const Unit&) const {}
};

__device__ __forceinline__ unsigned cvt_pk_bf16(float lo, float hi) { unsigned r; asm volatile("v_cvt_pk_bf16_f32 %0, %1, %2" : "=v"(r) : "v"(lo), "v"(hi)); return r; }
typedef float f32x2 __attribute__((ext_vector_type(2)));
typedef unsigned u32x2 __attribute__((ext_vector_type(2)));
__device__ __forceinline__ float fast_sigmoid(float x) { return __builtin_amdgcn_rcpf(1.0f + __builtin_amdgcn_exp2f(-1.4426950408889634f * x)); }
struct EpiProj {
    static constexpr bool PERM = true, AFTER_DRAIN = false;
    bf16_t* O; int ldc; int qcols; float qscale;
    __device__ __forceinline__ void operator()(const f32x4 (&acc)[2][2][4][2], const Unit& u, int wr, int wc, int fr, int fq) const {
        const int row0 = u.pm * BM + wr * 64 + fr, colt = u.pn * BM, col0 = colt + wc * 32 + 8 * fq;
        const float sc = colt < qcols ? qscale : 1.0f;
#pragma unroll
        for (int ai = 0; ai < 2; ++ai)
#pragma unroll
            for (int m = 0; m < 4; ++m) { bf16_t* rowp = O + (size_t)(row0 + ai * HALF + m * 16) * ldc + col0;
#pragma unroll
                for (int bj = 0; bj < 2; ++bj) { const f32x4 v0 = acc[ai][bj][m][0] * sc, v1 = acc[ai][bj][m][1] * sc;
                    u32x4 w; w.x = cvt_pk_bf16(v0[0], v0[1]); w.y = cvt_pk_bf16(v0[2], v0[3]); w.z = cvt_pk_bf16(v1[0], v1[1]); w.w = cvt_pk_bf16(v1[2], v1[3]);
                    *(u32x4*)(rowp + bj * HALF) = w; } }
    }
};
struct EpiSwiglu {
    static constexpr bool PERM = true, AFTER_DRAIN = false;
    bf16_t* Z; int ldz;
    __device__ __forceinline__ void operator()(const f32x4 (&acc)[2][2][4][2], const Unit& u, int wr, int wc, int fr, int fq) const {
        const int row0 = u.pm * BM + wr * 64 + fr, col0 = u.pn * HALF + wc * 32 + 8 * fq;
#pragma unroll
        for (int ai = 0; ai < 2; ++ai)
#pragma unroll
            for (int m = 0; m < 4; ++m) { bf16_t* rowp = Z + (size_t)(row0 + ai * HALF + m * 16) * ldz + col0;
                f32x4 z0, z1;
#pragma unroll
                for (int i = 0; i < 4; ++i) { const float g0 = acc[ai][0][m][0][i], g1 = acc[ai][0][m][1][i];
                    z0[i] = g0 * fast_sigmoid(g0) * acc[ai][1][m][0][i]; z1[i] = g1 * fast_sigmoid(g1) * acc[ai][1][m][1][i]; }
                u32x4 w; w.x = cvt_pk_bf16(z0[0], z0[1]); w.y = cvt_pk_bf16(z0[2], z0[3]); w.z = cvt_pk_bf16(z1[0], z1[1]); w.w = cvt_pk_bf16(z1[2], z1[3]);
                *(u32x4*)rowp = w; }
    }
};
struct EpiOut {
    static constexpr bool PERM = true, AFTER_DRAIN = false;
    bf16_t* Y; int ldc; float* stat;
    __device__ __forceinline__ void operator()(const f32x4 (&acc)[2][2][4][2], const Unit& u, int wr, int wc, int fr, int fq) const {
        const int row0 = u.pm * BM + wr * 64 + fr, col0 = u.pn * BM + wc * 32 + 8 * fq;
#pragma unroll
        for (int ai = 0; ai < 2; ++ai)
#pragma unroll
            for (int m = 0; m < 4; ++m) { const int row = row0 + ai * HALF + m * 16; bf16_t* rowp = Y + (size_t)row * ldc + col0; float q = 0.f;
#pragma unroll
                for (int bj = 0; bj < 2; ++bj) { const f32x4 v0 = acc[ai][bj][m][0], v1 = acc[ai][bj][m][1];
                    q += (v0[0] * v0[0] + v0[1] * v0[1]) + (v0[2] * v0[2] + v0[3] * v0[3]) + (v1[0] * v1[0] + v1[1] * v1[1]) + (v1[2] * v1[2] + v1[3] * v1[3]);
                    u32x4 w; w.x = cvt_pk_bf16(v0[0], v0[1]); w.y = cvt_pk_bf16(v0[2], v0[3]); w.z = cvt_pk_bf16(v1[0], v1[1]); w.w = cvt_pk_bf16(v1[2], v1[3]);
                    *(u32x4*)(rowp + bj * HALF) = w; }
                q += __shfl_xor(q, 16); q += __shfl_xor(q, 32);
                if (fq == 0) stat[(size_t)row * 32 + 4 * u.pn + wc] = q; }
    }
};
__device__ __forceinline__ float gelu_tanh_f(float x) { const float t = 1.5957691216057308f * (x + 0.044715f * x * x * x); return x * fast_sigmoid(t); }
struct EpiSguIn {
    static constexpr bool PERM = true, AFTER_DRAIN = false;
    bf16_t* O; int ldc; float* stat2;
    __device__ __forceinline__ void operator()(const f32x4 (&acc)[2][2][4][2], const Unit& u, int wr, int wc, int fr, int fq) const {
        const int row0 = u.pm * BM + wr * 64 + fr, col0 = u.pn * BM + wc * 32 + 8 * fq; const bool vhalf = u.pn >= 8;
#pragma unroll
        for (int ai = 0; ai < 2; ++ai)
#pragma unroll
            for (int m = 0; m < 4; ++m) { const int row = row0 + ai * HALF + m * 16; bf16_t* rowp = O + (size_t)row * ldc + col0; float s = 0.f, q = 0.f;
#pragma unroll
                for (int bj = 0; bj < 2; ++bj) { f32x4 v0, v1;
#pragma unroll
                    for (int i = 0; i < 4; ++i) { v0[i] = gelu_tanh_f(acc[ai][bj][m][0][i]); v1[i] = gelu_tanh_f(acc[ai][bj][m][1][i]); }
                    s += (v0[0] + v0[1]) + (v0[2] + v0[3]) + (v1[0] + v1[1]) + (v1[2] + v1[3]);
                    q += (v0[0] * v0[0] + v0[1] * v0[1]) + (v0[2] * v0[2] + v0[3] * v0[3]) + (v1[0] * v1[0] + v1[1] * v1[1]) + (v1[2] * v1[2] + v1[3] * v1[3]);
                    u32x4 w; w.x = cvt_pk_bf16(v0[0], v0[1]); w.y = cvt_pk_bf16(v0[2], v0[3]); w.z = cvt_pk_bf16(v1[0], v1[1]); w.w = cvt_pk_bf16(v1[2], v1[3]);
                    *(u32x4*)(rowp + bj * HALF) = w; }
                if (vhalf) { s += __shfl_xor(s, 16); s += __shfl_xor(s, 32); q += __shfl_xor(q, 16); q += __shfl_xor(q, 32);
                    if (fq == 0) { float* sp = stat2 + ((size_t)row * 32 + 4 * (u.pn - 8) + wc) * 2; sp[0] = s; sp[1] = q; } } }
    }
};
template <class Epi, class Sched, bool ALIGN_EPI = false, bool SP2 = false>
__device__ __forceinline__ void gemm_phase(PG8_LAS unsigned char* lds, const Gemm g, const Sched& S, const Epi& E) {
    int tid_ = threadIdx.x; asm volatile("" : "+v"(tid_));
    const int tid = tid_, wid = __builtin_amdgcn_readfirstlane(tid >> 6), lane = tid & 63, wr = wid >> 2, wc = wid & 3, fr = lane & 15, fq = lane >> 4;
    const int K = g.K, nt = K / BK;
    unsigned voffA[2], voffB[2];
#pragma unroll
    for (int i = 0; i < 2; ++i) { int R, C; stage_rc(tid * 16 + i * 8192, R, C); const int Rb = Epi::PERM ? ((R & ~31) + perm32(R & 31)) : R;
        voffA[i] = (unsigned)(R * K + C) * 2u; voffB[i] = (unsigned)(Rb * K + C) * 2u; }
    const size_t kstep = (size_t)(BK * 2);
    const size_t hstep = (size_t)HALF * K * 2;
    const size_t tstep = 2 * hstep;
    const unsigned ldsw = (unsigned)wid * 1024u;
    const int aoff = lds_byte(wr * 64 + fr, fq * 8), boff = lds_byte(wc * 32 + fr, fq * 8);
#define PG8_SA(b, h) (((b) * 2 + (h)) * HTB)
#define PG8_SB(b, h) ((4 + (b) * 2 + (h)) * HTB)
#define PG8_STAGE(bufoff, gbase, voff) do { _Pragma("unroll") for (int _i = 0; _i < 2; ++_i) \
        __builtin_amdgcn_global_load_lds((const unsigned*)((const char*)(gbase) + (voff)[_i]), (PG8_LAS unsigned*)(lds + (bufoff) + ldsw + _i * 8192), 16, 0, 0); } while (0)
#define PG8_LDA(dst, b, h) do { _Pragma("unroll") for (int m = 0; m < 4; ++m) _Pragma("unroll") for (int k = 0; k < 2; ++k) dst[m][k] = *(const PG8_LAS bf16x8*)(lds + PG8_SA(b, h) + aoff + m * 2048 + k * 1024); } while (0)
#define PG8_LDB(dst, b, h) do { _Pragma("unroll") for (int n = 0; n < 2; ++n) _Pragma("unroll") for (int k = 0; k < 2; ++k) dst[n][k] = *(const PG8_LAS bf16x8*)(lds + PG8_SB(b, h) + boff + n * 2048 + k * 1024); } while (0)
#define PG8_MMA(ai, bj, At, Bt) do { __builtin_amdgcn_s_setprio(1); _Pragma("unroll") for (int m = 0; m < 4; ++m) _Pragma("unroll") for (int n = 0; n < 2; ++n) _Pragma("unroll") for (int k = 0; k < 2; ++k) \
        acc[ai][bj][m][n] = __builtin_amdgcn_mfma_f32_16x16x32_bf16(Bt[n][k], At[m][k], acc[ai][bj][m][n], 0, 0, 0); __builtin_amdgcn_s_setprio(0); } while (0)
#define PG8_WAIT_V(n) asm volatile("s_waitcnt vmcnt(" #n ")" ::: "memory")
#define PG8_WAIT_L(n) asm volatile("s_waitcnt lgkmcnt(" #n ")" ::: "memory")
#define PG8_BAR __builtin_amdgcn_s_barrier()
#define PG8_SCHED __builtin_amdgcn_sched_barrier(0)
    Unit cur, nxt; int ui = 0;
    if (!S.next(0, cur)) return;
    f32x4 acc[2][2][4][2];
#pragma unroll
    for (int a = 0; a < 2; ++a)
#pragma unroll
        for (int b = 0; b < 2; ++b)
#pragma unroll
            for (int m = 0; m < 4; ++m)
#pragma unroll
                for (int n = 0; n < 2; ++n) acc[a][b][m][n] = (f32x4){0.f, 0.f, 0.f, 0.f};
    bf16x8 At[4][2], B0[2][2], B1[2][2];
    const char* cA = (const char*)g.A + (size_t)cur.pm * tstep; const char* cB = (const char*)g.Bt + (size_t)cur.pn * tstep;
    S.a_ready(cur);
    if constexpr (SP2) {
        PG8_STAGE(PG8_SB(0, 0), cB, voffB); PG8_STAGE(PG8_SB(0, 1), cB + hstep, voffB); PG8_STAGE(PG8_SA(0, 0), cA, voffA); PG8_STAGE(PG8_SA(0, 1), cA + hstep, voffA);
        if (wr == 1) PG8_BAR;
        PG8_WAIT_V(2); PG8_BAR;
        PG8_STAGE(PG8_SB(1, 0), cB + kstep, voffB); PG8_STAGE(PG8_SA(1, 0), cA + kstep, voffA); PG8_STAGE(PG8_SB(1, 1), cB + hstep + kstep, voffB);
        PG8_WAIT_V(6); PG8_BAR;
    } else {
        PG8_STAGE(PG8_SB(0, 0), cB, voffB); PG8_STAGE(PG8_SA(0, 0), cA, voffA); PG8_STAGE(PG8_SB(0, 1), cB + hstep, voffB); PG8_STAGE(PG8_SA(0, 1), cA + hstep, voffA);
        if (wr == 1) PG8_BAR;
        PG8_WAIT_V(4); PG8_BAR;
        PG8_STAGE(PG8_SB(1, 0), cB + kstep, voffB); PG8_STAGE(PG8_SA(1, 0), cA + kstep, voffA); PG8_STAGE(PG8_SB(1, 1), cB + hstep + kstep, voffB);
        PG8_WAIT_V(6); PG8_BAR;
    }
    for (;;) {
        const bool has_next = S.next(ui + 1, nxt);
        const char* nA = has_next ? (const char*)g.A + (size_t)nxt.pm * tstep : cA; const char* nB = has_next ? (const char*)g.Bt + (size_t)nxt.pn * tstep : cB;
        for (int t = 0; t < nt; t += 2) {
            const bool last = (t == nt - 2);
            const char* a1 = cA + (size_t)(t + 1) * kstep;
            const char* a2 = last ? nA : cA + (size_t)(t + 2) * kstep; const char* b2 = last ? nB : cB + (size_t)(t + 2) * kstep;
            const char* a3 = a2 + kstep; const char* b3 = b2 + kstep;
            if (last && has_next) S.a_ready(nxt);
            if constexpr (SP2) {
            PG8_LDB(B0, 0, 0); PG8_LDB(B1, 0, 1); PG8_SCHED; PG8_LDA(At, 0, 0); PG8_STAGE(PG8_SA(1, 1), a1 + hstep, voffA);
            PG8_WAIT_V(8); PG8_WAIT_L(0); PG8_BAR; PG8_MMA(0, 0, At, B0); PG8_MMA(0, 1, At, B1); PG8_BAR; PG8_SCHED;
            PG8_LDA(At, 0, 1); PG8_STAGE(PG8_SB(0, 0), b2, voffB); PG8_STAGE(PG8_SB(0, 1), b2 + hstep, voffB); PG8_STAGE(PG8_SA(0, 0), a2, voffA);
            PG8_WAIT_V(8); PG8_WAIT_L(0); PG8_BAR; PG8_MMA(1, 0, At, B0); PG8_MMA(1, 1, At, B1); PG8_BAR; PG8_SCHED;
            PG8_LDB(B0, 1, 0); PG8_LDB(B1, 1, 1); PG8_SCHED; PG8_LDA(At, 1, 0); PG8_STAGE(PG8_SA(0, 1), a2 + hstep, voffA);
            PG8_WAIT_V(8); PG8_WAIT_L(0); PG8_BAR; PG8_MMA(0, 0, At, B0); PG8_MMA(0, 1, At, B1); PG8_BAR; PG8_SCHED;
            PG8_LDA(At, 1, 1); PG8_STAGE(PG8_SB(1, 0), b3, voffB); PG8_STAGE(PG8_SB(1, 1), b3 + hstep, voffB); PG8_STAGE(PG8_SA(1, 0), a3, voffA);
            PG8_WAIT_V(8); PG8_WAIT_L(0); PG8_BAR; PG8_MMA(1, 0, At, B0); PG8_MMA(1, 1, At, B1); PG8_BAR; PG8_SCHED;
            } else {
            PG8_LDB(B0, 0, 0); PG8_SCHED; PG8_LDA(At, 0, 0); PG8_STAGE(PG8_SA(1, 1), a1 + hstep, voffA);
            PG8_WAIT_L(8); PG8_BAR; PG8_WAIT_L(0); PG8_MMA(0, 0, At, B0); PG8_BAR; PG8_SCHED;
            PG8_LDB(B1, 0, 1); PG8_STAGE(PG8_SB(0, 0), b2, voffB);
            PG8_BAR; PG8_WAIT_L(0); PG8_MMA(0, 1, At, B1); PG8_BAR;
            PG8_LDA(At, 0, 1); PG8_STAGE(PG8_SA(0, 0), a2, voffA);
            PG8_BAR; PG8_WAIT_L(0); PG8_MMA(1, 0, At, B0); PG8_BAR; PG8_SCHED;
            PG8_STAGE(PG8_SB(0, 1), b2 + hstep, voffB);
            PG8_WAIT_V(6); PG8_BAR; PG8_MMA(1, 1, At, B1); PG8_BAR;
            PG8_LDB(B0, 1, 0); PG8_SCHED; PG8_LDA(At, 1, 0); PG8_STAGE(PG8_SA(0, 1), a2 + hstep, voffA);
            PG8_WAIT_L(8); PG8_BAR; PG8_WAIT_L(0); PG8_MMA(0, 0, At, B0); PG8_BAR; PG8_SCHED;
            PG8_LDB(B1, 1, 1); PG8_STAGE(PG8_SB(1, 0), b3, voffB);
            PG8_BAR; PG8_WAIT_L(0); PG8_MMA(0, 1, At, B1); PG8_BAR;
            PG8_LDA(At, 1, 1); PG8_STAGE(PG8_SA(1, 0), a3, voffA);
            PG8_BAR; PG8_WAIT_L(0); PG8_MMA(1, 0, At, B0); PG8_BAR; PG8_SCHED;
            PG8_STAGE(PG8_SB(1, 1), b3 + hstep, voffB);
            PG8_WAIT_V(6); PG8_BAR; PG8_MMA(1, 1, At, B1); PG8_BAR;
            }
        }
        if constexpr (ALIGN_EPI) { if (wr == 0) PG8_BAR; }
        if constexpr (!Epi::AFTER_DRAIN) { E(acc, cur, wr, wc, fr, fq); S.done(cur); }
        if (!has_next) break;
#pragma unroll
        for (int a = 0; a < 2; ++a)
#pragma unroll
            for (int b = 0; b < 2; ++b)
#pragma unroll
                for (int m = 0; m < 4; ++m)
#pragma unroll
                    for (int n = 0; n < 2; ++n) acc[a][b][m][n] = (f32x4){0.f, 0.f, 0.f, 0.f};
        cur = nxt; cA = nA; cB = nB; ++ui;
        if constexpr (ALIGN_EPI) { if (wr == 1) PG8_BAR; }
    }
    PG8_WAIT_V(0);
    if constexpr (!ALIGN_EPI) { if (wr == 0) PG8_BAR; }
    PG8_BAR;
    if constexpr (Epi::AFTER_DRAIN) { E.fused(acc, cur, wr, wc, fr, fq, lds, wid, lane); S.done(cur); }
#undef PG8_SA
#undef PG8_SB
#undef PG8_STAGE
#undef PG8_LDA
#undef PG8_LDB
#undef PG8_MMA
#undef PG8_WAIT_V
#undef PG8_WAIT_L
#undef PG8_BAR
#undef PG8_SCHED
}
}
#define GAS __attribute__((address_space(1)))
#define LAS __attribute__((address_space(3)))
typedef unsigned short bf16;
typedef unsigned v4u __attribute__((ext_vector_type(4)));
typedef float f32x4 __attribute__((ext_vector_type(4)));
typedef short bf16x8 __attribute__((ext_vector_type(8)));
typedef GAS unsigned gu32;
typedef GAS unsigned long long gu64;
#define RLX_AGENT __ATOMIC_RELAXED, __HIP_MEMORY_SCOPE_AGENT
#define LDS_WAIT() asm volatile("s_waitcnt lgkmcnt(0)" ::: "memory")
#define VM_WAIT() asm volatile("s_waitcnt vmcnt(0)" ::: "memory")
__device__ __forceinline__ unsigned long long rt() { return __builtin_amdgcn_s_memrealtime(); }
__device__ __forceinline__ unsigned f2bf(float f) { unsigned u = __builtin_bit_cast(unsigned, f); return (u + 0x7fffu + ((u >> 16) & 1u)) >> 16; }
__device__ __forceinline__ unsigned pk2(float lo, float hi) { return f2bf(lo) | (f2bf(hi) << 16); }
#define XB_TMO      128
#define XB_XCNT(j)  (256  + 64 * (j))
#define XB_XSUB(j)  (1280 + 64 * (j))
#define XB_XGEN(j)  (2304 + 64 * (j))
#define XB_TOP      3328
#define XB_TOPGEN   3392
#define XCD_BAR_WORDS 3456
#define XB_SPIN_CAP (1u << 18)

__device__ __forceinline__ unsigned xb_ld(unsigned* p)              { return __hip_atomic_load(p, __ATOMIC_RELAXED, __HIP_MEMORY_SCOPE_AGENT); }
__device__ __forceinline__ unsigned xb_add(unsigned* p, unsigned v) { return __hip_atomic_fetch_add(p, v, __ATOMIC_RELAXED, __HIP_MEMORY_SCOPE_AGENT); }
__device__ __forceinline__ unsigned xb_xcc_id() { return (unsigned)__builtin_amdgcn_s_getreg((3 << 11) | 20) & 0xFu; }
#define XB_SPIN(cond, bar) do { unsigned _sp = 0; while (cond) { __builtin_amdgcn_s_sleep(1); \
    if ((++_sp & 255u) == 0u) { if (xb_ld(&(bar)[XB_TMO])) break; if (_sp > XB_SPIN_CAP) { atomicAdd(&(bar)[XB_TMO], 1u); break; } } } } while (0)

struct XcdBarrier {
    unsigned* bar; unsigned x;
    volatile LAS unsigned* st;
};

__device__ __forceinline__ XcdBarrier xcd_barrier_post(unsigned* bar, volatile LAS unsigned* st) {
    XcdBarrier b; b.bar = bar; b.x = xb_xcc_id(); b.st = st;
    if (threadIdx.x == 0) (void)xb_add(&bar[XB_XCNT(b.x)], 1u);
    return b;
}
__device__ __forceinline__ void xcd_barrier_complete(unsigned* bar, unsigned x, unsigned& nloc, unsigned& nx) {
    const unsigned G = gridDim.x * gridDim.y * gridDim.z;
    unsigned sum, cnt, mine, sp = 0u;
    for (;;) {
        sum = 0u; cnt = 0u; mine = 0u;
#pragma unroll
        for (unsigned j = 0; j < 16; ++j) { const unsigned c = xb_ld(&bar[XB_XCNT(j)]); sum += c; cnt += (c > 0u) ? 1u : 0u; mine = (j == x) ? c : mine; }
        if (sum == G) break;
        __builtin_amdgcn_s_sleep(1);
        if ((++sp & 255u) == 0u) { if (xb_ld(&bar[XB_TMO])) break; if (sp > XB_SPIN_CAP) { atomicAdd(&bar[XB_TMO], 1u); break; } }
    }
    nloc = mine > 0u ? mine : 1u; nx = cnt > 0u ? cnt : 1u;
}

__device__ __forceinline__ void xcd_barrier(const XcdBarrier& b) {
    asm volatile("s_waitcnt vmcnt(0)" ::: "memory");
    __syncthreads();
    if (threadIdx.x == 0) {
        unsigned* bar = b.bar;
        __builtin_amdgcn_s_waitcnt(0);
        unsigned nloc = b.st[0], nx = b.st[1];
        if (nloc == 0u) { xcd_barrier_complete(bar, b.x, nloc, nx); b.st[0] = nloc; b.st[1] = nx; }
        const unsigned old = xb_add(&bar[XB_XSUB(b.x)], 1u);
        const unsigned gen = old / nloc;
        if (old + 1u == (gen + 1u) * nloc) {
            __builtin_amdgcn_fence(__ATOMIC_RELEASE, "agent");
            asm volatile("s_waitcnt vmcnt(0)" ::: "memory");
            const unsigned og = xb_add(&bar[XB_TOP], 1u);
            const unsigned tg = og / nx;
            if (og + 1u == (tg + 1u) * nx) xb_add(&bar[XB_TOPGEN], 1u);
            else XB_SPIN(xb_ld(&bar[XB_TOPGEN]) == tg, bar);
            __builtin_amdgcn_fence(__ATOMIC_ACQUIRE, "agent");
            xb_add(&bar[XB_XGEN(b.x)], 1u);
            asm volatile("s_waitcnt vmcnt(0)" ::: "memory");
        } else {
            XB_SPIN(xb_ld(&bar[XB_XGEN(b.x)]) == gen, bar);
            __builtin_amdgcn_fence(__ATOMIC_ACQUIRE, "agent");
            asm volatile("s_waitcnt vmcnt(0)" ::: "memory");
        }
    }
    __syncthreads();
}
typedef float f32x16 __attribute__((ext_vector_type(16)));
typedef unsigned u32x2 __attribute__((ext_vector_type(2)));
typedef short s16x4 __attribute__((ext_vector_type(4)));
typedef unsigned u32x4 __attribute__((ext_vector_type(4)));
__device__ __forceinline__ float bf2f(unsigned h) { return __builtin_bit_cast(float, h << 16); }

constexpr int NWAVES = 8, NTHR = 512;
constexpr int BATCH = 2, SEQ = 8192, DM = 2048, M = BATCH * SEQ, DEPTH = 4, DFF = 5632;
constexpr int FOX_H = 16, FOX_D = 128, FOX_IN = 6160, FOX_N = 6144;
constexpr int SWA_D = 64, SWA_HQ = 32, SWA_HK = 8, SWA_N = 3072;
constexpr int SGU_N = 4096;
constexpr float EPS = 1e-6f, LOG2E = 1.4426950408889634f;
constexpr float FOX_QSCALE = 0.08838834764831845f * LOG2E;
constexpr float SWA_QSCALE = 0.125f * LOG2E;
constexpr int MOD_KS = 32;

constexpr size_t MiB = 1u << 20;
constexpr size_t WS_CTL = 0, CTL_ZERO_BYTES = 1 * MiB;
constexpr size_t WS_VEC = 1 * MiB;
constexpr size_t WS_ROPE = 2 * MiB;
constexpr size_t WS_WFG = 3 * MiB;
constexpr size_t WS_WSM = 3 * MiB + 512 * 1024;
constexpr size_t WS_LOGF = 4 * MiB;
constexpr size_t WS_CUM = 5 * MiB;
constexpr size_t WS_YSTAT = 6 * MiB;
constexpr size_t WS_VSTAT = 8 * MiB;
constexpr size_t WS_MODP = 12 * MiB;
constexpr size_t WS_WGU = 24 * MiB, WGU_BYTES = 44 * MiB;
constexpr size_t WS_WDN = 200 * MiB, WDN_BYTES = 22 * MiB;
constexpr size_t WS_WFOXIN = 288 * MiB, WFOXIN_BYTES = 24 * MiB;
constexpr size_t WS_WFOXOUT = 336 * MiB, WSQ_BYTES = 8 * MiB;
constexpr size_t WS_WSGUIN = 352 * MiB, WS_WSGUOUT = 368 * MiB, WS_WSWAIN = 376 * MiB, WS_WSWAOUT = 388 * MiB;
constexpr size_t WS_H = 396 * MiB;
constexpr size_t WS_PROJ = 460 * MiB;
constexpr size_t WS_O = 652 * MiB;
constexpr size_t WS_Y = 716 * MiB;
constexpr size_t WS_XA = 780 * MiB;
constexpr size_t WS_END = 908 * MiB;
constexpr int CW_TMO = 0, CW_CODE = 1, CW_BAR = 4096, CW_ERR = 8192, CW_ERRV = 8193, CW_NCHK = 8194;

constexpr int RING_BYTES = 131072, LDSCTL_OFF = RING_BYTES, MISC_OFF = LDSCTL_OFF + 320, LDS_BYTES = 147456;

struct Args { const float* in[23]; float* out; unsigned char* ws; int ph_lo, ph_hi; };
static_assert(sizeof(Args) == 25 * 8 + 8, "Args has no padding");

struct Frame {
    LAS unsigned char* lds;
    int tid, lane, wave, vcu, G;
};
__device__ __forceinline__ Frame launder(const Frame& Fi) { Frame F = Fi; asm volatile("" : "+v"(F.tid)); F.lane = F.tid & 63; F.wave = __builtin_amdgcn_readfirstlane(F.tid >> 6); asm volatile("" : "+s"(F.vcu)); return F; }
__device__ __forceinline__ float wave_sum(float v) {
#pragma unroll
    for (int o = 1; o < 64; o <<= 1) v += __shfl_xor(v, o);
    return v;
}
__device__ __forceinline__ float wave_max(float v) {
#pragma unroll
    for (int o = 1; o < 64; o <<= 1) v = fmaxf(v, __shfl_xor(v, o));
    return v;
}

__device__ __forceinline__ void p0_transpose_item(const float* W, int ldw, int K, bf16* WT, int k0, int n0, int c0, LAS float* scr, int lane) {
#pragma unroll 8
    for (int i = 0; i < 32; ++i) { const int kk = 2 * i + (lane >> 5); scr[kk * 33 + (lane & 31)] = W[(size_t)(k0 + kk) * ldw + c0 + (lane & 31)]; }
    LDS_WAIT(); asm volatile("" ::: "memory");
    const int c = lane & 7;
#pragma unroll
    for (int j = 0; j < 4; ++j) { const int n = (lane >> 3) + 8 * j; const LAS float* s = scr + (8 * c) * 33 + n;
        v4u o; o.x = pk2(s[0 * 33], s[1 * 33]); o.y = pk2(s[2 * 33], s[3 * 33]); o.z = pk2(s[4 * 33], s[5 * 33]); o.w = pk2(s[6 * 33], s[7 * 33]);
        *(GAS v4u*)(WT + (size_t)(n0 + n) * K + k0 + 8 * c) = o; }
    LDS_WAIT(); asm volatile("" ::: "memory");
}
constexpr int IT_GU = 32 * 352, IT_DN = 88 * 64, IT_FOXIN = 32 * 192, IT_SQ = 32 * 64, IT_SGUIN = 32 * 128, IT_SWAIN = 32 * 96;
constexpr int IT_TOTAL = 4 * IT_GU + 4 * IT_DN + 2 * IT_FOXIN + 2 * IT_SQ + IT_SGUIN + IT_SQ + IT_SWAIN + IT_SQ;
constexpr int MOD_CHUNKS = 12288 / 256;
constexpr int IT_MOD = DEPTH * MOD_KS * MOD_CHUNKS;
__device__ __forceinline__ void conv_item(const Args& a, int r, LAS float* scr, int lane) {
    unsigned char* ws = a.ws;
    const float* W; int ldw, K, N; bf16* WT; int gu = 0;
    if (r < 4 * IT_GU) { const int l = r / IT_GU; r -= l * IT_GU; W = a.in[9] + (size_t)l * DM * 2 * DFF; ldw = 2 * DFF; K = DM; N = 2 * DFF; WT = (bf16*)(ws + WS_WGU + l * WGU_BYTES); gu = 1; }
    else { r -= 4 * IT_GU;
    if (r < 4 * IT_DN) { const int l = r / IT_DN; r -= l * IT_DN; W = a.in[10] + (size_t)l * DFF * DM; ldw = DM; K = DFF; N = DM; WT = (bf16*)(ws + WS_WDN + l * WDN_BYTES); }
    else { r -= 4 * IT_DN;
    if (r < 2 * IT_FOXIN) { const int l = r / IT_FOXIN; r -= l * IT_FOXIN; W = a.in[11] + (size_t)l * DM * FOX_IN; ldw = FOX_IN; K = DM; N = FOX_N; WT = (bf16*)(ws + WS_WFOXIN + l * WFOXIN_BYTES); }
    else { r -= 2 * IT_FOXIN;
    if (r < 2 * IT_SQ) { const int l = r / IT_SQ; r -= l * IT_SQ; W = a.in[13] + (size_t)l * DM * DM; ldw = DM; K = DM; N = DM; WT = (bf16*)(ws + WS_WFOXOUT + l * WSQ_BYTES); }
    else { r -= 2 * IT_SQ;
    if (r < IT_SGUIN) { W = a.in[14]; ldw = SGU_N; K = DM; N = SGU_N; WT = (bf16*)(ws + WS_WSGUIN); }
    else { r -= IT_SGUIN;
    if (r < IT_SQ) { W = a.in[19]; ldw = DM; K = DM; N = DM; WT = (bf16*)(ws + WS_WSGUOUT); }
    else { r -= IT_SQ;
    if (r < IT_SWAIN) { W = a.in[20]; ldw = SWA_N; K = DM; N = SWA_N; WT = (bf16*)(ws + WS_WSWAIN); }
    else { r -= IT_SWAIN; W = a.in[22]; ldw = DM; K = DM; N = DM; WT = (bf16*)(ws + WS_WSWAOUT); } } } } } } }
    const int nblk = N / 32, kb = r / nblk, nb = r % nblk, n0 = 32 * nb;
    int c0 = n0;
    if (gu) { const int tile = n0 >> 8, bj = (n0 >> 7) & 1, j = n0 & 127; c0 = bj * DFF + tile * 128 + j; }
    p0_transpose_item(W, ldw, K, WT, 64 * kb, n0, c0, scr, lane);
}
__device__ __forceinline__ void mod_item(const Args& a, int r, const LAS float* sc, int lane) {
    const int l = r / (MOD_KS * MOD_CHUNKS), ks = (r / MOD_CHUNKS) % MOD_KS, ch = r % MOD_CHUNKS;
    const float* W = a.in[3] + ((size_t)l * DM + ks * 64) * 12288 + ch * 256 + lane * 4;
    f32x4 a0 = {0.f, 0.f, 0.f, 0.f}, a1 = {0.f, 0.f, 0.f, 0.f};
#pragma unroll 8
    for (int k = 0; k < 64; ++k) { const f32x4 w = *(const f32x4*)(W + (size_t)k * 12288); const float s0 = sc[ks * 64 + k], s1 = sc[DM + ks * 64 + k]; a0 += w * s0; a1 += w * s1; }
    float* P = (float*)(a.ws + WS_MODP) + ((size_t)(l * MOD_KS + ks) * 2) * 12288 + ch * 256 + lane * 4;
    *(f32x4*)P = a0; *(f32x4*)(P + 12288) = a1;
}
__device__ __forceinline__ double sin_poly(double r) { const double r2 = r * r; return r * (1.0 + r2 * (-1.0 / 6 + r2 * (1.0 / 120 + r2 * (-1.0 / 5040 + r2 * (1.0 / 362880 + r2 * (-1.0 / 39916800 + r2 * (1.0 / 6227020800.0 + r2 * (-1.0 / 1307674368000.0)))))))); }
__device__ __forceinline__ double cos_poly(double r) { const double r2 = r * r; return 1.0 + r2 * (-0.5 + r2 * (1.0 / 24 + r2 * (-1.0 / 720 + r2 * (1.0 / 40320 + r2 * (-1.0 / 3628800 + r2 * (1.0 / 479001600.0 + r2 * (-1.0 / 87178291200.0 + r2 * (1.0 / 20922789888000.0)))))))); }
__device__ __forceinline__ void sincos_f32angle(float ang, float& c, float& s) {
    const double x = (double)ang, q = rint(x * 0.6366197723675814);
    const double r = (x - q * 1.5707963267948966) - q * 6.123233995736766e-17;
    const int n = ((int)(long long)q) & 3;
    const double sr = sin_poly(r), cr = cos_poly(r);
    const double ss = (n == 0) ? sr : (n == 1) ? cr : (n == 2) ? -sr : -cr;
    const double cc = (n == 0) ? cr : (n == 1) ? -sr : (n == 2) ? -cr : sr;
    c = (float)cc; s = (float)ss;
}
__constant__ float ROPE_INV[8] = {1.0f, 0.193922743f, 0.0376060307f, 0.00729266461f, 0.00141421356f, 0.000274248188f, 5.3182961e-05f, 1.03133862e-05f};
__device__ __forceinline__ void p0_prologue(const Frame& Fi, const Args& a) {
    Frame F = launder(Fi);
    unsigned char* ws = a.ws;
    LAS float* sc = (LAS float*)(F.lds + 8 * 8704);
    for (int i = F.tid; i < 2 * DM; i += NTHR) { const float v = a.in[1][i]; sc[i] = v / (1.0f + expf(-v)); }
    __syncthreads();
    LAS float* scr = (LAS float*)(F.lds + F.wave * 8704);
    const int gw = F.vcu * NWAVES + F.wave, NGW = F.G * NWAVES;
    for (int it = gw; it < IT_MOD + IT_TOTAL; it += NGW) { if (it < IT_MOD) mod_item(a, it, sc, F.lane); else conv_item(a, it - IT_MOD, scr, F.lane); }
    const int gt = F.vcu * NTHR + F.tid, NGT = F.G * NTHR;
    float* rope = (float*)(ws + WS_ROPE); const int* pos = (const int*)a.in[2];
    for (int i = gt; i < M * 8; i += NGT) { const int m = i >> 3, k = i & 7; const float ang = (float)pos[m] * ROPE_INV[k]; float c, s; sincos_f32angle(ang, c, s); rope[m * 16 + k] = c; rope[m * 16 + 8 + k] = s; }
    float* wfg = (float*)(ws + WS_WFG);
    for (int i = gt; i < 2 * 16 * DM; i += NGT) { const int j = i / (16 * DM), hd = (i / DM) % 16, k = i % DM; wfg[i] = a.in[11][((size_t)j * DM + k) * FOX_IN + FOX_N + hd]; }
    bf16* wsm = (bf16*)(ws + WS_WSM);
    for (int i = gt; i < 16 * 128 * 128; i += NGT) { const int t = (i >> 7) & 127, s = i & 127; wsm[i] = (bf16)(s <= t ? f2bf(a.in[17][i]) : 0u); }
}
__device__ __forceinline__ void p1_modvec(const Frame& Fi, const Args& a) {
    Frame F = launder(Fi);
    const int gt = F.vcu * NTHR + F.tid, NGT = F.G * NTHR;
    const float* modp = (const float*)(a.ws + WS_MODP); float* vec = (float*)(a.ws + WS_VEC);
    for (int i = gt; i < DEPTH * 2 * 6 * DM; i += NGT) {
        const int col = i % DM, part = (i / DM) % 6, b = (i / (6 * DM)) % 2, l = i / (12 * DM);
        float s = 0.f;
        for (int ks = 0; ks < MOD_KS; ++ks) s += modp[((size_t)(l * MOD_KS + ks) * 2 + b) * 12288 + part * DM + col];
        s += a.in[4][l * 12288 + part * DM + col];
        float v; int slot;
        if (part == 0) { v = s; slot = 1; } else if (part == 1) { v = a.in[5][l * DM + col] * (1.0f + s); slot = 0; } else if (part == 2) { v = s * a.in[6][l * DM + col]; slot = 2; }
        else if (part == 3) { v = s; slot = 4; } else if (part == 4) { v = a.in[7][l * DM + col] * (1.0f + s); slot = 3; } else { v = s * a.in[8][l * DM + col]; slot = 5; }
        vec[((size_t)(l * 2 + b) * 6 + slot) * DM + col] = v;
    }
}
__device__ __forceinline__ float log_sigmoidf(float x) { return x < 0.f ? x - log1pf(expf(x)) : -log1pf(expf(-x)); }
__device__ __forceinline__ void norm_phase(const Frame& Fi, const float* xin, float* xout, const bf16* y, const float* ystat, const float* gvec, const float* avec, const float* shvec,
                                           bf16* hout, const float* wfg, const float* bfv, float* logf) {
    Frame F = launder(Fi);
    const int lane = F.lane;
    if (wfg) { for (int i = F.tid; i < 16 * DM / 4; i += NTHR) ((LAS f32x4*)F.lds)[i] = ((const f32x4*)wfg)[i]; __syncthreads(); }
    const int gw = F.vcu * NWAVES + F.wave, NGW = F.G * NWAVES;
    int curb = -1; f32x4 av[8], sv[8], gv[8];
#pragma unroll
    for (int j = 0; j < 8; ++j) { av[j] = (f32x4){0.f, 0.f, 0.f, 0.f}; sv[j] = av[j]; gv[j] = av[j]; }
    for (int m = gw; m < M; m += NGW) {
        const int b = m >> 13;
        if (b != curb) { curb = b; const size_t vo = (size_t)b * 6 * DM;
#pragma unroll
            for (int j = 0; j < 8; ++j) { if (hout) { av[j] = ((const f32x4*)(avec + vo))[64 * j + lane]; sv[j] = ((const f32x4*)(shvec + vo))[64 * j + lane]; } if (y) gv[j] = ((const f32x4*)(gvec + vo))[64 * j + lane]; } }
        f32x4 xv[8];
        const f32x4* xr = (const f32x4*)(xin + (size_t)m * DM);
#pragma unroll
        for (int j = 0; j < 8; ++j) xv[j] = xr[64 * j + lane];
        if (y) {
            float q = lane < 32 ? ystat[(size_t)m * 32 + lane] : 0.f; q = wave_sum(q);
            const float rstdy = 1.0f / sqrtf(q * (1.0f / DM) + EPS);
            const u32x2* yr = (const u32x2*)(y + (size_t)m * DM);
#pragma unroll
            for (int j = 0; j < 8; ++j) { const u32x2 w = yr[64 * j + lane]; f32x4 yf; yf[0] = bf2f(w.x & 0xffffu); yf[1] = bf2f(w.x >> 16); yf[2] = bf2f(w.y & 0xffffu); yf[3] = bf2f(w.y >> 16);
                xv[j] += gv[j] * (yf * rstdy); }
            if (xout) { f32x4* xo = (f32x4*)(xout + (size_t)m * DM);
#pragma unroll
                for (int j = 0; j < 8; ++j) xo[64 * j + lane] = xv[j]; }
        }
        if (hout) {
            float q = 0.f;
#pragma unroll
            for (int j = 0; j < 8; ++j) q += (xv[j][0] * xv[j][0] + xv[j][1] * xv[j][1]) + (xv[j][2] * xv[j][2] + xv[j][3] * xv[j][3]);
            q = wave_sum(q);
            const float rstdx = 1.0f / sqrtf(q * (1.0f / DM) + EPS);
            u32x2* ho = (u32x2*)(hout + (size_t)m * DM);
#pragma unroll
            for (int j = 0; j < 8; ++j) { xv[j] = xv[j] * rstdx * av[j] + sv[j]; u32x2 w; w.x = pk2(xv[j][0], xv[j][1]); w.y = pk2(xv[j][2], xv[j][3]); ho[64 * j + lane] = w; }
            if (wfg) {
                float mine = 0.f;
#pragma unroll 1
                for (int hd = 0; hd < 16; ++hd) { const LAS f32x4* wr = (const LAS f32x4*)F.lds + hd * (DM / 4); float p = 0.f;
#pragma unroll
                    for (int j = 0; j < 8; ++j) { const f32x4 w = wr[64 * j + lane]; p += (xv[j][0] * w[0] + xv[j][1] * w[1]) + (xv[j][2] * w[2] + xv[j][3] * w[3]); }
                    p = wave_sum(p); if (lane == hd) mine = p; }
                if (lane < 16) logf[(size_t)(b * 16 + lane) * SEQ + (m & (SEQ - 1))] = log_sigmoidf(mine + bfv[lane]);
            }
        }
    }
    if (wfg) __syncthreads();
}
__device__ __forceinline__ void fox_scan(const Frame& Fi, const float* logf, float* cum) {
    Frame F = launder(Fi);
    if (blockIdx.x < 32) {
        const float* src = logf + (size_t)blockIdx.x * SEQ + 16 * F.tid; float* dst = cum + (size_t)blockIdx.x * SEQ + 16 * F.tid;
        f32x4 v[4];
#pragma unroll
        for (int j = 0; j < 4; ++j) v[j] = ((const f32x4*)src)[j];
        double tot = 0.0;
#pragma unroll
        for (int j = 0; j < 4; ++j) { tot += (double)v[j][0]; tot += (double)v[j][1]; tot += (double)v[j][2]; tot += (double)v[j][3]; }
        LAS double* sd = (LAS double*)F.lds;
        sd[F.tid] = tot; __syncthreads();
        if (F.tid == 0) { double run = 0.0; for (int i = 0; i < NTHR; ++i) { const double t = sd[i]; sd[i] = run; run += t; } }
        __syncthreads();
        double run = sd[F.tid];
#pragma unroll
        for (int j = 0; j < 4; ++j) { f32x4 o; run += (double)v[j][0]; o[0] = (float)run; run += (double)v[j][1]; o[1] = (float)run; run += (double)v[j][2]; o[2] = (float)run; run += (double)v[j][3]; o[3] = (float)run; ((f32x4*)dst)[j] = o; }
        __syncthreads();
    }
}
#define MFMA32(a, b, c) __builtin_amdgcn_mfma_f32_32x32x16_bf16((a), (b), (c), 0, 0, 0)
typedef short v4i16_t __attribute__((ext_vector_type(4)));
__device__ __forceinline__ s16x4 lds_tr16(const LAS unsigned char* p) { return __builtin_bit_cast(s16x4, __builtin_amdgcn_ds_read_tr16_b64_v4i16((LAS v4i16_t*)p)); }
__device__ __forceinline__ int crow(int r, int hi) { return (r & 3) + 8 * (r >> 2) + 4 * hi; }
__device__ __forceinline__ bf16x8 pack8(const f32x16& p, int s) {
    u32x4 w; w.x = pg8::cvt_pk_bf16(p[8 * s + 0], p[8 * s + 1]); w.y = pg8::cvt_pk_bf16(p[8 * s + 2], p[8 * s + 3]); w.z = pg8::cvt_pk_bf16(p[8 * s + 4], p[8 * s + 5]); w.w = pg8::cvt_pk_bf16(p[8 * s + 6], p[8 * s + 7]);
    return __builtin_bit_cast(bf16x8, w);
}
__device__ __forceinline__ bf16x8 cat44(s16x4 lo, s16x4 hi) { return (bf16x8){lo[0], lo[1], lo[2], lo[3], hi[0], hi[1], hi[2], hi[3]}; }
#define WG_BAR() do { asm volatile("s_waitcnt vmcnt(0) lgkmcnt(0)" ::: "memory"); __builtin_amdgcn_s_barrier(); asm volatile("" ::: "memory"); } while (0)

constexpr int FA_KROW = 272, FA_VROW = 320, FA_KBUF = 64 * FA_KROW, FA_VBUF = 64 * FA_VROW, FA_K0 = 0, FA_V0 = 2 * FA_KBUF, FA_B0 = FA_V0 + 2 * FA_VBUF;
__device__ __forceinline__ void fox_attn_phase(const Frame& Fi, const bf16* P, const float* cum, bf16* O) {
    Frame F = launder(Fi);
    const int tid = F.tid, lane = F.lane, wave = F.wave, r32 = lane & 31, hi = lane >> 5;
    LAS unsigned char* lds = F.lds;
    const int bh = F.vcu >> 3, sidx = F.vcu & 7, b = bh >> 4, hd = bh & 15;
    const int srow = tid >> 3, sc16 = (tid & 7) * 16;
    const int trq = (lane & 15) >> 2, trp = lane & 3, trc = (lane >> 4) & 1;
    const size_t rowbase = (size_t)b * SEQ;
#pragma unroll 1
    for (int ui = 0; ui < 4; ++ui) {
        const int qb = (ui == 0) ? sidx : (ui == 1) ? 15 - sidx : (ui == 2) ? 16 + sidx : 31 - sidx;
        const int q0 = 256 * qb, T0 = 4 * qb + 3, tw = 4 * qb + (wave >> 1);
        const int qrow = q0 + 32 * wave + r32;
        bf16x8 qf[8];
        { const bf16* qp = P + (rowbase + qrow) * FOX_N + hd * FOX_D + 8 * hi;
#pragma unroll
          for (int d0 = 0; d0 < 8; ++d0) qf[d0] = *(const bf16x8*)(qp + 16 * d0); }
        const float* cumh = cum + (size_t)bh * SEQ;
        const float Fref = cumh[q0];
        const bf16* Kg = P + rowbase * FOX_N + 2048 + hd * FOX_D + sc16;
        const bf16* Vg = P + rowbase * FOX_N + 4096 + hd * FOX_D + sc16;
        u32x4 kr0, kr1, vr0, vr1; float br = 0.f;
#define FA_LOAD(t) do { const size_t ro = (size_t)(64 * (t) + srow) * FOX_N; kr0 = *(const u32x4*)(Kg + ro); kr1 = *(const u32x4*)(Kg + ro + 8); vr0 = *(const u32x4*)(Vg + ro); vr1 = *(const u32x4*)(Vg + ro + 8); \
            if (tid < 64) br = cumh[64 * (t) + tid]; } while (0)
#define FA_STORE(buf) do { LAS unsigned char* kd = lds + FA_K0 + (buf) * FA_KBUF + srow * FA_KROW + sc16 * 2; *(LAS u32x4*)kd = kr0; *(LAS u32x4*)(kd + 16) = kr1; \
            LAS unsigned char* vd = lds + FA_V0 + (buf) * FA_VBUF + srow * FA_VROW + sc16 * 2; *(LAS u32x4*)vd = vr0; *(LAS u32x4*)(vd + 16) = vr1; \
            if (tid < 64) ((LAS float*)(lds + FA_B0))[(buf) * 64 + tid] = (Fref - br) * LOG2E; } while (0)
        f32x16 o[4];
#pragma unroll
        for (int d = 0; d < 4; ++d)
#pragma unroll
            for (int r = 0; r < 16; ++r) o[d][r] = 0.f;
        float mrun = -INFINITY, lrun = 0.f;
        FA_LOAD(T0); FA_STORE(0); WG_BAR();
        int cur = 0;
#pragma unroll 1
        for (int t = T0; t >= 0; --t) {
            if (t > 0) FA_LOAD(t - 1);
            if (t <= tw) {
                const LAS unsigned char* kb = lds + FA_K0 + cur * FA_KBUF + r32 * FA_KROW + 16 * hi;
                const LAS float* bb = (const LAS float*)(lds + FA_B0) + cur * 64 + 4 * hi;
                f32x16 s0, s1;
#pragma unroll
                for (int g = 0; g < 4; ++g) { const f32x4 b0 = *(const LAS f32x4*)(bb + 8 * g), b1 = *(const LAS f32x4*)(bb + 32 + 8 * g);
#pragma unroll
                    for (int i = 0; i < 4; ++i) { s0[4 * g + i] = b0[i]; s1[4 * g + i] = b1[i]; } }
#pragma unroll
                for (int d0 = 0; d0 < 8; ++d0) { const bf16x8 k0 = *(const LAS bf16x8*)(kb + 32 * d0), k1 = *(const LAS bf16x8*)(kb + 32 * FA_KROW + 32 * d0);
                    s0 = MFMA32(k0, qf[d0], s0); s1 = MFMA32(k1, qf[d0], s1); }
                if (t == tw) {
#pragma unroll
                    for (int r = 0; r < 16; ++r) { const int key = 64 * t + crow(r, hi); if (key > qrow) s0[r] = -INFINITY; if (key + 32 > qrow) s1[r] = -INFINITY; }
                }
                float mx = fmaxf(s0[0], s1[0]);
#pragma unroll
                for (int r = 1; r < 16; ++r) mx = fmaxf(mx, fmaxf(s0[r], s1[r]));
                mx = fmaxf(mx, __shfl_xor(mx, 32));
                const float mnew = fmaxf(mrun, mx), alpha = __builtin_amdgcn_exp2f(mrun - mnew);
                mrun = mnew;
                float ps = 0.f;
#pragma unroll
                for (int r = 0; r < 16; ++r) { s0[r] = __builtin_amdgcn_exp2f(s0[r] - mnew); s1[r] = __builtin_amdgcn_exp2f(s1[r] - mnew); ps += s0[r] + s1[r]; }
                lrun = lrun * alpha + ps;
#pragma unroll
                for (int d = 0; d < 4; ++d)
#pragma unroll
                    for (int r = 0; r < 16; ++r) o[d][r] *= alpha;
                bf16x8 pf[4]; pf[0] = pack8(s0, 0); pf[1] = pack8(s0, 1); pf[2] = pack8(s1, 0); pf[3] = pack8(s1, 1);
                const LAS unsigned char* vb = lds + FA_V0 + cur * FA_VBUF + (4 * hi + trq) * FA_VROW + (16 * trc + 4 * trp) * 2;
#pragma unroll
                for (int ks = 0; ks < 4; ++ks) {
#pragma unroll
                    for (int d = 0; d < 4; ++d) { const s16x4 lo = lds_tr16(vb + 16 * ks * FA_VROW + 64 * d), hh = lds_tr16(vb + (16 * ks + 8) * FA_VROW + 64 * d);
                        o[d] = MFMA32(cat44(lo, hh), pf[ks], o[d]); }
                }
            }
            if (t > 0) FA_STORE(cur ^ 1);
            WG_BAR(); cur ^= 1;
        }
        const float ltot = lrun + __shfl_xor(lrun, 32), inv = 1.0f / ltot;
        bf16* op = O + (rowbase + qrow) * DM + hd * FOX_D + 4 * hi;
#pragma unroll
        for (int d = 0; d < 4; ++d)
#pragma unroll
            for (int g = 0; g < 4; ++g) { u32x2 w; w.x = pg8::cvt_pk_bf16(o[d][4 * g] * inv, o[d][4 * g + 1] * inv); w.y = pg8::cvt_pk_bf16(o[d][4 * g + 2] * inv, o[d][4 * g + 3] * inv);
                *(u32x2*)(op + 32 * d + 8 * g) = w; }
#undef FA_LOAD
#undef FA_STORE
    }
}
constexpr int SW_KROW = 144, SW_VROW = 192, SW_K0 = 0, SW_V0 = 256 * SW_KROW;
__device__ __forceinline__ void swa_phase(const Frame& Fi, const bf16* P, const float* rope, const float* sinks, bf16* O) {
    Frame F = launder(Fi);
    const int tid = F.tid, lane = F.lane, wave = F.wave, r32 = lane & 31, hi = lane >> 5;
    LAS unsigned char* lds = F.lds;
    const int trq = (lane & 15) >> 2, trp = lane & 3, trc = (lane >> 4) & 1;
#pragma unroll 1
    for (int u = F.vcu; u < BATCH * 64 * SWA_HK; u += F.G) {
        const int hk = u & 7, n = (u >> 3) & 63, b = u >> 9;
        const size_t blk0 = (size_t)b * SEQ + (size_t)n * 128;
#pragma unroll
        for (int it = 0; it < 2; ++it) { const int item = tid + it * NTHR, row = item >> 2, pr = item & 3;
            u32x4 k0 = {0u, 0u, 0u, 0u}, k1 = k0, v0 = k0, v1 = k0;
            if (n > 0 || row >= 128) { const size_t m = blk0 - 128 + row; const bf16* kp = P + m * SWA_N + 2048 + hk * SWA_D + 16 * pr; const bf16* vp = P + m * SWA_N + 2560 + hk * SWA_D + 16 * pr;
                k0 = *(const u32x4*)kp; k1 = *(const u32x4*)(kp + 8); v0 = *(const u32x4*)vp; v1 = *(const u32x4*)(vp + 8);
                if (pr == 0) { const f32x4* cs = (const f32x4*)(rope + m * 16); const f32x4 c0 = cs[0], c1 = cs[1], s0 = cs[2], s1 = cs[3];
                    u32x4 n0, n1;
#pragma unroll
                    for (int i = 0; i < 4; ++i) { const float c_lo = (i < 2) ? c0[2 * i] : c1[2 * i - 4], c_hi = (i < 2) ? c0[2 * i + 1] : c1[2 * i - 3], s_lo = (i < 2) ? s0[2 * i] : s1[2 * i - 4], s_hi = (i < 2) ? s0[2 * i + 1] : s1[2 * i - 3];
                        const float a_lo = bf2f(k0[i] & 0xffffu), a_hi = bf2f(k0[i] >> 16), b_lo = bf2f(k1[i] & 0xffffu), b_hi = bf2f(k1[i] >> 16);
                        n0[i] = pk2(a_lo * c_lo - b_lo * s_lo, a_hi * c_hi - b_hi * s_hi); n1[i] = pk2(b_lo * c_lo + a_lo * s_lo, b_hi * c_hi + a_hi * s_hi); }
                    k0 = n0; k1 = n1; } }
            LAS unsigned char* kd = lds + SW_K0 + row * SW_KROW + 32 * pr; *(LAS u32x4*)kd = k0; *(LAS u32x4*)(kd + 16) = k1;
            LAS unsigned char* vd = lds + SW_V0 + row * SW_VROW + 32 * pr; *(LAS u32x4*)vd = v0; *(LAS u32x4*)(vd + 16) = v1; }
        WG_BAR();
#pragma unroll 1
        for (int it = 0; it < 2; ++it) {
            const int g = wave & 3, rb = (wave >> 2) + 2 * it, hq = hk * 4 + g;
            const int qi = 32 * rb + r32; const size_t m = blk0 + qi;
            bf16x8 qf[4];
            { const bf16* qp = P + m * SWA_N + hq * SWA_D;
              const u32x4 x1 = *(const u32x4*)qp, x2 = *(const u32x4*)(qp + 8);
              const f32x4* cs = (const f32x4*)(rope + m * 16); const f32x4 c0 = cs[0], c1 = cs[1], s0 = cs[2], s1 = cs[3];
              u32x4 w;
#pragma unroll
              for (int i = 0; i < 4; ++i) { const float c_lo = (i < 2) ? c0[2 * i] : c1[2 * i - 4], c_hi = (i < 2) ? c0[2 * i + 1] : c1[2 * i - 3], s_lo = (i < 2) ? s0[2 * i] : s1[2 * i - 4], s_hi = (i < 2) ? s0[2 * i + 1] : s1[2 * i - 3];
                  const float a_lo = bf2f(x1[i] & 0xffffu), a_hi = bf2f(x1[i] >> 16), b_lo = bf2f(x2[i] & 0xffffu), b_hi = bf2f(x2[i] >> 16);
                  const float r_lo = hi ? (b_lo * c_lo + a_lo * s_lo) : (a_lo * c_lo - b_lo * s_lo), r_hi = hi ? (b_hi * c_hi + a_hi * s_hi) : (a_hi * c_hi - b_hi * s_hi);
                  w[i] = pk2(r_lo * SWA_QSCALE, r_hi * SWA_QSCALE); }
              qf[0] = __builtin_bit_cast(bf16x8, w);
#pragma unroll
              for (int d0 = 1; d0 < 4; ++d0) { const u32x4 x = *(const u32x4*)(qp + 16 * d0 + 8 * hi); u32x4 ww;
#pragma unroll
                  for (int i = 0; i < 4; ++i) ww[i] = pk2(bf2f(x[i] & 0xffffu) * SWA_QSCALE, bf2f(x[i] >> 16) * SWA_QSCALE);
                  qf[d0] = __builtin_bit_cast(bf16x8, ww); } }
            f32x16 s[5];
#pragma unroll
            for (int j = 0; j < 5; ++j) {
#pragma unroll
                for (int r = 0; r < 16; ++r) s[j][r] = 0.f;
                const LAS unsigned char* kb = lds + SW_K0 + (32 * (rb + j) + r32) * SW_KROW + 16 * hi;
#pragma unroll
                for (int d0 = 0; d0 < 4; ++d0) s[j] = MFMA32(*(const LAS bf16x8*)(kb + 32 * d0), qf[d0], s[j]);
#pragma unroll
                for (int r = 0; r < 16; ++r) { const int kk = 32 * (rb + j) + crow(r, hi), ki = kk - 128, rel = qi - ki; const bool ok = (rel >= 0) && (rel < 128) && (n * 128 + ki >= 0); if (!ok) s[j][r] = -INFINITY; }
            }
            const float sink2 = sinks[hq] * LOG2E;
            float mx = sink2;
#pragma unroll
            for (int j = 0; j < 5; ++j)
#pragma unroll
                for (int r = 0; r < 16; ++r) mx = fmaxf(mx, s[j][r]);
            mx = fmaxf(mx, __shfl_xor(mx, 32));
            float ps = 0.f;
#pragma unroll
            for (int j = 0; j < 5; ++j)
#pragma unroll
                for (int r = 0; r < 16; ++r) { s[j][r] = __builtin_amdgcn_exp2f(s[j][r] - mx); ps += s[j][r]; }
            ps += __shfl_xor(ps, 32);
            const float inv = 1.0f / (ps + __builtin_amdgcn_exp2f(sink2 - mx));
            f32x16 o[2];
#pragma unroll
            for (int d = 0; d < 2; ++d)
#pragma unroll
                for (int r = 0; r < 16; ++r) o[d][r] = 0.f;
            const LAS unsigned char* vb = lds + SW_V0 + (32 * rb + 4 * hi + trq) * SW_VROW + (16 * trc + 4 * trp) * 2;
#pragma unroll
            for (int j = 0; j < 5; ++j)
#pragma unroll
                for (int ks = 0; ks < 2; ++ks) { const bf16x8 pf = pack8(s[j], ks);
#pragma unroll
                    for (int d = 0; d < 2; ++d) { const s16x4 lo = lds_tr16(vb + (32 * j + 16 * ks) * SW_VROW + 64 * d), hh = lds_tr16(vb + (32 * j + 16 * ks + 8) * SW_VROW + 64 * d);
                        o[d] = MFMA32(cat44(lo, hh), pf, o[d]); } }
            bf16* op = O + m * DM + hq * SWA_D + 4 * hi;
#pragma unroll
            for (int d = 0; d < 2; ++d)
#pragma unroll
                for (int gq = 0; gq < 4; ++gq) { u32x2 w; w.x = pg8::cvt_pk_bf16(o[d][4 * gq] * inv, o[d][4 * gq + 1] * inv); w.y = pg8::cvt_pk_bf16(o[d][4 * gq + 2] * inv, o[d][4 * gq + 3] * inv);
                    *(u32x2*)(op + 32 * d + 8 * gq) = w; }
        }
        WG_BAR();
    }
}
constexpr int SG_VROW = 320, SG_V0 = 0, SG_ST = 128 * SG_VROW;
__device__ __forceinline__ void sgu_phase(const Frame& Fi, const bf16* P, const float* vstat, const float* lng, const float* lnb, const bf16* wsm, const float* bs, bf16* O) {
    Frame F = launder(Fi);
    const int tid = F.tid, lane = F.lane, wave = F.wave, r32 = lane & 31, hi = lane >> 5;
    LAS unsigned char* lds = F.lds;
    const int trq = (lane & 15) >> 2, trp = lane & 3, trc = (lane >> 4) & 1;
    LAS float* rst = (LAS float*)(lds + SG_ST);
#pragma unroll 1
    for (int u = F.vcu; u < BATCH * 64 * 16; u += F.G) {
        const int g = u & 15, ch = (u >> 4) & 63, b = u >> 10;
        const size_t m0 = (size_t)b * SEQ + (size_t)ch * 128;
        if (tid < 128) { const float* sp = vstat + (m0 + tid) * 64; float s = 0.f, q = 0.f;
#pragma unroll 8
            for (int i = 0; i < 32; ++i) { s += sp[2 * i]; q += sp[2 * i + 1]; }
            const float mean = s * (1.0f / DM), var = fmaxf(q * (1.0f / DM) - mean * mean, 0.f);
            rst[2 * tid] = mean; rst[2 * tid + 1] = 1.0f / sqrtf(var + EPS); }
        WG_BAR();
#pragma unroll
        for (int it = 0; it < 4; ++it) { const int item = tid + it * NTHR, row = item >> 4, c8 = (item & 15) * 8;
            const u32x4 x = *(const u32x4*)(P + (m0 + row) * SGU_N + 2048 + g * 128 + c8);
            const f32x4 g0 = *(const f32x4*)(lng + g * 128 + c8), g1 = *(const f32x4*)(lng + g * 128 + c8 + 4), b0 = *(const f32x4*)(lnb + g * 128 + c8), b1 = *(const f32x4*)(lnb + g * 128 + c8 + 4);
            const float mean = rst[2 * row], rstd = rst[2 * row + 1]; u32x4 w;
#pragma unroll
            for (int i = 0; i < 4; ++i) { const float ga = (i < 2) ? g0[2 * i] : g1[2 * i - 4], gb = (i < 2) ? g0[2 * i + 1] : g1[2 * i - 3], ba = (i < 2) ? b0[2 * i] : b1[2 * i - 4], bb = (i < 2) ? b0[2 * i + 1] : b1[2 * i - 3];
                w[i] = pk2((bf2f(x[i] & 0xffffu) - mean) * rstd * ga + ba, (bf2f(x[i] >> 16) - mean) * rstd * gb + bb); }
            *(LAS u32x4*)(lds + SG_V0 + row * SG_VROW + c8 * 2) = w; }
        WG_BAR();
        const int tb = wave & 3;
        const bf16* wrow = wsm + ((size_t)g * 128 + 32 * tb + r32) * 128 + 8 * hi;
#pragma unroll 1
        for (int it = 0; it < 2; ++it) { const int db = (wave >> 2) + 2 * it;
            f32x16 acc;
#pragma unroll
            for (int r = 0; r < 16; ++r) acc[r] = 0.f;
            const LAS unsigned char* vb = lds + SG_V0 + (8 * hi + trq) * SG_VROW + (32 * db + 16 * trc + 4 * trp) * 2;
#pragma unroll 1
            for (int ks = 0; ks < 2 * tb + 2; ++ks) { const bf16x8 wf = *(const bf16x8*)(wrow + 16 * ks);
                const s16x4 lo = lds_tr16(vb + 16 * ks * SG_VROW), hh = lds_tr16(vb + (16 * ks + 4) * SG_VROW);
                acc = MFMA32(cat44(lo, hh), wf, acc); }
            const int t = 32 * tb + r32; const float bias = bs[g * 128 + t];
            const bf16* up = P + (m0 + t) * SGU_N + g * 128 + 32 * db + 4 * hi; bf16* op = O + (m0 + t) * DM + g * 128 + 32 * db + 4 * hi;
#pragma unroll
            for (int gq = 0; gq < 4; ++gq) { const u32x2 uu = *(const u32x2*)(up + 8 * gq); u32x2 w;
                w.x = pg8::cvt_pk_bf16(bf2f(uu.x & 0xffffu) * (acc[4 * gq] + bias), bf2f(uu.x >> 16) * (acc[4 * gq + 1] + bias));
                w.y = pg8::cvt_pk_bf16(bf2f(uu.y & 0xffffu) * (acc[4 * gq + 2] + bias), bf2f(uu.y >> 16) * (acc[4 * gq + 3] + bias));
                *(u32x2*)(op + 8 * gq) = w; } }
        WG_BAR();
    }
}
constexpr int NPHASE = 31, PH_FINAL = 30;
__global__ void __launch_bounds__(NTHR, 2) mk_fwd(Args args) {
    extern __shared__ __attribute__((aligned(16))) unsigned char lds_raw[];
    Frame F;
    F.lds = (LAS unsigned char*)lds_raw;
    F.tid = threadIdx.x; F.lane = F.tid & 63; F.wave = __builtin_amdgcn_readfirstlane(F.tid >> 6);
    F.G = gridDim.x; { const int bx = blockIdx.x; F.vcu = (F.G % 8 == 0) ? (bx % 8) * (F.G / 8) + bx / 8 : bx; }
    unsigned char* ws = args.ws;
    gu32* ctl = (gu32*)(ws + WS_CTL);
    for (int u = F.tid; u < (LDS_BYTES - LDSCTL_OFF) / 4; u += NTHR) ((LAS unsigned*)(F.lds + LDSCTL_OFF))[u] = 0u;
    __syncthreads();
    XcdBarrier bar = xcd_barrier_post((unsigned*)(ctl + CW_BAR), (volatile LAS unsigned*)(F.lds + MISC_OFF) + 8);
    const int lo = args.ph_lo, hi = args.ph_hi;
#define IN(k) (lo <= (k) && (k) < hi)
#define SEAM(k) do { if (IN(k) && IN((k) + 1)) xcd_barrier(bar); } while (0)
    bf16* Hb = (bf16*)(ws + WS_H); bf16* Pb = (bf16*)(ws + WS_PROJ); bf16* Ob = (bf16*)(ws + WS_O); bf16* Yb = (bf16*)(ws + WS_Y);
    float* XA = (float*)(ws + WS_XA); float* ystat = (float*)(ws + WS_YSTAT); float* vstat = (float*)(ws + WS_VSTAT);
    const float* vec = (const float*)(ws + WS_VEC);
    float* logf = (float*)(ws + WS_LOGF); float* cum = (float*)(ws + WS_CUM);

    if (IN(0)) { p0_prologue(F, args); } SEAM(0);
    if (IN(1)) { p1_modvec(F, args); } SEAM(1);

#pragma unroll 1
    for (int s = 0; s < 2 * DEPTH; ++s) {
        const int l = s >> 1, half = s & 1, kind = l % 3, jj = l / 3, base = 2 + 7 * l + 4 * half;
        if (IN(base)) {
            const float* xin = (s == 0 || s == 1) ? args.in[0] : (((s - 1) & 1) ? XA : args.out);
            float* xout = (s == 0) ? nullptr : ((s & 1) ? XA : args.out);
            const float* lv = vec + (size_t)l * 12 * DM;
            const float* gsrc = (s == 0) ? nullptr : (half ? lv + 2 * DM : vec + (size_t)(l - 1) * 12 * DM + 5 * DM);
            const float* av = half ? lv + 3 * DM : lv + 0 * DM; const float* sv = half ? lv + 4 * DM : lv + 1 * DM;
            const bool fox = (half == 0 && kind == 0);
            norm_phase(F, xin, xout, s == 0 ? nullptr : Yb, ystat, gsrc, av, sv, Hb, fox ? (const float*)(ws + WS_WFG) + (size_t)jj * 16 * DM : nullptr, args.in[12] + jj * 16, logf);
        }
        SEAM(base);
        if (half == 0) {
            if (IN(base + 1)) {
                if (kind == 1) {
                    pg8::Gemm g{Hb, (const bf16*)(ws + WS_WSGUIN), M, SGU_N, DM}; pg8::StaticOrder S; S.init(M, SGU_N, F.G, (int)blockIdx.x);
                    pg8::EpiSguIn E{Pb, SGU_N, vstat};
                    pg8::gemm_phase<pg8::EpiSguIn, pg8::StaticOrder, true, true>(F.lds, g, S, E);
                } else {
                    if (kind == 0) fox_scan(F, logf, cum);
                    const int N = kind == 0 ? FOX_N : SWA_N;
                    const bf16* Bt = kind == 0 ? (const bf16*)(ws + WS_WFOXIN + jj * WFOXIN_BYTES) : (const bf16*)(ws + WS_WSWAIN);
                    pg8::Gemm g{Hb, Bt, M, N, DM}; pg8::StaticOrder S; S.init(M, N, F.G, (int)blockIdx.x);
                    pg8::EpiProj E{Pb, N, kind == 0 ? 2048 : 0, FOX_QSCALE};
                    pg8::gemm_phase<pg8::EpiProj, pg8::StaticOrder, true, true>(F.lds, g, S, E);
                }
            }
            SEAM(base + 1);
            if (IN(base + 2)) {
                if (kind == 0) fox_attn_phase(F, Pb, cum, Ob);
                else if (kind == 1) sgu_phase(F, Pb, vstat, args.in[15], args.in[16], (const bf16*)(ws + WS_WSM), args.in[18], Ob);
                else swa_phase(F, Pb, (const float*)(ws + WS_ROPE), args.in[21], Ob);
            }
            SEAM(base + 2);
        } else {
            if (IN(base + 1)) {
                pg8::Gemm g{Hb, (const bf16*)(ws + WS_WGU + l * WGU_BYTES), M, 2 * DFF, DM}; pg8::StaticOrder S; S.init(M, 2 * DFF, F.G, (int)blockIdx.x);
                pg8::EpiSwiglu E{Pb, DFF};
                pg8::gemm_phase<pg8::EpiSwiglu, pg8::StaticOrder, true, true>(F.lds, g, S, E);
            }
            SEAM(base + 1);
        }
        { const int ph = half ? base + 2 : base + 3;
          if (IN(ph)) {
              const bf16* A = half ? Pb : Ob; const int K = half ? DFF : DM;
              const bf16* Bt = half ? (const bf16*)(ws + WS_WDN + l * WDN_BYTES) : (kind == 0 ? (const bf16*)(ws + WS_WFOXOUT + jj * WSQ_BYTES) : kind == 1 ? (const bf16*)(ws + WS_WSGUOUT) : (const bf16*)(ws + WS_WSWAOUT));
              pg8::Gemm g{A, Bt, M, DM, K}; pg8::StaticOrder S; S.init(M, DM, F.G, (int)blockIdx.x);
              pg8::EpiOut E{Yb, DM, ystat};
              pg8::gemm_phase<pg8::EpiOut, pg8::StaticOrder, true, true>(F.lds, g, S, E);
          }
          SEAM(ph); }
    }
    if (IN(PH_FINAL)) {
        const float* gsrc = vec + (size_t)3 * 12 * DM + 5 * DM;
        norm_phase(F, XA, args.out, Yb, ystat, gsrc, nullptr, nullptr, nullptr, nullptr, nullptr, nullptr);
    }
#undef IN
#undef SEAM
}
#if DBG
static void dbg_checks(int phase, const Args& a, hipStream_t stream);
__global__ void dbg_finalize(Args a);
#endif
extern "C" void kernel_launch(void* const* d_in, const int* in_sizes, int n_in, void* d_out, int out_size, void* d_ws, size_t ws_size, hipStream_t stream) {
    static int grid = 0;
    if (grid == 0) {
        if (n_in != 23 || out_size != M * DM || ws_size < WS_END) { fprintf(stderr, "kernel_launch: unexpected shapes (n_in %d, out %d, ws %zu); nothing launched\n", n_in, out_size, ws_size); grid = -1; return; }
        int dev = 0, cus = 0, per_cu = 0;
        if (hipGetDevice(&dev) != hipSuccess || hipDeviceGetAttribute(&cus, hipDeviceAttributeMultiprocessorCount, dev) != hipSuccess) { grid = -1; return; }
        if (hipFuncSetAttribute((const void*)mk_fwd, hipFuncAttributeMaxDynamicSharedMemorySize, LDS_BYTES) != hipSuccess) { fprintf(stderr, "kernel_launch: hipFuncSetAttribute failed\n"); grid = -1; return; }
        if (hipOccupancyMaxActiveBlocksPerMultiprocessor(&per_cu, (const void*)mk_fwd, NTHR, LDS_BYTES) != hipSuccess || per_cu < 1) { fprintf(stderr, "kernel_launch: occupancy query says %d blocks per CU\n", per_cu); }
        (void)hipGetLastError();
        grid = cus;
        if (grid != 256) { fprintf(stderr, "kernel_launch: built for a 256-CU device, found %d CUs; nothing launched\n", cus); grid = -1; return; }
    }
    if (grid < 0) return;
    (void)hipMemsetAsync((char*)d_ws + WS_CTL, 0, CTL_ZERO_BYTES, stream);
    Args a{};
    for (int i = 0; i < 23; ++i) a.in[i] = (const float*)d_in[i];
    a.out = (float*)d_out; a.ws = (unsigned char*)d_ws;
#if DBG
    for (int ph = 0; ph < NPHASE; ++ph) { a.ph_lo = ph; a.ph_hi = ph + 1; hipLaunchKernelGGL(mk_fwd, dim3(grid), dim3(NTHR), LDS_BYTES, stream, a); dbg_checks(ph, a, stream); }
    hipLaunchKernelGGL(dbg_finalize, dim3(1024), dim3(256), 0, stream, a);
#else
    a.ph_lo = 0; a.ph_hi = NPHASE;
    hipLaunchKernelGGL(mk_fwd, dim3(grid), dim3(NTHR), LDS_BYTES, stream, a);
#endif
    const hipError_t le = hipPeekAtLastError();
    if (le != hipSuccess) fprintf(stderr, "kernel_launch: launch failed: %s\n", hipGetErrorName(le));
}
#if DBG
__device__ __forceinline__ void dbg_fail(unsigned char* ws, unsigned code, float val) {
    unsigned* ctl = (unsigned*)(ws + WS_CTL);
    if (atomicCAS(ctl + CW_ERR, 0u, code) == 0u) ctl[CW_ERRV] = __float_as_uint(val);
}
__device__ __forceinline__ float block_sum256(float v, float* sh) {
    const int t = threadIdx.x; sh[t] = v; __syncthreads();
    for (int o = 128; o > 0; o >>= 1) { if (t < o) sh[t] += sh[t + o]; __syncthreads(); }
    const float r = sh[0]; __syncthreads(); return r;
}
__device__ __forceinline__ float block_max256(float v, float* sh) {
    const int t = threadIdx.x; sh[t] = v; __syncthreads();
    for (int o = 128; o > 0; o >>= 1) { if (t < o) sh[t] = fmaxf(sh[t], sh[t + o]); __syncthreads(); }
    const float r = sh[0]; __syncthreads(); return r;
}
__device__ __forceinline__ unsigned hash32(unsigned x) { x ^= x >> 16; x *= 0x7feb352du; x ^= x >> 15; x *= 0x846ca68bu; x ^= x >> 16; return x; }
__device__ __forceinline__ int dbg_row(int i) { return i * 256 + ((i * 37 + 11) & 255); }

struct ChkW { const float* W; const bf16* WT; int ldw, K, N, gu; };
__global__ void chk_weights(Args a, ChkW c, unsigned code) {
    const unsigned i = blockIdx.x * blockDim.x + threadIdx.x; const unsigned h = hash32(i * 2654435761u + code);
    const int n = h % c.N, k = hash32(h) % c.K;
    int col = n; if (c.gu) { const int tile = n >> 8, bj = (n >> 7) & 1, j = n & 127; col = bj * DFF + tile * 128 + j; }
    const float w = c.W[(size_t)k * c.ldw + col], g = bf2f(c.WT[(size_t)n * c.K + k]);
    if (!(fabsf(g - w) <= 0.004f * fabsf(w) + 1e-30f)) dbg_fail(a.ws, code, (float)n);
}
__global__ void chk_tables(Args a, unsigned code) {
    const int i = blockIdx.x * blockDim.x + threadIdx.x;
    const float* wfg = (const float*)(a.ws + WS_WFG); const bf16* wsm = (const bf16*)(a.ws + WS_WSM); const float* rope = (const float*)(a.ws + WS_ROPE);
    { const int j = i / 32768, hd = (i / 2048) % 16, k = i % 2048; if (wfg[i] != a.in[11][((size_t)j * DM + k) * FOX_IN + FOX_N + hd]) dbg_fail(a.ws, code, 1.f); }
    for (int e = i; e < 16 * 128 * 128; e += 65536) { const int t = (e >> 7) & 127, s = e & 127; const float w = s <= t ? a.in[17][e] : 0.f; if (!(fabsf(bf2f(wsm[e]) - w) <= 0.004f * fabsf(w))) dbg_fail(a.ws, code, 2.f); }
    { const int m = i & (M - 1), k = (i >> 14) & 7  ; const int pos = ((const int*)a.in[2])[m]; const float ang = (float)pos * ROPE_INV[k];
      const float c = cosf(ang), s = sinf(ang); if (!(fabsf(rope[m * 16 + k] - c) < 2e-5f && fabsf(rope[m * 16 + 8 + k] - s) < 2e-5f)) dbg_fail(a.ws, code, 3.f); }
}
__global__ void chk_modvec(Args a, unsigned code) {
    const int i = blockIdx.x * blockDim.x + threadIdx.x;
    if (i >= 3072) return;
    const int l = i / 768, b = (i / 384) % 2, slot = (i / 64) % 6, col = ((i % 64) * 32 + (i * 7) % 32) % DM;
    const int part = slot == 0 ? 1 : slot == 1 ? 0 : slot == 2 ? 2 : slot == 3 ? 4 : slot == 4 ? 3 : 5;
    double s = 0.0;
    for (int k = 0; k < DM; ++k) { const double c = (double)a.in[1][b * DM + k]; s += c / (1.0 + exp(-c)) * (double)a.in[3][((size_t)l * DM + k) * 12288 + part * DM + col]; }
    s += (double)a.in[4][l * 12288 + part * DM + col];
    double v;
    if (slot == 0) v = (double)a.in[5][l * DM + col] * (1.0 + s); else if (slot == 1) v = s; else if (slot == 2) v = s * (double)a.in[6][l * DM + col];
    else if (slot == 3) v = (double)a.in[7][l * DM + col] * (1.0 + s); else if (slot == 4) v = s; else v = s * (double)a.in[8][l * DM + col];
    const float got = ((const float*)(a.ws + WS_VEC))[((size_t)(l * 2 + b) * 6 + slot) * DM + col];
    if (!(fabs((double)got - v) <= 1e-3 * fabs(v) + 1e-4)) dbg_fail(a.ws, code, (float)i);
}
struct ChkN { const float* xin; const float* xout; const bf16* y; const float* g; const float* av; const float* sv; const bf16* h; const float* wfox; const float* bf; const float* logf; };
__global__ void chk_norm(Args a, ChkN c, unsigned code) {
    __shared__ float sh[256]; __shared__ float hrow[DM];
    const int m = dbg_row(blockIdx.x), b = m >> 13, t = threadIdx.x; const size_t vo = (size_t)b * 6 * DM;
    float xn[8];
    float q = 0.f;
    if (c.y) { for (int j = 0; j < 8; ++j) { const float yv = bf2f(c.y[(size_t)m * DM + t + 256 * j]); q += yv * yv; } }
    q = block_sum256(q, sh);
    const float rstdy = 1.0f / sqrtf(q / DM + EPS);
    float e2 = 0.f, r2 = 0.f;
    for (int j = 0; j < 8; ++j) { const int col = t + 256 * j; float x = c.xin[(size_t)m * DM + col];
        if (c.y) { x += c.g[vo + col] * bf2f(c.y[(size_t)m * DM + col]) * rstdy; if (c.xout) { const float d = c.xout[(size_t)m * DM + col] - x; e2 += d * d; r2 += x * x; } }
        xn[j] = x; }
    e2 = block_sum256(e2, sh); r2 = block_sum256(r2, sh);
    if (c.y && c.xout && !(e2 <= 1e-4f * r2)) dbg_fail(a.ws, code, sqrtf(e2 / (r2 + 1e-30f)));
    if (!c.h) return;
    float qx = 0.f; for (int j = 0; j < 8; ++j) qx += xn[j] * xn[j];
    qx = block_sum256(qx, sh);
    const float rstdx = 1.0f / sqrtf(qx / DM + EPS);
    e2 = 0.f; r2 = 0.f;
    for (int j = 0; j < 8; ++j) { const int col = t + 256 * j; const float hv = xn[j] * rstdx * c.av[vo + col] + c.sv[vo + col]; hrow[col] = hv; const float d = bf2f(c.h[(size_t)m * DM + col]) - hv; e2 += d * d; r2 += hv * hv; }
    e2 = block_sum256(e2, sh); r2 = block_sum256(r2, sh);
    if (!(e2 <= 1e-4f * r2)) dbg_fail(a.ws, code + 40, sqrtf(e2 / (r2 + 1e-30f)));
    if (!c.wfox) return;
    __syncthreads();
    for (int hd = 0; hd < 16; ++hd) { float p = 0.f; for (int j = 0; j < 8; ++j) { const int k = t + 256 * j; p += hrow[k] * c.wfox[(size_t)k * FOX_IN + FOX_N + hd]; }
        p = block_sum256(p, sh);
        if (t == 0) { const float x = p + c.bf[hd]; const float ls = (float)(-log1p(exp(-(double)x))); const float got = c.logf[(size_t)(b * 16 + hd) * SEQ + (m & (SEQ - 1))];
            if (!(fabsf(got - ls) <= 5e-3f)) dbg_fail(a.ws, code + 80, got - ls); } }
}
struct ChkG { const bf16* A; const float* W; const bf16* out; const float* stat; int K, ldw, N, mode, ldo, qcols; float qscale; int pad; };
static ChkG mkG(const bf16* A, int K, const float* W, int ldw, int N, int mode, const bf16* out, int ldo, int qcols, float qscale, const float* stat) { ChkG c{}; c.A = A; c.W = W; c.out = out; c.stat = stat; c.K = K; c.ldw = ldw; c.N = N; c.mode = mode; c.ldo = ldo; c.qcols = qcols; c.qscale = qscale; c.pad = 0; return c; }
__global__ void chk_gemm(Args a, ChkG c, unsigned code) {
    __shared__ float sh[256]; __shared__ float arow[DFF];
    const int m = dbg_row(blockIdx.x), t = threadIdx.x;
    for (int k = t; k < c.K; k += 256) arow[k] = bf2f(c.A[(size_t)m * c.K + k]);
    __syncthreads();
    float e2 = 0.f, r2 = 0.f, s1 = 0.f, s2 = 0.f, emax = 0.f;
    for (int col = t; col < c.N; col += 256) {
        float d0 = 0.f, d1 = 0.f;
        for (int k = 0; k < c.K; ++k) { d0 += arow[k] * c.W[(size_t)k * c.ldw + col]; if (c.mode == 2) d1 += arow[k] * c.W[(size_t)k * c.ldw + DFF + col]; }
        float ex;
        if (c.mode == 0) ex = d0 * (col < c.qcols ? c.qscale : 1.0f);
        else if (c.mode == 1) ex = 0.5f * d0 * (1.0f + tanhf(0.7978845608028654f * (d0 + 0.044715f * d0 * d0 * d0)));
        else if (c.mode == 2) ex = d0 / (1.0f + expf(-d0)) * d1;
        else ex = d0;
        const float got = bf2f(c.out[(size_t)m * c.ldo + col]), d = got - ex; e2 += d * d; r2 += ex * ex; emax = fmaxf(emax, fabsf(d));
        if (c.mode == 3) s2 += ex * ex;
        if (c.mode == 1 && col >= 2048) { s1 += ex; s2 += ex * ex; }
    }
    e2 = block_sum256(e2, sh); r2 = block_sum256(r2, sh); emax = block_max256(emax, sh); s1 = block_sum256(s1, sh); s2 = block_sum256(s2, sh);
    const float rms = sqrtf(r2 / c.N);
    if (!(e2 <= 4e-4f * r2) || !(emax <= 0.15f * rms + 1e-6f)) dbg_fail(a.ws, code, sqrtf(e2 / (r2 + 1e-30f)));
    if (t == 0 && c.stat) {
        if (c.mode == 3) { float q = 0.f; for (int i = 0; i < 32; ++i) q += c.stat[(size_t)m * 32 + i]; if (!(fabsf(q - s2) <= 0.02f * s2)) dbg_fail(a.ws, code + 40, q / s2); }
        if (c.mode == 1) { float s = 0.f, q = 0.f; for (int i = 0; i < 32; ++i) { s += c.stat[((size_t)m * 32 + i) * 2]; q += c.stat[((size_t)m * 32 + i) * 2 + 1]; }
            if (!(fabsf(q - s2) <= 0.02f * s2) || !(fabsf(s - s1) <= 0.02f * fabsf(s1) + 1.0f)) dbg_fail(a.ws, code + 40, q / s2); }
    }
}
__global__ void chk_scan(Args a, unsigned code) {
    const int i = blockIdx.x * blockDim.x + threadIdx.x; if (i >= 128) return;
    const int bh = i >> 2, which = i & 3, t = which == 0 ? 0 : which == 1 ? 1000 + 13 * bh : which == 2 ? 4096 + bh : 8191;
    const float* lf = (const float*)(a.ws + WS_LOGF) + (size_t)bh * SEQ; double s = 0.0;
    for (int j = 0; j <= t; ++j) s += (double)lf[j];
    const float got = ((const float*)(a.ws + WS_CUM))[(size_t)bh * SEQ + t];
    if (!(fabs((double)got - s) <= 1e-3 + 1e-5 * fabs(s))) dbg_fail(a.ws, code, (float)((double)got - s));
}
__global__ void chk_fox(Args a, unsigned code) {
    __shared__ float sh[256]; __shared__ float sc[SEQ]; __shared__ float qv[FOX_D];
    const int bh = blockIdx.x >> 2, which = blockIdx.x & 3, b = bh >> 4, hd = bh & 15, t = threadIdx.x;
    const int i = which == 0 ? (bh % 3) : which == 1 ? 63 + 64 * (bh % 5) + (bh & 1) : which == 2 ? 3000 + 97 * bh : 8191 - (bh % 7) * 256;
    const bf16* P = (const bf16*)(a.ws + WS_PROJ); const float* cum = (const float*)(a.ws + WS_CUM) + (size_t)bh * SEQ; const size_t rb = (size_t)b * SEQ;
    if (t < FOX_D) qv[t] = bf2f(P[(rb + i) * FOX_N + hd * FOX_D + t]);
    __syncthreads();
    float mx = -INFINITY;
    for (int j = t; j <= i; j += 256) { const bf16* kp = P + (rb + j) * FOX_N + 2048 + hd * FOX_D; float d = 0.f; for (int e = 0; e < FOX_D; ++e) d += qv[e] * bf2f(kp[e]);
        d += (cum[i] - cum[j]) * LOG2E; sc[j] = d; mx = fmaxf(mx, d); }
    mx = block_max256(mx, sh);
    float l = 0.f;
    for (int j = t; j <= i; j += 256) { const float p = exp2f(sc[j] - mx); sc[j] = p; l += p; }
    l = block_sum256(l, sh);
    float e2 = 0.f, r2 = 0.f;
    if (t < FOX_D) { float o = 0.f; for (int j = 0; j <= i; ++j) o += sc[j] * bf2f(P[(rb + j) * FOX_N + 4096 + hd * FOX_D + t]); o /= l;
        const float got = bf2f(((const bf16*)(a.ws + WS_O))[(rb + i) * DM + hd * FOX_D + t]), d = got - o; e2 = d * d; r2 = o * o; }
    e2 = block_sum256(e2, sh); r2 = block_sum256(r2, sh);
    if (!(e2 <= 1e-3f * r2)) dbg_fail(a.ws, code, sqrtf(e2 / (r2 + 1e-30f)) + 10.f * which);
}
__global__ void chk_swa(Args a, unsigned code) {
    __shared__ float qv[64]; __shared__ float sc[128]; __shared__ float red[2];
    const int smp = blockIdx.x, t = threadIdx.x;
    const int b = smp & 1, hq = (smp * 5 + 3) & 31, hk = hq >> 2;
    const int i = (smp < 8) ? smp * 17 : (smp < 16) ? 127 + (smp - 8) * 128 : (smp * 131 + 29) & (SEQ - 1);
    const bf16* P = (const bf16*)(a.ws + WS_PROJ); const int* pos = (const int*)a.in[2]; const size_t rb = (size_t)b * SEQ;
    { const bf16* qp = P + (rb + i) * SWA_N + hq * SWA_D; float v = bf2f(qp[t]);
      if (t < 16) { const int k = t & 7; const float ang = (float)pos[rb + i] * ROPE_INV[k], c = cosf(ang), s = sinf(ang); const float x1 = bf2f(qp[k]), x2 = bf2f(qp[8 + k]); v = (t < 8) ? x1 * c - x2 * s : x2 * c + x1 * s; }
      qv[t] = v; }
    __syncthreads();
    const int blk = i >> 7;
    for (int jj = t; jj < 128; jj += 64) { const int j = i - jj; float d = -INFINITY;
        if (j >= 0 && j >= (blk - 1) * 128) { const bf16* kp = P + (rb + j) * SWA_N + 2048 + hk * SWA_D; d = 0.f;
            for (int e = 0; e < 64; ++e) { float kv = bf2f(kp[e]);
                if (e < 16) { const int k = e & 7; const float ang = (float)pos[rb + j] * ROPE_INV[k], c = cosf(ang), s = sinf(ang); const float x1 = bf2f(kp[k]), x2 = bf2f(kp[8 + k]); kv = (e < 8) ? x1 * c - x2 * s : x2 * c + x1 * s; }
                d += qv[e] * kv; }
            d *= 0.125f; }
        sc[jj] = d; }
    __syncthreads();
    if (t == 0) { float mx = a.in[21][hq]; for (int jj = 0; jj < 128; ++jj) mx = fmaxf(mx, sc[jj]); float l = expf(a.in[21][hq] - mx); for (int jj = 0; jj < 128; ++jj) l += expf(sc[jj] - mx); red[0] = mx; red[1] = l; }
    __syncthreads();
    float o = 0.f;
    for (int jj = 0; jj < 128; ++jj) { const int j = i - jj; if (sc[jj] > -INFINITY) o += expf(sc[jj] - red[0]) * bf2f(P[(rb + j) * SWA_N + 2560 + hk * SWA_D + t]); }
    o /= red[1];
    const float got = bf2f(((const bf16*)(a.ws + WS_O))[(rb + i) * DM + hq * SWA_D + t]);
    float e2 = (got - o) * (got - o), r2 = o * o;
    for (int of = 32; of > 0; of >>= 1) { e2 += __shfl_xor(e2, of); r2 += __shfl_xor(r2, of); }
    if (t == 0 && !(e2 <= 1e-3f * r2)) dbg_fail(a.ws, code, sqrtf(e2 / (r2 + 1e-30f)));
}
__global__ void chk_sgu(Args a, unsigned code) {
    __shared__ float mean[128], rstd[128]; __shared__ float sh[128];
    const int smp = blockIdx.x, d = threadIdx.x;
    const int g = (smp * 7 + 1) & 15, m = (smp < 4) ? smp * 128 + (smp == 0 ? 0 : 127) : (smp * 1031 + 77) & (M - 1), tt = m & 127; const size_t m0 = (size_t)(m - tt);
    const bf16* P = (const bf16*)(a.ws + WS_PROJ);
    for (int s = 0; s <= tt; ++s) { float su = 0.f, sq = 0.f; for (int c = d; c < DM; c += 128) { const float v = bf2f(P[(m0 + s) * SGU_N + 2048 + c]); su += v; sq += v * v; }
        sh[d] = su; __syncthreads(); for (int o = 64; o > 0; o >>= 1) { if (d < o) sh[d] += sh[d + o]; __syncthreads(); } const float mu = sh[0] / DM; __syncthreads();
        sh[d] = sq; __syncthreads(); for (int o = 64; o > 0; o >>= 1) { if (d < o) sh[d] += sh[d + o]; __syncthreads(); } const float var = sh[0] / DM - mu * mu; __syncthreads();
        if (d == 0) { mean[s] = mu; rstd[s] = 1.0f / sqrtf(fmaxf(var, 0.f) + EPS); } }
    __syncthreads();
    float f = 0.f; const int col = g * 128 + d;
    for (int s = 0; s <= tt; ++s) { const float vn = (bf2f(P[(m0 + s) * SGU_N + 2048 + col]) - mean[s]) * rstd[s] * a.in[15][col] + a.in[16][col]; f += a.in[17][((size_t)g * 128 + tt) * 128 + s] * vn; }
    f += a.in[18][g * 128 + tt];
    const float ex = bf2f(P[(size_t)m * SGU_N + col]) * f, got = bf2f(((const bf16*)(a.ws + WS_O))[(size_t)m * DM + col]);
    float e2 = (got - ex) * (got - ex), r2 = ex * ex;
    sh[d] = e2; __syncthreads(); for (int o = 64; o > 0; o >>= 1) { if (d < o) sh[d] += sh[d + o]; __syncthreads(); } e2 = sh[0]; __syncthreads();
    sh[d] = r2; __syncthreads(); for (int o = 64; o > 0; o >>= 1) { if (d < o) sh[d] += sh[d + o]; __syncthreads(); } r2 = sh[0];
    if (d == 0 && !(e2 <= 1e-3f * r2)) dbg_fail(a.ws, code, sqrtf(e2 / (r2 + 1e-30f)));
}
__global__ void dbg_finalize(Args a) {
    const unsigned* ctl = (const unsigned*)(a.ws + WS_CTL); const unsigned code = ctl[CW_ERR], tmo = ctl[CW_TMO] | ctl[CW_BAR + XB_TMO];
#ifdef DBG_REPORT_VALUE
    const float v = code ? 1000.f * fabsf(__uint_as_float(ctl[CW_ERRV])) : 0.f;
#else
    const float v = code ? 1000.f * (float)code : (tmo ? 999000.f : 0.f);
#endif
    if (v != 0.f) for (size_t i = (size_t)blockIdx.x * blockDim.x + threadIdx.x; i < (size_t)M * DM; i += (size_t)gridDim.x * blockDim.x) a.out[i] = v;
}
static void dbg_checks(int ph, const Args& a, hipStream_t st) {
    unsigned char* ws = a.ws; const unsigned code = (unsigned)ph + 1;
    const bf16* Hb = (const bf16*)(ws + WS_H); const bf16* Pb = (const bf16*)(ws + WS_PROJ); const bf16* Ob = (const bf16*)(ws + WS_O); const bf16* Yb = (const bf16*)(ws + WS_Y);
    const float* XA = (const float*)(ws + WS_XA); const float* vec = (const float*)(ws + WS_VEC);
    if (ph == 0) {
        for (int l = 0; l < 4; ++l) { ChkW c{a.in[9] + (size_t)l * DM * 2 * DFF, (const bf16*)(ws + WS_WGU + l * WGU_BYTES), 2 * DFF, DM, 2 * DFF, 1}; hipLaunchKernelGGL(chk_weights, dim3(64), dim3(256), 0, st, a, c, code); }
        for (int l = 0; l < 4; ++l) { ChkW c{a.in[10] + (size_t)l * DFF * DM, (const bf16*)(ws + WS_WDN + l * WDN_BYTES), DM, DFF, DM, 0}; hipLaunchKernelGGL(chk_weights, dim3(64), dim3(256), 0, st, a, c, code); }
        for (int l = 0; l < 2; ++l) { ChkW c{a.in[11] + (size_t)l * DM * FOX_IN, (const bf16*)(ws + WS_WFOXIN + l * WFOXIN_BYTES), FOX_IN, DM, FOX_N, 0}; hipLaunchKernelGGL(chk_weights, dim3(64), dim3(256), 0, st, a, c, code); }
        for (int l = 0; l < 2; ++l) { ChkW c{a.in[13] + (size_t)l * DM * DM, (const bf16*)(ws + WS_WFOXOUT + l * WSQ_BYTES), DM, DM, DM, 0}; hipLaunchKernelGGL(chk_weights, dim3(64), dim3(256), 0, st, a, c, code); }
        { ChkW c{a.in[14], (const bf16*)(ws + WS_WSGUIN), SGU_N, DM, SGU_N, 0}; hipLaunchKernelGGL(chk_weights, dim3(64), dim3(256), 0, st, a, c, code); }
        { ChkW c{a.in[19], (const bf16*)(ws + WS_WSGUOUT), DM, DM, DM, 0}; hipLaunchKernelGGL(chk_weights, dim3(64), dim3(256), 0, st, a, c, code); }
        { ChkW c{a.in[20], (const bf16*)(ws + WS_WSWAIN), SWA_N, DM, SWA_N, 0}; hipLaunchKernelGGL(chk_weights, dim3(64), dim3(256), 0, st, a, c, code); }
        { ChkW c{a.in[22], (const bf16*)(ws + WS_WSWAOUT), DM, DM, DM, 0}; hipLaunchKernelGGL(chk_weights, dim3(64), dim3(256), 0, st, a, c, code); }
        hipLaunchKernelGGL(chk_tables, dim3(256), dim3(256), 0, st, a, code + 40);
        return;
    }
    if (ph == 1) { hipLaunchKernelGGL(chk_modvec, dim3(12), dim3(256), 0, st, a, code); return; }
    if (ph == PH_FINAL) { ChkN c{XA, a.out, Yb, vec + (size_t)3 * 12 * DM + 5 * DM, nullptr, nullptr, nullptr, nullptr, nullptr, nullptr}; hipLaunchKernelGGL(chk_norm, dim3(64), dim3(256), 0, st, a, c, code); return; }
    const int r = ph - 2, l = r / 7, j = r % 7, kind = l % 3, jj = l / 3, half = j >= 4, s = 2 * l + half;
    const float* lv = vec + (size_t)l * 12 * DM;
    if (j == 0 || j == 4) {
        const float* xin = (s == 0 || s == 1) ? a.in[0] : (((s - 1) & 1) ? XA : (const float*)a.out); const float* xout = (s == 0) ? nullptr : ((s & 1) ? XA : (const float*)a.out);
        const float* gsrc = (s == 0) ? nullptr : (half ? lv + 2 * DM : vec + (size_t)(l - 1) * 12 * DM + 5 * DM);
        const bool fox = (!half && kind == 0);
        ChkN c{xin, xout, s == 0 ? nullptr : Yb, gsrc, half ? lv + 3 * DM : lv, half ? lv + 4 * DM : lv + DM, Hb, fox ? a.in[11] + (size_t)jj * DM * FOX_IN : nullptr, a.in[12] + jj * 16, (const float*)(ws + WS_LOGF)};
        hipLaunchKernelGGL(chk_norm, dim3(64), dim3(256), 0, st, a, c, code); return;
    }
    if (j == 1) {
        if (kind == 0) { hipLaunchKernelGGL(chk_scan, dim3(1), dim3(128), 0, st, a, code + 80);
            ChkG c = mkG(Hb, DM, a.in[11] + (size_t)jj * DM * FOX_IN, FOX_IN, FOX_N, 0, Pb, FOX_N, 2048, FOX_QSCALE, nullptr); hipLaunchKernelGGL(chk_gemm, dim3(64), dim3(256), 0, st, a, c, code); }
        else if (kind == 1) { ChkG c = mkG(Hb, DM, a.in[14], SGU_N, SGU_N, 1, Pb, SGU_N, 0, 1.f, (const float*)(ws + WS_VSTAT)); hipLaunchKernelGGL(chk_gemm, dim3(64), dim3(256), 0, st, a, c, code); }
        else { ChkG c = mkG(Hb, DM, a.in[20], SWA_N, SWA_N, 0, Pb, SWA_N, 0, 1.f, nullptr); hipLaunchKernelGGL(chk_gemm, dim3(64), dim3(256), 0, st, a, c, code); }
        return;
    }
    if (j == 2) { if (kind == 0) hipLaunchKernelGGL(chk_fox, dim3(128), dim3(256), 0, st, a, code); else if (kind == 1) hipLaunchKernelGGL(chk_sgu, dim3(48), dim3(128), 0, st, a, code); else hipLaunchKernelGGL(chk_swa, dim3(64), dim3(64), 0, st, a, code); return; }
    if (j == 3) { const float* W = kind == 0 ? a.in[13] + (size_t)jj * DM * DM : kind == 1 ? a.in[19] : a.in[22];
        ChkG c = mkG(Ob, DM, W, DM, DM, 3, Yb, DM, 0, 1.f, (const float*)(ws + WS_YSTAT)); hipLaunchKernelGGL(chk_gemm, dim3(64), dim3(256), 0, st, a, c, code); return; }
    if (j == 5) { ChkG c = mkG(Hb, DM, a.in[9] + (size_t)l * DM * 2 * DFF, 2 * DFF, DFF, 2, Pb, DFF, 0, 1.f, nullptr); hipLaunchKernelGGL(chk_gemm, dim3(64), dim3(256), 0, st, a, c, code); return; }
    if (j == 6) { ChkG c = mkG(Pb, DFF, a.in[10] + (size_t)l * DFF * DM, DM, DM, 3, Yb, DM, 0, 1.f, (const float*)(ws + WS_YSTAT)); hipLaunchKernelGGL(chk_gemm, dim3(64), dim3(256), 0, st, a, c, code); return; }
}
#endif
```

```cpp
#include <hip/hip_runtime.h>
#include <cstdio>
#include <cstdint>
#include <cmath>

#define PROBE_REPEAT 0
#ifndef DBG
#define DBG 0
#endif

namespace pg8 {
#define PG8_LAS __attribute__((address_space(3)))
typedef unsigned short bf16_t;
typedef short bf16x8 __attribute__((ext_vector_type(8)));
typedef float f32x4 __attribute__((ext_vector_type(4)));
typedef unsigned u32x4 __attribute__((ext_vector_type(4)));
constexpr int BM = 256, BK = 64, HALF = 128, HTB = HALF * BK * 2  , STAGE_BYTES = 8 * HTB, NXCD = 8, WGM = 8;

__host__ __device__ __forceinline__ int lds_byte(int r, int c) { const int st = (r >> 4) * 2 + (c >> 5), rr = r & 15, cc = c & 31, ob = rr * 64 + cc * 2; return st * 1024 + (ob ^ (((ob >> 9) & 1) << 5)); }
__host__ __device__ __forceinline__ void stage_rc(int b, int& R, int& C) { const int st = b / 1024, sb = b % 1024, swz = sb ^ (((sb >> 9) & 1) << 5); R = (st >> 1) * 16 + swz / 64; C = (st & 1) * 32 + (swz % 64) / 2; }
__host__ __device__ __forceinline__ int perm32(int rho) { const int n = rho >> 4, i = rho & 15; return 8 * (i >> 2) + 4 * n + (i & 3); }

struct Unit { int pm, pn; };
struct Gemm { const bf16_t* A; const bf16_t* Bt; int M, N, K; };

struct StaticOrder {
    int nM, nN, nwg, G, c;
    __host__ __device__ void init(int M, int N, int G_, int c_) { nM = M / BM; nN = N / BM; nwg = nM * nN; G = G_; c = c_; }
    __host__ __device__ bool next(int i, Unit& u) const {
        const long L = (long)i * G + c; if (L >= nwg) return false;
        int wgid = (int)L; { const int q = nwg / NXCD, r = nwg % NXCD, xcd = wgid % NXCD, off = wgid / NXCD; wgid = (xcd < r ? xcd * (q + 1) : r * (q + 1) + (xcd - r) * q) + off; }
        const int nig = WGM * nN, gid = wgid / nig, fm = gid * WGM, gsz = (nM - fm) < WGM ? (nM - fm) : WGM;
        u.pm = fm + ((wgid % nig) % gsz); u.pn = (wgid % nig) / gsz; return true;
    }
    __device__ __forceinline__ void a_ready(const Unit&) const {}
    __device__ __forceinline__ void done(const Unit&) const {}
};

__device__ __forceinline__ unsigned cvt_pk_bf16(float lo, float hi) { unsigned r; asm volatile("v_cvt_pk_bf16_f32 %0, %1, %2" : "=v"(r) : "v"(lo), "v"(hi)); return r; }
typedef float f32x2 __attribute__((ext_vector_type(2)));
typedef unsigned u32x2 __attribute__((ext_vector_type(2)));
__device__ __forceinline__ float fast_sigmoid(float x) { return __builtin_amdgcn_rcpf(1.0f + __builtin_amdgcn_exp2f(-1.4426950408889634f * x)); }
struct EpiProj {
    static constexpr bool PERM = true, AFTER_DRAIN = false;
    bf16_t* O; int ldc; int qcols; float qscale;
    __device__ __forceinline__ void operator()(const f32x4 (&acc)[2][2][4][2], const Unit& u, int wr, int wc, int fr, int fq) const {
        const int row0 = u.pm * BM + wr * 64 + fr, colt = u.pn * BM, col0 = colt + wc * 32 + 8 * fq;
        const float sc = colt < qcols ? qscale : 1.0f;
#pragma unroll
        for (int ai = 0; ai < 2; ++ai)
#pragma unroll
            for (int m = 0; m < 4; ++m) { bf16_t* rowp = O + (size_t)(row0 + ai * HALF + m * 16) * ldc + col0;
#pragma unroll
                for (int bj = 0; bj < 2; ++bj) { const f32x4 v0 = acc[ai][bj][m][0] * sc, v1 = acc[ai][bj][m][1] * sc;
                    u32x4 w; w.x = cvt_pk_bf16(v0[0], v0[1]); w.y = cvt_pk_bf16(v0[2], v0[3]); w.z = cvt_pk_bf16(v1[0], v1[1]); w.w = cvt_pk_bf16(v1[2], v1[3]);
                    *(u32x4*)(rowp + bj * HALF) = w; } }
    }
};
struct EpiSwiglu {
    static constexpr bool PERM = true, AFTER_DRAIN = false;
    bf16_t* Z; int ldz;
    __device__ __forceinline__ void operator()(const f32x4 (&acc)[2][2][4][2], const Unit& u, int wr, int wc, int fr, int fq) const {
        const int row0 = u.pm * BM + wr * 64 + fr, col0 = u.pn * HALF + wc * 32 + 8 * fq;
#pragma unroll
        for (int ai = 0; ai < 2; ++ai)
#pragma unroll
            for (int m = 0; m < 4; ++m) { bf16_t* rowp = Z + (size_t)(row0 + ai * HALF + m * 16) * ldz + col0;
                f32x4 z0, z1;
#pragma unroll
                for (int i = 0; i < 4; ++i) { const float g0 = acc[ai][0][m][0][i], g1 = acc[ai][0][m][1][i];
                    z0[i] = g0 * fast_sigmoid(g0) * acc[ai][1][m][0][i]; z1[i] = g1 * fast_sigmoid(g1) * acc[ai][1][m][1][i]; }
                u32x4 w; w.x = cvt_pk_bf16(z0[0], z0[1]); w.y = cvt_pk_bf16(z0[2], z0[3]); w.z = cvt_pk_bf16(z1[0], z1[1]); w.w = cvt_pk_bf16(z1[2], z1[3]);
                *(u32x4*)rowp = w; }
    }
};
struct EpiOut {
    static constexpr bool PERM = true, AFTER_DRAIN = false;
    bf16_t* Y; int ldc; float* stat;
    __device__ __forceinline__ void operator()(const f32x4 (&acc)[2][2][4][2], const Unit& u, int wr, int wc, int fr, int fq) const {
        const int row0 = u.pm * BM + wr * 64 + fr, col0 = u.pn * BM + wc * 32 + 8 * fq;
#pragma unroll
        for (int ai = 0; ai < 2; ++ai)
#pragma unroll
            for (int m = 0; m < 4; ++m) { const int row = row0 + ai * HALF + m * 16; bf16_t* rowp = Y + (size_t)row * ldc + col0; float q = 0.f;
#pragma unroll
                for (int bj = 0; bj < 2; ++bj) { const f32x4 v0 = acc[ai][bj][m][0], v1 = acc[ai][bj][m][1];
                    q += (v0[0] * v0[0] + v0[1] * v0[1]) + (v0[2] * v0[2] + v0[3] * v0[3]) + (v1[0] * v1[0] + v1[1] * v1[1]) + (v1[2] * v1[2] + v1[3] * v1[3]);
                    u32x4 w; w.x = cvt_pk_bf16(v0[0], v0[1]); w.y = cvt_pk_bf16(v0[2], v0[3]); w.z = cvt_pk_bf16(v1[0], v1[1]); w.w = cvt_pk_bf16(v1[2], v1[3]);
                    *(u32x4*)(rowp + bj * HALF) = w; }
                q += __shfl_xor(q, 16); q += __shfl_xor(q, 32);
                if (fq == 0) stat[(size_t)row * 32 + 4 * u.pn + wc] = q; }
    }
};
__device__ __forceinline__ float gelu_tanh_f(float x) { const float t = 1.5957691216057308f * (x + 0.044715f * x * x * x); return x * fast_sigmoid(t); }
struct EpiSguIn {
    static constexpr bool PERM = true, AFTER_DRAIN = false;
    bf16_t* O; int ldc; float* stat2;
    __device__ __forceinline__ void operator()(const f32x4 (&acc)[2][2][4][2], const Unit& u, int wr, int wc, int fr, int fq) const {
        const int row0 = u.pm * BM + wr * 64 + fr, col0 = u.pn * BM + wc * 32 + 8 * fq; const bool vhalf = u.pn >= 8;
#pragma unroll
        for (int ai = 0; ai < 2; ++ai)
#pragma unroll
            for (int m = 0; m < 4; ++m) { const int row = row0 + ai * HALF + m * 16; bf16_t* rowp = O + (size_t)row * ldc + col0; float s = 0.f, q = 0.f;
#pragma unroll
                for (int bj = 0; bj < 2; ++bj) { f32x4 v0, v1;
#pragma unroll
                    for (int i = 0; i < 4; ++i) { v0[i] = gelu_tanh_f(acc[ai][bj][m][0][i]); v1[i] = gelu_tanh_f(acc[ai][bj][m][1][i]); }
                    s += (v0[0] + v0[1]) + (v0[2] + v0[3]) + (v1[0] + v1[1]) + (v1[2] + v1[3]);
                    q += (v0[0] * v0[0] + v0[1] * v0[1]) + (v0[2] * v0[2] + v0[3] * v0[3]) + (v1[0] * v1[0] + v1[1] * v1[1]) + (v1[2] * v1[2] + v1[3] * v1[3]);
                    u32x4 w; w.x = cvt_pk_bf16(v0[0], v0[1]); w.y = cvt_pk_bf16(v0[2], v0[3]); w.z = cvt_pk_bf16(v1[0], v1[1]); w.w = cvt_pk_bf16(v1[2], v1[3]);
                    *(u32x4*)(rowp + bj * HALF) = w; }
                if (vhalf) { s += __shfl_xor(s, 16); s += __shfl_xor(s, 32); q += __shfl_xor(q, 16); q += __shfl_xor(q, 32);
                    if (fq == 0) { float* sp = stat2 + ((size_t)row * 32 + 4 * (u.pn - 8) + wc) * 2; sp[0] = s; sp[1] = q; } } }
    }
};
template <class Epi, class Sched, bool ALIGN_EPI = false, bool SP2 = false>
__device__ __forceinline__ void gemm_phase(PG8_LAS unsigned char* lds, const Gemm g, const Sched& S, const Epi& E) {
    int tid_ = threadIdx.x; asm volatile("" : "+v"(tid_));
    const int tid = tid_, wid = __builtin_amdgcn_readfirstlane(tid >> 6), lane = tid & 63, wr = wid >> 2, wc = wid & 3, fr = lane & 15, fq = lane >> 4;
    const int K = g.K, nt = K / BK;
    unsigned voffA[2], voffB[2];
#pragma unroll
    for (int i = 0; i < 2; ++i) { int R, C; stage_rc(tid * 16 + i * 8192, R, C); const int Rb = Epi::PERM ? ((R & ~31) + perm32(R & 31)) : R;
        voffA[i] = (unsigned)(R * K + C) * 2u; voffB[i] = (unsigned)(Rb * K + C) * 2u; }
    const size_t kstep = (size_t)(BK * 2);
    const size_t hstep = (size_t)HALF * K * 2;
    const size_t tstep = 2 * hstep;
    const unsigned ldsw = (unsigned)wid * 1024u;
    const int aoff = lds_byte(wr * 64 + fr, fq * 8), boff = lds_byte(wc * 32 + fr, fq * 8);
#define PG8_SA(b, h) (((b) * 2 + (h)) * HTB)
#define PG8_SB(b, h) ((4 + (b) * 2 + (h)) * HTB)
#define PG8_STAGE(bufoff, gbase, voff) do { _Pragma("unroll") for (int _i = 0; _i < 2; ++_i) \
        __builtin_amdgcn_global_load_lds((const unsigned*)((const char*)(gbase) + (voff)[_i]), (PG8_LAS unsigned*)(lds + (bufoff) + ldsw + _i * 8192), 16, 0, 0); } while (0)
#define PG8_LDA(dst, b, h) do { _Pragma("unroll") for (int m = 0; m < 4; ++m) _Pragma("unroll") for (int k = 0; k < 2; ++k) dst[m][k] = *(const PG8_LAS bf16x8*)(lds + PG8_SA(b, h) + aoff + m * 2048 + k * 1024); } while (0)
#define PG8_LDB(dst, b, h) do { _Pragma("unroll") for (int n = 0; n < 2; ++n) _Pragma("unroll") for (int k = 0; k < 2; ++k) dst[n][k] = *(const PG8_LAS bf16x8*)(lds + PG8_SB(b, h) + boff + n * 2048 + k * 1024); } while (0)
#define PG8_MMA(ai, bj, At, Bt) do { __builtin_amdgcn_s_setprio(1); _Pragma("unroll") for (int m = 0; m < 4; ++m) _Pragma("unroll") for (int n = 0; n < 2; ++n) _Pragma("unroll") for (int k = 0; k < 2; ++k) \
        acc[ai][bj][m][n] = __builtin_amdgcn_mfma_f32_16x16x32_bf16(Bt[n][k], At[m][k], acc[ai][bj][m][n], 0, 0, 0); __builtin_amdgcn_s_setprio(0); } while (0)
#define PG8_WAIT_V(n) asm volatile("s_waitcnt vmcnt(" #n ")" ::: "memory")
#define PG8_WAIT_L(n) asm volatile("s_waitcnt lgkmcnt(" #n ")" ::: "memory")
#define PG8_BAR __builtin_amdgcn_s_barrier()
#define PG8_SCHED __builtin_amdgcn_sched_barrier(0)
    Unit cur, nxt; int ui = 0;
    if (!S.next(0, cur)) return;
    f32x4 acc[2][2][4][2];
#pragma unroll
    for (int a = 0; a < 2; ++a)
#pragma unroll
        for (int b = 0; b < 2; ++b)
#pragma unroll
            for (int m = 0; m < 4; ++m)
#pragma unroll
                for (int n = 0; n < 2; ++n) acc[a][b][m][n] = (f32x4){0.f, 0.f, 0.f, 0.f};
    bf16x8 At[4][2], B0[2][2], B1[2][2];
    const char* cA = (const char*)g.A + (size_t)cur.pm * tstep; const char* cB = (const char*)g.Bt + (size_t)cur.pn * tstep;
    S.a_ready(cur);
    if constexpr (SP2) {
        PG8_STAGE(PG8_SB(0, 0), cB, voffB); PG8_STAGE(PG8_SB(0, 1), cB + hstep, voffB); PG8_STAGE(PG8_SA(0, 0), cA, voffA); PG8_STAGE(PG8_SA(0, 1), cA + hstep, voffA);
        if (wr == 1) PG8_BAR;
        PG8_WAIT_V(2); PG8_BAR;
        PG8_STAGE(PG8_SB(1, 0), cB + kstep, voffB); PG8_STAGE(PG8_SA(1, 0), cA + kstep, voffA); PG8_STAGE(PG8_SB(1, 1), cB + hstep + kstep, voffB);
        PG8_WAIT_V(6); PG8_BAR;
    } else {
        PG8_STAGE(PG8_SB(0, 0), cB, voffB); PG8_STAGE(PG8_SA(0, 0), cA, voffA); PG8_STAGE(PG8_SB(0, 1), cB + hstep, voffB); PG8_STAGE(PG8_SA(0, 1), cA + hstep, voffA);
        if (wr == 1) PG8_BAR;
        PG8_WAIT_V(4); PG8_BAR;
        PG8_STAGE(PG8_SB(1, 0), cB + kstep, voffB); PG8_STAGE(PG8_SA(1, 0), cA + kstep, voffA); PG8_STAGE(PG8_SB(1, 1), cB + hstep + kstep, voffB);
        PG8_WAIT_V(6); PG8_BAR;
    }
    for (;;) {
        const bool has_next = S.next(ui + 1, nxt);
        const char* nA = has_next ? (const char*)g.A + (size_t)nxt.pm * tstep : cA; const char* nB = has_next ? (const char*)g.Bt + (size_t)nxt.pn * tstep : cB;
        for (int t = 0; t < nt; t += 2) {
            const bool last = (t == nt - 2);
            const char* a1 = cA + (size_t)(t + 1) * kstep;
            const char* a2 = last ? nA : cA + (size_t)(t + 2) * kstep; const char* b2 = last ? nB : cB + (size_t)(t + 2) * kstep;
            const char* a3 = a2 + kstep; const char* b3 = b2 + kstep;
            if (last && has_next) S.a_ready(nxt);
            if constexpr (SP2) {
            PG8_LDB(B0, 0, 0); PG8_LDB(B1, 0, 1); PG8_SCHED; PG8_LDA(At, 0, 0); PG8_STAGE(PG8_SA(1, 1), a1 + hstep, voffA);
            PG8_WAIT_V(8); PG8_WAIT_L(0); PG8_BAR; PG8_MMA(0, 0, At, B0); PG8_MMA(0, 1, At, B1); PG8_BAR; PG8_SCHED;
            PG8_LDA(At, 0, 1); PG8_STAGE(PG8_SB(0, 0), b2, voffB); PG8_STAGE(PG8_SB(0, 1), b2 + hstep, voffB); PG8_STAGE(PG8_SA(0, 0), a2, voffA);
            PG8_WAIT_V(8); PG8_WAIT_L(0); PG8_BAR; PG8_MMA(1, 0, At, B0); PG8_MMA(1, 1, At, B1); PG8_BAR; PG8_SCHED;
            PG8_LDB(B0, 1, 0); PG8_LDB(B1, 1, 1); PG8_SCHED; PG8_LDA(At, 1, 0); PG8_STAGE(PG8_SA(0, 1), a2 + hstep, voffA);
            PG8_WAIT_V(8); PG8_WAIT_L(0); PG8_BAR; PG8_MMA(0, 0, At, B0); PG8_MMA(0, 1, At, B1); PG8_BAR; PG8_SCHED;
            PG8_LDA(At, 1, 1); PG8_STAGE(PG8_SB(1, 0), b3, voffB); PG8_STAGE(PG8_SB(1, 1), b3 + hstep, voffB); PG8_STAGE(PG8_SA(1, 0), a3, voffA);
            PG8_WAIT_V(8); PG8_WAIT_L(0); PG8_BAR; PG8_MMA(1, 0, At, B0); PG8_MMA(1, 1, At, B1); PG8_BAR; PG8_SCHED;
            } else {
            PG8_LDB(B0, 0, 0); PG8_SCHED; PG8_LDA(At, 0, 0); PG8_STAGE(PG8_SA(1, 1), a1 + hstep, voffA);
            PG8_WAIT_L(8); PG8_BAR; PG8_WAIT_L(0); PG8_MMA(0, 0, At, B0); PG8_BAR; PG8_SCHED;
            PG8_LDB(B1, 0, 1); PG8_STAGE(PG8_SB(0, 0), b2, voffB);
            PG8_BAR; PG8_WAIT_L(0); PG8_MMA(0, 1, At, B1); PG8_BAR;
            PG8_LDA(At, 0, 1); PG8_STAGE(PG8_SA(0, 0), a2, voffA);
            PG8_BAR; PG8_WAIT_L(0); PG8_MMA(1, 0, At, B0); PG8_BAR; PG8_SCHED;
            PG8_STAGE(PG8_SB(0, 1), b2 + hstep, voffB);
            PG8_WAIT_V(6); PG8_BAR; PG8_MMA(1, 1, At, B1); PG8_BAR;
            PG8_LDB(B0, 1, 0); PG8_SCHED; PG8_LDA(At, 1, 0); PG8_STAGE(PG8_SA(0, 1), a2 + hstep, voffA);
            PG8_WAIT_L(8); PG8_BAR; PG8_WAIT_L(0); PG8_MMA(0, 0, At, B0); PG8_BAR; PG8_SCHED;
            PG8_LDB(B1, 1, 1); PG8_STAGE(PG8_SB(1, 0), b3, voffB);
            PG8_BAR; PG8_WAIT_L(0); PG8_MMA(0, 1, At, B1); PG8_BAR;
            PG8_LDA(At, 1, 1); PG8_STAGE(PG8_SA(1, 0), a3, voffA);
            PG8_BAR; PG8_WAIT_L(0); PG8_MMA(1, 0, At, B0); PG8_BAR; PG8_SCHED;
            PG8_STAGE(PG8_SB(1, 1), b3 + hstep, voffB);
            PG8_WAIT_V(6); PG8_BAR; PG8_MMA(1, 1, At, B1); PG8_BAR;
            }
        }
        if constexpr (ALIGN_EPI) { if (wr == 0) PG8_BAR; }
        if constexpr (!Epi::AFTER_DRAIN) { E(acc, cur, wr, wc, fr, fq); S.done(cur); }
        if (!has_next) break;
#pragma unroll
        for (int a = 0; a < 2; ++a)
#pragma unroll
            for (int b = 0; b < 2; ++b)
#pragma unroll
                for (int m = 0; m < 4; ++m)
#pragma unroll
                    for (int n = 0; n < 2; ++n) acc[a][b][m][n] = (f32x4){0.f, 0.f, 0.f, 0.f};
        cur = nxt; cA = nA; cB = nB; ++ui;
        if constexpr (ALIGN_EPI) { if (wr == 1) PG8_BAR; }
    }
    PG8_WAIT_V(0);
    if constexpr (!ALIGN_EPI) { if (wr == 0) PG8_BAR; }
    PG8_BAR;
    if constexpr (Epi::AFTER_DRAIN) { E.fused(acc, cur, wr, wc, fr, fq, lds, wid, lane); S.done(cur); }
#undef PG8_SA
#undef PG8_SB
#undef PG8_STAGE
#undef PG8_LDA
#undef PG8_LDB
#undef PG8_MMA
#undef PG8_WAIT_V
#undef PG8_WAIT_L
#undef PG8_BAR
#undef PG8_SCHED
}
}
#define GAS __attribute__((address_space(1)))
#define LAS __attribute__((address_space(3)))
typedef unsigned short bf16;
typedef unsigned v4u __attribute__((ext_vector_type(4)));
typedef float f32x4 __attribute__((ext_vector_type(4)));
typedef short bf16x8 __attribute__((ext_vector_type(8)));
typedef GAS unsigned gu32;
typedef GAS unsigned long long gu64;
#define RLX_AGENT __ATOMIC_RELAXED, __HIP_MEMORY_SCOPE_AGENT
#define LDS_WAIT() asm volatile("s_waitcnt lgkmcnt(0)" ::: "memory")
#define VM_WAIT() asm volatile("s_waitcnt vmcnt(0)" ::: "memory")
__device__ __forceinline__ unsigned long long rt() { return __builtin_amdgcn_s_memrealtime(); }
__device__ __forceinline__ unsigned f2bf(float f) { unsigned u = __builtin_bit_cast(unsigned, f); return (u + 0x7fffu + ((u >> 16) & 1u)) >> 16; }
__device__ __forceinline__ unsigned pk2(float lo, float hi) { return f2bf(lo) | (f2bf(hi) << 16); }
#define XB_TMO      128
#define XB_XCNT(j)  (256  + 64 * (j))
#define XB_XSUB(j)  (1280 + 64 * (j))
#define XB_XGEN(j)  (2304 + 64 * (j))
#define XB_TOP      3328
#define XB_TOPGEN   3392
#define XCD_BAR_WORDS 3456
#define XB_SPIN_CAP (1u << 18)

__device__ __forceinline__ unsigned xb_ld(unsigned* p)              { return __hip_atomic_load(p, __ATOMIC_RELAXED, __HIP_MEMORY_SCOPE_AGENT); }
__device__ __forceinline__ unsigned xb_add(unsigned* p, unsigned v) { return __hip_atomic_fetch_add(p, v, __ATOMIC_RELAXED, __HIP_MEMORY_SCOPE_AGENT); }
__device__ __forceinline__ unsigned xb_xcc_id() { return (unsigned)__builtin_amdgcn_s_getreg((3 << 11) | 20) & 0xFu; }
#define XB_SPIN(cond, bar) do { unsigned _sp = 0; while (cond) { __builtin_amdgcn_s_sleep(1); \
    if ((++_sp & 255u) == 0u) { if (xb_ld(&(bar)[XB_TMO])) break; if (_sp > XB_SPIN_CAP) { atomicAdd(&(bar)[XB_TMO], 1u); break; } } } } while (0)

struct XcdBarrier {
    unsigned* bar; unsigned x;
    volatile LAS unsigned* st;
};

__device__ __forceinline__ XcdBarrier xcd_barrier_post(unsigned* bar, volatile LAS unsigned* st) {
    XcdBarrier b; b.bar = bar; b.x = xb_xcc_id(); b.st = st;
    if (threadIdx.x == 0) (void)xb_add(&bar[XB_XCNT(b.x)], 1u);
    return b;
}
__device__ __forceinline__ void xcd_barrier_complete(unsigned* bar, unsigned x, unsigned& nloc, unsigned& nx) {
    const unsigned G = gridDim.x * gridDim.y * gridDim.z;
    unsigned sum, cnt, mine, sp = 0u;
    for (;;) {
        sum = 0u; cnt = 0u; mine = 0u;
#pragma unroll
        for (unsigned j = 0; j < 16; ++j) { const unsigned c = xb_ld(&bar[XB_XCNT(j)]); sum += c; cnt += (c > 0u) ? 1u : 0u; mine = (j == x) ? c : mine; }
        if (sum == G) break;
        __builtin_amdgcn_s_sleep(1);
        if ((++sp & 255u) == 0u) { if (xb_ld(&bar[XB_TMO])) break; if (sp > XB_SPIN_CAP) { atomicAdd(&bar[XB_TMO], 1u); break; } }
    }
    nloc = mine > 0u ? mine : 1u; nx = cnt > 0u ? cnt : 1u;
}

__device__ __forceinline__ void xcd_barrier(const XcdBarrier& b) {
    asm volatile("s_waitcnt vmcnt(0)" ::: "memory");
    __syncthreads();
    if (threadIdx.x == 0) {
        unsigned* bar = b.bar;
        __builtin_amdgcn_s_waitcnt(0);
        unsigned nloc = b.st[0], nx = b.st[1];
        if (nloc == 0u) { xcd_barrier_complete(bar, b.x, nloc, nx); b.st[0] = nloc; b.st[1] = nx; }
        const unsigned old = xb_add(&bar[XB_XSUB(b.x)], 1u);
        const unsigned gen = old / nloc;
        if (old + 1u == (gen + 1u) * nloc) {
            __builtin_amdgcn_fence(__ATOMIC_RELEASE, "agent");
            asm volatile("s_waitcnt vmcnt(0)" ::: "memory");
            const unsigned og = xb_add(&bar[XB_TOP], 1u);
            const unsigned tg = og / nx;
            if (og + 1u == (tg + 1u) * nx) xb_add(&bar[XB_TOPGEN], 1u);
            else XB_SPIN(xb_ld(&bar[XB_TOPGEN]) == tg, bar);
            __builtin_amdgcn_fence(__ATOMIC_ACQUIRE, "agent");
            xb_add(&bar[XB_XGEN(b.x)], 1u);
            asm volatile("s_waitcnt vmcnt(0)" ::: "memory");
        } else {
            XB_SPIN(xb_ld(&bar[XB_XGEN(b.x)]) == gen, bar);
            __builtin_amdgcn_fence(__ATOMIC_ACQUIRE, "agent");
            asm volatile("s_waitcnt vmcnt(0)" ::: "memory");
        }
    }
    __syncthreads();
}
typedef float f32x16 __attribute__((ext_vector_type(16)));
typedef unsigned u32x2 __attribute__((ext_vector_type(2)));
typedef short s16x4 __attribute__((ext_vector_type(4)));
typedef unsigned u32x4 __attribute__((ext_vector_type(4)));
__device__ __forceinline__ float bf2f(unsigned h) { return __builtin_bit_cast(float, h << 16); }

constexpr int NWAVES = 8, NTHR = 512;
constexpr int BATCH = 2, SEQ = 8192, DM = 2048, M = BATCH * SEQ, DEPTH = 4, DFF = 5632;
constexpr int FOX_H = 16, FOX_D = 128, FOX_IN = 6160, FOX_N = 6144;
constexpr int SWA_D = 64, SWA_HQ = 32, SWA_HK = 8, SWA_N = 3072;
constexpr int SGU_N = 4096;
constexpr float EPS = 1e-6f, LOG2E = 1.4426950408889634f;
constexpr float FOX_QSCALE = 0.08838834764831845f * LOG2E;
constexpr float SWA_QSCALE = 0.125f * LOG2E;
constexpr int MOD_KS = 32;

constexpr size_t MiB = 1u << 20;
constexpr size_t WS_CTL = 0, CTL_ZERO_BYTES = 1 * MiB;
constexpr size_t WS_VEC = 1 * MiB;
constexpr size_t WS_ROPE = 2 * MiB;
constexpr size_t WS_WFG = 3 * MiB;
constexpr size_t WS_WSM = 3 * MiB + 512 * 1024;
constexpr size_t WS_LOGF = 4 * MiB;
constexpr size_t WS_CUM = 5 * MiB;
constexpr size_t WS_YSTAT = 6 * MiB;
constexpr size_t WS_VSTAT = 8 * MiB;
constexpr size_t WS_MODP = 12 * MiB;
constexpr size_t WS_WGU = 24 * MiB, WGU_BYTES = 44 * MiB;
constexpr size_t WS_WDN = 200 * MiB, WDN_BYTES = 22 * MiB;
constexpr size_t WS_WFOXIN = 288 * MiB, WFOXIN_BYTES = 24 * MiB;
constexpr size_t WS_WFOXOUT = 336 * MiB, WSQ_BYTES = 8 * MiB;
constexpr size_t WS_WSGUIN = 352 * MiB, WS_WSGUOUT = 368 * MiB, WS_WSWAIN = 376 * MiB, WS_WSWAOUT = 388 * MiB;
constexpr size_t WS_H = 396 * MiB;
constexpr size_t WS_PROJ = 460 * MiB;
constexpr size_t WS_O = 652 * MiB;
constexpr size_t WS_Y = 716 * MiB;
constexpr size_t WS_XA = 780 * MiB;
constexpr size_t WS_END = 908 * MiB;
constexpr int CW_TMO = 0, CW_CODE = 1, CW_BAR = 4096, CW_ERR = 8192, CW_ERRV = 8193, CW_NCHK = 8194;

constexpr int RING_BYTES = 131072, LDSCTL_OFF = RING_BYTES, MISC_OFF = LDSCTL_OFF + 320, LDS_BYTES = 147456;

struct Args { const float* in[23]; float* out; unsigned char* ws; int ph_lo, ph_hi; };
static_assert(sizeof(Args) == 25 * 8 + 8, "Args has no padding");

struct Frame {
    LAS unsigned char* lds;
    int tid, lane, wave, vcu, G;
};
__device__ __forceinline__ Frame launder(const Frame& Fi) { Frame F = Fi; asm volatile("" : "+v"(F.tid)); F.lane = F.tid & 63; F.wave = __builtin_amdgcn_readfirstlane(F.tid >> 6); asm volatile("" : "+s"(F.vcu)); return F; }
__device__ __forceinline__ float wave_sum(float v) {
#pragma unroll
    for (int o = 1; o < 64; o <<= 1) v += __shfl_xor(v, o);
    return v;
}
__device__ __forceinline__ float wave_max(float v) {
#pragma unroll
    for (int o = 1; o < 64; o <<= 1) v = fmaxf(v, __shfl_xor(v, o));
    return v;
}

__device__ __forceinline__ void p0_transpose_item(const float* W, int ldw, int K, bf16* WT, int k0, int n0, int c0, LAS float* scr, int lane) {
#pragma unroll 8
    for (int i = 0; i < 32; ++i) { const int kk = 2 * i + (lane >> 5); scr[kk * 33 + (lane & 31)] = W[(size_t)(k0 + kk) * ldw + c0 + (lane & 31)]; }
    LDS_WAIT(); asm volatile("" ::: "memory");
    const int c = lane & 7;
#pragma unroll
    for (int j = 0; j < 4; ++j) { const int n = (lane >> 3) + 8 * j; const LAS float* s = scr + (8 * c) * 33 + n;
        v4u o; o.x = pk2(s[0 * 33], s[1 * 33]); o.y = pk2(s[2 * 33], s[3 * 33]); o.z = pk2(s[4 * 33], s[5 * 33]); o.w = pk2(s[6 * 33], s[7 * 33]);
        *(GAS v4u*)(WT + (size_t)(n0 + n) * K + k0 + 8 * c) = o; }
    LDS_WAIT(); asm volatile("" ::: "memory");
}
constexpr int IT_GU = 32 * 352, IT_DN = 88 * 64, IT_FOXIN = 32 * 192, IT_SQ = 32 * 64, IT_SGUIN = 32 * 128, IT_SWAIN = 32 * 96;
constexpr int IT_TOTAL = 4 * IT_GU + 4 * IT_DN + 2 * IT_FOXIN + 2 * IT_SQ + IT_SGUIN + IT_SQ + IT_SWAIN + IT_SQ;
constexpr int MOD_CHUNKS = 12288 / 256;
constexpr int IT_MOD = DEPTH * MOD_KS * MOD_CHUNKS;
__device__ __forceinline__ void conv_item(const Args& a, int r, LAS float* scr, int lane) {
    unsigned char* ws = a.ws;
    const float* W; int ldw, K, N; bf16* WT; int gu = 0;
    if (r < 4 * IT_GU) { const int l = r / IT_GU; r -= l * IT_GU; W = a.in[9] + (size_t)l * DM * 2 * DFF; ldw = 2 * DFF; K = DM; N = 2 * DFF; WT = (bf16*)(ws + WS_WGU + l * WGU_BYTES); gu = 1; }
    else { r -= 4 * IT_GU;
    if (r < 4 * IT_DN) { const int l = r / IT_DN; r -= l * IT_DN; W = a.in[10] + (size_t)l * DFF * DM; ldw = DM; K = DFF; N = DM; WT = (bf16*)(ws + WS_WDN + l * WDN_BYTES); }
    else { r -= 4 * IT_DN;
    if (r < 2 * IT_FOXIN) { const int l = r / IT_FOXIN; r -= l * IT_FOXIN; W = a.in[11] + (size_t)l * DM * FOX_IN; ldw = FOX_IN; K = DM; N = FOX_N; WT = (bf16*)(ws + WS_WFOXIN + l * WFOXIN_BYTES); }
    else { r -= 2 * IT_FOXIN;
    if (r < 2 * IT_SQ) { const int l = r / IT_SQ; r -= l * IT_SQ; W = a.in[13] + (size_t)l * DM * DM; ldw = DM; K = DM; N = DM; WT = (bf16*)(ws + WS_WFOXOUT + l * WSQ_BYTES); }
    else { r -= 2 * IT_SQ;
    if (r < IT_SGUIN) { W = a.in[14]; ldw = SGU_N; K = DM; N = SGU_N; WT = (bf16*)(ws + WS_WSGUIN); }
    else { r -= IT_SGUIN;
    if (r < IT_SQ) { W = a.in[19]; ldw = DM; K = DM; N = DM; WT = (bf16*)(ws + WS_WSGUOUT); }
    else { r -= IT_SQ;
    if (r < IT_SWAIN) { W = a.in[20]; ldw = SWA_N; K = DM; N = SWA_N; WT = (bf16*)(ws + WS_WSWAIN); }
    else { r -= IT_SWAIN; W = a.in[22]; ldw = DM; K = DM; N = DM; WT = (bf16*)(ws + WS_WSWAOUT); } } } } } } }
    const int nblk = N / 32, kb = r / nblk, nb = r % nblk, n0 = 32 * nb;
    int c0 = n0;
    if (gu) { const int tile = n0 >> 8, bj = (n0 >> 7) & 1, j = n0 & 127; c0 = bj * DFF + tile * 128 + j; }
    p0_transpose_item(W, ldw, K, WT, 64 * kb, n0, c0, scr, lane);
}
__device__ __forceinline__ void mod_item(const Args& a, int r, const LAS float* sc, int lane) {
    const int l = r / (MOD_KS * MOD_CHUNKS), ks = (r / MOD_CHUNKS) % MOD_KS, ch = r % MOD_CHUNKS;
    const float* W = a.in[3] + ((size_t)l * DM + ks * 64) * 12288 + ch * 256 + lane * 4;
    f32x4 a0 = {0.f, 0.f, 0.f, 0.f}, a1 = {0.f, 0.f, 0.f, 0.f};
#pragma unroll 8
    for (int k = 0; k < 64; ++k) { const f32x4 w = *(const f32x4*)(W + (size_t)k * 12288); const float s0 = sc[ks * 64 + k], s1 = sc[DM + ks * 64 + k]; a0 += w * s0; a1 += w * s1; }
    float* P = (float*)(a.ws + WS_MODP) + ((size_t)(l * MOD_KS + ks) * 2) * 12288 + ch * 256 + lane * 4;
    *(f32x4*)P = a0; *(f32x4*)(P + 12288) = a1;
}
__device__ __forceinline__ double sin_poly(double r) { const double r2 = r * r; return r * (1.0 + r2 * (-1.0 / 6 + r2 * (1.0 / 120 + r2 * (-1.0 / 5040 + r2 * (1.0 / 362880 + r2 * (-1.0 / 39916800 + r2 * (1.0 / 6227020800.0 + r2 * (-1.0 / 1307674368000.0)))))))); }
__device__ __forceinline__ double cos_poly(double r) { const double r2 = r * r; return 1.0 + r2 * (-0.5 + r2 * (1.0 / 24 + r2 * (-1.0 / 720 + r2 * (1.0 / 40320 + r2 * (-1.0 / 3628800 + r2 * (1.0 / 479001600.0 + r2 * (-1.0 / 87178291200.0 + r2 * (1.0 / 20922789888000.0)))))))); }
__device__ __forceinline__ void sincos_f32angle(float ang, float& c, float& s) {
    const double x = (double)ang, q = rint(x * 0.6366197723675814);
    const double r = (x - q * 1.5707963267948966) - q * 6.123233995736766e-17;
    const int n = ((int)(long long)q) & 3;
    const double sr = sin_poly(r), cr = cos_poly(r);
    const double ss = (n == 0) ? sr : (n == 1) ? cr : (n == 2) ? -sr : -cr;
    const double cc = (n == 0) ? cr : (n == 1) ? -sr : (n == 2) ? -cr : sr;
    c = (float)cc; s = (float)ss;
}
__constant__ float ROPE_INV[8] = {1.0f, 0.193922743f, 0.0376060307f, 0.00729266461f, 0.00141421356f, 0.000274248188f, 5.3182961e-05f, 1.03133862e-05f};
__device__ __forceinline__ void p0_prologue(const Frame& Fi, const Args& a) {
    Frame F = launder(Fi);
    unsigned char* ws = a.ws;
    LAS float* sc = (LAS float*)(F.lds + 8 * 8704);
    for (int i = F.tid; i < 2 * DM; i += NTHR) { const float v = a.in[1][i]; sc[i] = v / (1.0f + expf(-v)); }
    __syncthreads();
    LAS float* scr = (LAS float*)(F.lds + F.wave * 8704);
    const int gw = F.vcu * NWAVES + F.wave, NGW = F.G * NWAVES;
    for (int it = gw; it < IT_MOD + IT_TOTAL; it += NGW) { if (it < IT_MOD) mod_item(a, it, sc, F.lane); else conv_item(a, it - IT_MOD, scr, F.lane); }
    const int gt = F.vcu * NTHR + F.tid, NGT = F.G * NTHR;
    float* rope = (float*)(ws + WS_ROPE); const int* pos = (const int*)a.in[2];
    for (int i = gt; i < M * 8; i += NGT) { const int m = i >> 3, k = i & 7; const float ang = (float)pos[m] * ROPE_INV[k]; float c, s; sincos_f32angle(ang, c, s); rope[m * 16 + k] = c; rope[m * 16 + 8 + k] = s; }
    float* wfg = (float*)(ws + WS_WFG);
    for (int i = gt; i < 2 * 16 * DM; i += NGT) { const int j = i / (16 * DM), hd = (i / DM) % 16, k = i % DM; wfg[i] = a.in[11][((size_t)j * DM + k) * FOX_IN + FOX_N + hd]; }
    bf16* wsm = (bf16*)(ws + WS_WSM);
    for (int i = gt; i < 16 * 128 * 128; i += NGT) { const int t = (i >> 7) & 127, s = i & 127; wsm[i] = (bf16)(s <= t ? f2bf(a.in[17][i]) : 0u); }
}
__device__ __forceinline__ void p1_modvec(const Frame& Fi, const Args& a) {
    Frame F = launder(Fi);
    const int gt = F.vcu * NTHR + F.tid, NGT = F.G * NTHR;
    const float* modp = (const float*)(a.ws + WS_MODP); float* vec = (float*)(a.ws + WS_VEC);
    for (int i = gt; i < DEPTH * 2 * 6 * DM; i += NGT) {
        const int col = i % DM, part = (i / DM) % 6, b = (i / (6 * DM)) % 2, l = i / (12 * DM);
        float s = 0.f;
        for (int ks = 0; ks < MOD_KS; ++ks) s += modp[((size_t)(l * MOD_KS + ks) * 2 + b) * 12288 + part * DM + col];
        s += a.in[4][l * 12288 + part * DM + col];
        float v; int slot;
        if (part == 0) { v = s; slot = 1; } else if (part == 1) { v = a.in[5][l * DM + col] * (1.0f + s); slot = 0; } else if (part == 2) { v = s * a.in[6][l * DM + col]; slot = 2; }
        else if (part == 3) { v = s; slot = 4; } else if (part == 4) { v = a.in[7][l * DM + col] * (1.0f + s); slot = 3; } else { v = s * a.in[8][l * DM + col]; slot = 5; }
        vec[((size_t)(l * 2 + b) * 6 + slot) * DM + col] = v;
    }
}
__device__ __forceinline__ float log_sigmoidf(float x) { return x < 0.f ? x - log1pf(expf(x)) : -log1pf(expf(-x)); }
__device__ __forceinline__ void norm_phase(const Frame& Fi, const float* xin, float* xout, const bf16* y, const float* ystat, const float* gvec, const float* avec, const float* shvec,
                                           bf16* hout, const float* wfg, const float* bfv, float* logf) {
    Frame F = launder(Fi);
    const int lane = F.lane;
    if (wfg) { for (int i = F.tid; i < 16 * DM / 4; i += NTHR) ((LAS f32x4*)F.lds)[i] = ((const f32x4*)wfg)[i]; __syncthreads(); }
    const int gw = F.vcu * NWAVES + F.wave, NGW = F.G * NWAVES;
    int curb = -1; f32x4 av[8], sv[8], gv[8];
#pragma unroll
    for (int j = 0; j < 8; ++j) { av[j] = (f32x4){0.f, 0.f, 0.f, 0.f}; sv[j] = av[j]; gv[j] = av[j]; }
    for (int m = gw; m < M; m += NGW) {
        const int b = m >> 13;
        if (b != curb) { curb = b; const size_t vo = (size_t)b * 6 * DM;
#pragma unroll
            for (int j = 0; j < 8; ++j) { if (hout) { av[j] = ((const f32x4*)(avec + vo))[64 * j + lane]; sv[j] = ((const f32x4*)(shvec + vo))[64 * j + lane]; } if (y) gv[j] = ((const f32x4*)(gvec + vo))[64 * j + lane]; } }
        f32x4 xv[8];
        const f32x4* xr = (const f32x4*)(xin + (size_t)m * DM);
#pragma unroll
        for (int j = 0; j < 8; ++j) xv[j] = xr[64 * j + lane];
        if (y) {
            float q = lane < 32 ? ystat[(size_t)m * 32 + lane] : 0.f; q = wave_sum(q);
            const float rstdy = 1.0f / sqrtf(q * (1.0f / DM) + EPS);
            const u32x2* yr = (const u32x2*)(y + (size_t)m * DM);
#pragma unroll
            for (int j = 0; j < 8; ++j) { const u32x2 w = yr[64 * j + lane]; f32x4 yf; yf[0] = bf2f(w.x & 0xffffu); yf[1] = bf2f(w.x >> 16); yf[2] = bf2f(w.y & 0xffffu); yf[3] = bf2f(w.y >> 16);
                xv[j] += gv[j] * (yf * rstdy); }
            if (xout) { f32x4* xo = (f32x4*)(xout + (size_t)m * DM);
#pragma unroll
                for (int j = 0; j < 8; ++j) xo[64 * j + lane] = xv[j]; }
        }
        if (hout) {
            float q = 0.f;
#pragma unroll
            for (int j = 0; j < 8; ++j) q += (xv[j][0] * xv[j][0] + xv[j][1] * xv[j][1]) + (xv[j][2] * xv[j][2] + xv[j][3] * xv[j][3]);
            q = wave_sum(q);
            const float rstdx = 1.0f / sqrtf(q * (1.0f / DM) + EPS);
            u32x2* ho = (u32x2*)(hout + (size_t)m * DM);
#pragma unroll
            for (int j = 0; j < 8; ++j) { xv[j] = xv[j] * rstdx * av[j] + sv[j]; u32x2 w; w.x = pk2(xv[j][0], xv[j][1]); w.y = pk2(xv[j][2], xv[j][3]); ho[64 * j + lane] = w; }
            if (wfg) {
                float mine = 0.f;
#pragma unroll 1
                for (int hd = 0; hd < 16; ++hd) { const LAS f32x4* wr = (const LAS f32x4*)F.lds + hd * (DM / 4); float p = 0.f;
#pragma unroll
                    for (int j = 0; j < 8; ++j) { const f32x4 w = wr[64 * j + lane]; p += (xv[j][0] * w[0] + xv[j][1] * w[1]) + (xv[j][2] * w[2] + xv[j][3] * w[3]); }
                    p = wave_sum(p); if (lane == hd) mine = p; }
                if (lane < 16) logf[(size_t)(b * 16 + lane) * SEQ + (m & (SEQ - 1))] = log_sigmoidf(mine + bfv[lane]);
            }
        }
    }
    if (wfg) __syncthreads();
}
__device__ __forceinline__ void fox_scan(const Frame& Fi, const float* logf, float* cum) {
    Frame F = launder(Fi);
    if (blockIdx.x < 32) {
        const float* src = logf + (size_t)blockIdx.x * SEQ + 16 * F.tid; float* dst = cum + (size_t)blockIdx.x * SEQ + 16 * F.tid;
        f32x4 v[4];
#pragma unroll
        for (int j = 0; j < 4; ++j) v[j] = ((const f32x4*)src)[j];
        double tot = 0.0;
#pragma unroll
        for (int j = 0; j < 4; ++j) { tot += (double)v[j][0]; tot += (double)v[j][1]; tot += (double)v[j][2]; tot += (double)v[j][3]; }
        LAS double* sd = (LAS double*)F.lds;
        sd[F.tid] = tot; __syncthreads();
        if (F.tid == 0) { double run = 0.0; for (int i = 0; i < NTHR; ++i) { const double t = sd[i]; sd[i] = run; run += t; } }
        __syncthreads();
        double run = sd[F.tid];
#pragma unroll
        for (int j = 0; j < 4; ++j) { f32x4 o; run += (double)v[j][0]; o[0] = (float)run; run += (double)v[j][1]; o[1] = (float)run; run += (double)v[j][2]; o[2] = (float)run; run += (double)v[j][3]; o[3] = (float)run; ((f32x4*)dst)[j] = o; }
        __syncthreads();
    }
}
#define MFMA32(a, b, c) __builtin_amdgcn_mfma_f32_32x32x16_bf16((a), (b), (c), 0, 0, 0)
typedef short v4i16_t __attribute__((ext_vector_type(4)));
__device__ __forceinline__ s16x4 lds_tr16(const LAS unsigned char* p) { return __builtin_bit_cast(s16x4, __builtin_amdgcn_ds_read_tr16_b64_v4i16((LAS v4i16_t*)p)); }
__device__ __forceinline__ int crow(int r, int hi) { return (r & 3) + 8 * (r >> 2) + 4 * hi; }
__device__ __forceinline__ bf16x8 pack8(const f32x16& p, int s) {
    u32x4 w; w.x = pg8::cvt_pk_bf16(p[8 * s + 0], p[8 * s + 1]); w.y = pg8::cvt_pk_bf16(p[8 * s + 2], p[8 * s + 3]); w.z = pg8::cvt_pk_bf16(p[8 * s + 4], p[8 * s + 5]); w.w = pg8::cvt_pk_bf16(p[8 * s + 6], p[8 * s + 7]);
    return __builtin_bit_cast(bf16x8, w);
}
__device__ __forceinline__ bf16x8 cat44(s16x4 lo, s16x4 hi) { return (bf16x8){lo[0], lo[1], lo[2], lo[3], hi[0], hi[1], hi[2], hi[3]}; }
#define WG_BAR() do { asm volatile("s_waitcnt vmcnt(0) lgkmcnt(0)" ::: "memory"); __builtin_amdgcn_s_barrier(); asm volatile("" ::: "memory"); } while (0)

constexpr int FA_KROW = 272, FA_VROW = 320, FA_KBUF = 64 * FA_KROW, FA_VBUF = 64 * FA_VROW, FA_K0 = 0, FA_V0 = 2 * FA_KBUF, FA_B0 = FA_V0 + 2 * FA_VBUF, FA_PM0 = FA_B0 + 512, FA_RED0 = FA_PM0 + 512;
constexpr float FA_THR2 = 72.0f;
__device__ __forceinline__ void fox_attn_phase(const Frame& Fi, const bf16* P, const float* cum, bf16* O) {
    Frame F = launder(Fi);
    const int tid = F.tid, lane = F.lane, wave = F.wave, r32 = lane & 31, hi = lane >> 5;
    LAS unsigned char* lds = F.lds;
    const int bh = F.vcu >> 3, sidx = F.vcu & 7, b = bh >> 4, hd = bh & 15;
    const int srow = tid >> 3, sc16 = (tid & 7) * 16;
    const int trq = (lane & 15) >> 2, trp = lane & 3, trc = (lane >> 4) & 1;
    const size_t rowbase = (size_t)b * SEQ;
    LAS float* pmv = (LAS float*)(lds + FA_PM0); LAS float* red = (LAS float*)(lds + FA_RED0);
    {
        const bf16* Kh = P + rowbase * FOX_N + 2048 + hd * FOX_D + 8 * (lane & 15);
        float tmax = 0.f;
#pragma unroll 8
        for (int it = 0; it < 256; ++it) {
            const int key = 1024 * wave + 4 * it + (lane >> 4);
            const u32x4 x = *(const u32x4*)(Kh + (size_t)key * FOX_N); float ss = 0.f;
#pragma unroll
            for (int i = 0; i < 4; ++i) { const float lo = bf2f(x[i] & 0xffffu), h2 = bf2f(x[i] >> 16); ss += lo * lo + h2 * h2; }
            ss += __shfl_xor(ss, 1); ss += __shfl_xor(ss, 2); ss += __shfl_xor(ss, 4); ss += __shfl_xor(ss, 8);
            tmax = fmaxf(tmax, ss);
            if ((it & 15) == 15) { tmax = fmaxf(tmax, __shfl_xor(tmax, 16)); tmax = fmaxf(tmax, __shfl_xor(tmax, 32)); if (lane == 0) pmv[16 * wave + (it >> 4)] = tmax; tmax = 0.f; }
        }
        WG_BAR();
        if (tid == 0) { float run = 0.f; for (int t = 0; t < 128; ++t) { run = fmaxf(run, pmv[t]); pmv[t] = sqrtf(run) * 1.001f; } }
        WG_BAR();
    }
#pragma unroll 1
    for (int ui = 0; ui < 4; ++ui) {
        const int qb = (ui == 0) ? sidx : (ui == 1) ? 15 - sidx : (ui == 2) ? 16 + sidx : 31 - sidx;
        const int q0 = 256 * qb, T0 = 4 * qb + 3, tw = 4 * qb + (wave >> 1);
        const int qrow = q0 + 32 * wave + r32;
        bf16x8 qf[8];
        { const bf16* qp = P + (rowbase + qrow) * FOX_N + hd * FOX_D + 8 * hi;
#pragma unroll
          for (int d0 = 0; d0 < 8; ++d0) qf[d0] = *(const bf16x8*)(qp + 16 * d0); }
        float nq;
        { float q2 = 0.f;
#pragma unroll
          for (int d0 = 0; d0 < 8; ++d0)
#pragma unroll
              for (int j = 0; j < 8; ++j) { const float v = bf2f((unsigned)(unsigned short)qf[d0][j]); q2 += v * v; }
          q2 += __shfl_xor(q2, 32); nq = sqrtf(q2) * 1.001f; }
        const float* cumh = cum + (size_t)bh * SEQ;
        const float Fref = cumh[q0];
        const bf16* Kg = P + rowbase * FOX_N + 2048 + hd * FOX_D + sc16;
        const bf16* Vg = P + rowbase * FOX_N + 4096 + hd * FOX_D + sc16;
        u32x4 kr0, kr1, vr0, vr1; float br = 0.f;
#define FA_LOAD(t) do { const size_t ro = (size_t)(64 * (t) + srow) * FOX_N; kr0 = *(const u32x4*)(Kg + ro); kr1 = *(const u32x4*)(Kg + ro + 8); vr0 = *(const u32x4*)(Vg + ro); vr1 = *(const u32x4*)(Vg + ro + 8); \
            if (tid < 64) br = cumh[64 * (t) + tid]; } while (0)
#define FA_STORE(buf) do { LAS unsigned char* kd = lds + FA_K0 + (buf) * FA_KBUF + srow * FA_KROW + sc16 * 2; *(LAS u32x4*)kd = kr0; *(LAS u32x4*)(kd + 16) = kr1; \
            LAS unsigned char* vd = lds + FA_V0 + (buf) * FA_VBUF + srow * FA_VROW + sc16 * 2; *(LAS u32x4*)vd = vr0; *(LAS u32x4*)(vd + 16) = vr1; \
            if (tid < 64) ((LAS float*)(lds + FA_B0))[(buf) * 64 + tid] = (Fref - br) * LOG2E; } while (0)
        f32x16 o[4];
#pragma unroll
        for (int d = 0; d < 4; ++d)
#pragma unroll
            for (int r = 0; r < 16; ++r) o[d][r] = 0.f;
        float mrun = -INFINITY, lrun = 0.f;
        FA_LOAD(T0); FA_STORE(0); WG_BAR();
        int cur = 0;
        const int tb = 4 * qb; float dstar = 0.f;
#define FA_COND(tt) ((Fref - cumh[64 * (tt) + 63]) * LOG2E + dstar >= -FA_THR2)
        int t = T0;
#pragma unroll 1
        for (;;) {
            const bool nxt = (t > tb) ? true : (t == tb) ? false : (t > 0 && FA_COND(t - 1));
            if (nxt) FA_LOAD(t - 1);
            if (t <= tw) {
                const LAS unsigned char* kb = lds + FA_K0 + cur * FA_KBUF + r32 * FA_KROW + 16 * hi;
                const LAS float* bb = (const LAS float*)(lds + FA_B0) + cur * 64 + 4 * hi;
                f32x16 s0, s1;
#pragma unroll
                for (int g = 0; g < 4; ++g) { const f32x4 b0 = *(const LAS f32x4*)(bb + 8 * g), b1 = *(const LAS f32x4*)(bb + 32 + 8 * g);
#pragma unroll
                    for (int i = 0; i < 4; ++i) { s0[4 * g + i] = b0[i]; s1[4 * g + i] = b1[i]; } }
#pragma unroll
                for (int d0 = 0; d0 < 8; ++d0) { const bf16x8 k0 = *(const LAS bf16x8*)(kb + 32 * d0), k1 = *(const LAS bf16x8*)(kb + 32 * FA_KROW + 32 * d0);
                    s0 = MFMA32(k0, qf[d0], s0); s1 = MFMA32(k1, qf[d0], s1); }
                if (t == tw) {
#pragma unroll
                    for (int r = 0; r < 16; ++r) { const int key = 64 * t + crow(r, hi); if (key > qrow) s0[r] = -INFINITY; if (key + 32 > qrow) s1[r] = -INFINITY; }
                }
                float mx = fmaxf(s0[0], s1[0]);
#pragma unroll
                for (int r = 1; r < 16; ++r) mx = fmaxf(mx, fmaxf(s0[r], s1[r]));
                mx = fmaxf(mx, __shfl_xor(mx, 32));
                const float mnew = fmaxf(mrun, mx), alpha = __builtin_amdgcn_exp2f(mrun - mnew);
                mrun = mnew;
                float ps = 0.f;
#pragma unroll
                for (int r = 0; r < 16; ++r) { s0[r] = __builtin_amdgcn_exp2f(s0[r] - mnew); s1[r] = __builtin_amdgcn_exp2f(s1[r] - mnew); ps += s0[r] + s1[r]; }
                lrun = lrun * alpha + ps;
#pragma unroll
                for (int d = 0; d < 4; ++d)
#pragma unroll
                    for (int r = 0; r < 16; ++r) o[d][r] *= alpha;
                bf16x8 pf[4]; pf[0] = pack8(s0, 0); pf[1] = pack8(s0, 1); pf[2] = pack8(s1, 0); pf[3] = pack8(s1, 1);
                const LAS unsigned char* vb = lds + FA_V0 + cur * FA_VBUF + (4 * hi + trq) * FA_VROW + (16 * trc + 4 * trp) * 2;
#pragma unroll
                for (int ks = 0; ks < 4; ++ks) {
#pragma unroll
                    for (int d = 0; d < 4; ++d) { const s16x4 lo = lds_tr16(vb + 16 * ks * FA_VROW + 64 * d), hh = lds_tr16(vb + (16 * ks + 8) * FA_VROW + 64 * d);
                        o[d] = MFMA32(cat44(lo, hh), pf[ks], o[d]); }
                }
            }
            if (nxt) FA_STORE(cur ^ 1);
            WG_BAR();
            if (nxt) { cur ^= 1; --t; continue; }
            if (t == tb && tb > 0) {
                float val = nq * pmv[tb - 1] - mrun; val = wave_max(val);
                if (lane == 0) red[wave] = val;
                WG_BAR();
                dstar = fmaxf(fmaxf(fmaxf(red[0], red[1]), fmaxf(red[2], red[3])), fmaxf(fmaxf(red[4], red[5]), fmaxf(red[6], red[7])));
                if (!FA_COND(tb - 1)) break;
                FA_LOAD(tb - 1); FA_STORE(cur ^ 1); WG_BAR(); cur ^= 1; --t; continue;
            }
            break;
        }
#undef FA_COND
        const float ltot = lrun + __shfl_xor(lrun, 32), inv = 1.0f / ltot;
        bf16* op = O + (rowbase + qrow) * DM + hd * FOX_D + 4 * hi;
#pragma unroll
        for (int d = 0; d < 4; ++d)
#pragma unroll
            for (int g = 0; g < 4; ++g) { u32x2 w; w.x = pg8::cvt_pk_bf16(o[d][4 * g] * inv, o[d][4 * g + 1] * inv); w.y = pg8::cvt_pk_bf16(o[d][4 * g + 2] * inv, o[d][4 * g + 3] * inv);
                *(u32x2*)(op + 32 * d + 8 * g) = w; }
#undef FA_LOAD
#undef FA_STORE
    }
}
constexpr int SW_KROW = 144, SW_VROW = 192, SW_K0 = 0, SW_V0 = 256 * SW_KROW;
__device__ __forceinline__ void swa_phase(const Frame& Fi, const bf16* P, const float* rope, const float* sinks, bf16* O) {
    Frame F = launder(Fi);
    const int tid = F.tid, lane = F.lane, wave = F.wave, r32 = lane & 31, hi = lane >> 5;
    LAS unsigned char* lds = F.lds;
    const int trq = (lane & 15) >> 2, trp = lane & 3, trc = (lane >> 4) & 1;
#pragma unroll 1
    for (int u = F.vcu; u < BATCH * 64 * SWA_HK; u += F.G) {
        const int hk = u & 7, n = (u >> 3) & 63, b = u >> 9;
        const size_t blk0 = (size_t)b * SEQ + (size_t)n * 128;
#pragma unroll
        for (int it = 0; it < 2; ++it) { const int item = tid + it * NTHR, row = item >> 2, pr = item & 3;
            u32x4 k0 = {0u, 0u, 0u, 0u}, k1 = k0, v0 = k0, v1 = k0;
            if (n > 0 || row >= 128) { const size_t m = blk0 - 128 + row; const bf16* kp = P + m * SWA_N + 2048 + hk * SWA_D + 16 * pr; const bf16* vp = P + m * SWA_N + 2560 + hk * SWA_D + 16 * pr;
                k0 = *(const u32x4*)kp; k1 = *(const u32x4*)(kp + 8); v0 = *(const u32x4*)vp; v1 = *(const u32x4*)(vp + 8);
                if (pr == 0) { const f32x4* cs = (const f32x4*)(rope + m * 16); const f32x4 c0 = cs[0], c1 = cs[1], s0 = cs[2], s1 = cs[3];
                    u32x4 n0, n1;
#pragma unroll
                    for (int i = 0; i < 4; ++i) { const float c_lo = (i < 2) ? c0[2 * i] : c1[2 * i - 4], c_hi = (i < 2) ? c0[2 * i + 1] : c1[2 * i - 3], s_lo = (i < 2) ? s0[2 * i] : s1[2 * i - 4], s_hi = (i < 2) ? s0[2 * i + 1] : s1[2 * i - 3];
                        const float a_lo = bf2f(k0[i] & 0xffffu), a_hi = bf2f(k0[i] >> 16), b_lo = bf2f(k1[i] & 0xffffu), b_hi = bf2f(k1[i] >> 16);
                        n0[i] = pk2(a_lo * c_lo - b_lo * s_lo, a_hi * c_hi - b_hi * s_hi); n1[i] = pk2(b_lo * c_lo + a_lo * s_lo, b_hi * c_hi + a_hi * s_hi); }
                    k0 = n0; k1 = n1; } }
            LAS unsigned char* kd = lds + SW_K0 + row * SW_KROW + 32 * pr; *(LAS u32x4*)kd = k0; *(LAS u32x4*)(kd + 16) = k1;
            LAS unsigned char* vd = lds + SW_V0 + row * SW_VROW + 32 * pr; *(LAS u32x4*)vd = v0; *(LAS u32x4*)(vd + 16) = v1; }
        WG_BAR();
#pragma unroll 1
        for (int it = 0; it < 2; ++it) {
            const int g = wave & 3, rb = (wave >> 2) + 2 * it, hq = hk * 4 + g;
            const int qi = 32 * rb + r32; const size_t m = blk0 + qi;
            bf16x8 qf[4];
            { const bf16* qp = P + m * SWA_N + hq * SWA_D;
              const u32x4 x1 = *(const u32x4*)qp, x2 = *(const u32x4*)(qp + 8);
              const f32x4* cs = (const f32x4*)(rope + m * 16); const f32x4 c0 = cs[0], c1 = cs[1], s0 = cs[2], s1 = cs[3];
              u32x4 w;
#pragma unroll
              for (int i = 0; i < 4; ++i) { const float c_lo = (i < 2) ? c0[2 * i] : c1[2 * i - 4], c_hi = (i < 2) ? c0[2 * i + 1] : c1[2 * i - 3], s_lo = (i < 2) ? s0[2 * i] : s1[2 * i - 4], s_hi = (i < 2) ? s0[2 * i + 1] : s1[2 * i - 3];
                  const float a_lo = bf2f(x1[i] & 0xffffu), a_hi = bf2f(x1[i] >> 16), b_lo = bf2f(x2[i] & 0xffffu), b_hi = bf2f(x2[i] >> 16);
                  const float r_lo = hi ? (b_lo * c_lo + a_lo * s_lo) : (a_lo * c_lo - b_lo * s_lo), r_hi = hi ? (b_hi * c_hi + a_hi * s_hi) : (a_hi * c_hi - b_hi * s_hi);
                  w[i] = pk2(r_lo * SWA_QSCALE, r_hi * SWA_QSCALE); }
              qf[0] = __builtin_bit_cast(bf16x8, w);
#pragma unroll
              for (int d0 = 1; d0 < 4; ++d0) { const u32x4 x = *(const u32x4*)(qp + 16 * d0 + 8 * hi); u32x4 ww;
#pragma unroll
                  for (int i = 0; i < 4; ++i) ww[i] = pk2(bf2f(x[i] & 0xffffu) * SWA_QSCALE, bf2f(x[i] >> 16) * SWA_QSCALE);
                  qf[d0] = __builtin_bit_cast(bf16x8, ww); } }
            f32x16 s[5];
#pragma unroll
            for (int j = 0; j < 5; ++j) {
#pragma unroll
                for (int r = 0; r < 16; ++r) s[j][r] = 0.f;
                const LAS unsigned char* kb = lds + SW_K0 + (32 * (rb + j) + r32) * SW_KROW + 16 * hi;
#pragma unroll
                for (int d0 = 0; d0 < 4; ++d0) s[j] = MFMA32(*(const LAS bf16x8*)(kb + 32 * d0), qf[d0], s[j]);
#pragma unroll
                for (int r = 0; r < 16; ++r) { const int kk = 32 * (rb + j) + crow(r, hi), ki = kk - 128, rel = qi - ki; const bool ok = (rel >= 0) && (rel < 128) && (n * 128 + ki >= 0); if (!ok) s[j][r] = -INFINITY; }
            }
            const float sink2 = sinks[hq] * LOG2E;
            float mx = sink2;
#pragma unroll
            for (int j = 0; j < 5; ++j)
#pragma unroll
                for (int r = 0; r < 16; ++r) mx = fmaxf(mx, s[j][r]);
            mx = fmaxf(mx, __shfl_xor(mx, 32));
            float ps = 0.f;
#pragma unroll
            for (int j = 0; j < 5; ++j)
#pragma unroll
                for (int r = 0; r < 16; ++r) { s[j][r] = __builtin_amdgcn_exp2f(s[j][r] - mx); ps += s[j][r]; }
            ps += __shfl_xor(ps, 32);
            const float inv = 1.0f / (ps + __builtin_amdgcn_exp2f(sink2 - mx));
            f32x16 o[2];
#pragma unroll
            for (int d = 0; d < 2; ++d)
#pragma unroll
                for (int r = 0; r < 16; ++r) o[d][r] = 0.f;
            const LAS unsigned char* vb = lds + SW_V0 + (32 * rb + 4 * hi + trq) * SW_VROW + (16 * trc + 4 * trp) * 2;
#pragma unroll
            for (int j = 0; j < 5; ++j)
#pragma unroll
                for (int ks = 0; ks < 2; ++ks) { const bf16x8 pf = pack8(s[j], ks);
#pragma unroll
                    for (int d = 0; d < 2; ++d) { const s16x4 lo = lds_tr16(vb + (32 * j + 16 * ks) * SW_VROW + 64 * d), hh = lds_tr16(vb + (32 * j + 16 * ks + 8) * SW_VROW + 64 * d);
                        o[d] = MFMA32(cat44(lo, hh), pf, o[d]); } }
            bf16* op = O + m * DM + hq * SWA_D + 4 * hi;
#pragma unroll
            for (int d = 0; d < 2; ++d)
#pragma unroll
                for (int gq = 0; gq < 4; ++gq) { u32x2 w; w.x = pg8::cvt_pk_bf16(o[d][4 * gq] * inv, o[d][4 * gq + 1] * inv); w.y = pg8::cvt_pk_bf16(o[d][4 * gq + 2] * inv, o[d][4 * gq + 3] * inv);
                    *(u32x2*)(op + 32 * d + 8 * gq) = w; }
        }
        WG_BAR();
    }
}
constexpr int SG_VROW = 320, SG_V0 = 0, SG_ST = 128 * SG_VROW;
__device__ __forceinline__ void sgu_phase(const Frame& Fi, const bf16* P, const float* vstat, const float* lng, const float* lnb, const bf16* wsm, const float* bs, bf16* O) {
    Frame F = launder(Fi);
    const int tid = F.tid, lane = F.lane, wave = F.wave, r32 = lane & 31, hi = lane >> 5;
    LAS unsigned char* lds = F.lds;
    const int trq = (lane & 15) >> 2, trp = lane & 3, trc = (lane >> 4) & 1;
    LAS float* rst = (LAS float*)(lds + SG_ST);
#pragma unroll 1
    for (int u = F.vcu; u < BATCH * 64 * 16; u += F.G) {
        const int g = u & 15, ch = (u >> 4) & 63, b = u >> 10;
        const size_t m0 = (size_t)b * SEQ + (size_t)ch * 128;
        if (tid < 128) { const float* sp = vstat + (m0 + tid) * 64; float s = 0.f, q = 0.f;
#pragma unroll 8
            for (int i = 0; i < 32; ++i) { s += sp[2 * i]; q += sp[2 * i + 1]; }
            const float mean = s * (1.0f / DM), var = fmaxf(q * (1.0f / DM) - mean * mean, 0.f);
            rst[2 * tid] = mean; rst[2 * tid + 1] = 1.0f / sqrtf(var + EPS); }
        WG_BAR();
#pragma unroll
        for (int it = 0; it < 4; ++it) { const int item = tid + it * NTHR, row = item >> 4, c8 = (item & 15) * 8;
            const u32x4 x = *(const u32x4*)(P + (m0 + row) * SGU_N + 2048 + g * 128 + c8);
            const f32x4 g0 = *(const f32x4*)(lng + g * 128 + c8), g1 = *(const f32x4*)(lng + g * 128 + c8 + 4), b0 = *(const f32x4*)(lnb + g * 128 + c8), b1 = *(const f32x4*)(lnb + g * 128 + c8 + 4);
            const float mean = rst[2 * row], rstd = rst[2 * row + 1]; u32x4 w;
#pragma unroll
            for (int i = 0; i < 4; ++i) { const float ga = (i < 2) ? g0[2 * i] : g1[2 * i - 4], gb = (i < 2) ? g0[2 * i + 1] : g1[2 * i - 3], ba = (i < 2) ? b0[2 * i] : b1[2 * i - 4], bb = (i < 2) ? b0[2 * i + 1] : b1[2 * i - 3];
                w[i] = pk2((bf2f(x[i] & 0xffffu) - mean) * rstd * ga + ba, (bf2f(x[i] >> 16) - mean) * rstd * gb + bb); }
            *(LAS u32x4*)(lds + SG_V0 + row * SG_VROW + c8 * 2) = w; }
        WG_BAR();
        const int tb = wave & 3;
        const bf16* wrow = wsm + ((size_t)g * 128 + 32 * tb + r32) * 128 + 8 * hi;
#pragma unroll 1
        for (int it = 0; it < 2; ++it) { const int db = (wave >> 2) + 2 * it;
            f32x16 acc;
#pragma unroll
            for (int r = 0; r < 16; ++r) acc[r] = 0.f;
            const LAS unsigned char* vb = lds + SG_V0 + (8 * hi + trq) * SG_VROW + (32 * db + 16 * trc + 4 * trp) * 2;
#pragma unroll 1
            for (int ks = 0; ks < 2 * tb + 2; ++ks) { const bf16x8 wf = *(const bf16x8*)(wrow + 16 * ks);
                const s16x4 lo = lds_tr16(vb + 16 * ks * SG_VROW), hh = lds_tr16(vb + (16 * ks + 4) * SG_VROW);
                acc = MFMA32(cat44(lo, hh), wf, acc); }
            const int t = 32 * tb + r32; const float bias = bs[g * 128 + t];
            const bf16* up = P + (m0 + t) * SGU_N + g * 128 + 32 * db + 4 * hi; bf16* op = O + (m0 + t) * DM + g * 128 + 32 * db + 4 * hi;
#pragma unroll
            for (int gq = 0; gq < 4; ++gq) { const u32x2 uu = *(const u32x2*)(up + 8 * gq); u32x2 w;
                w.x = pg8::cvt_pk_bf16(bf2f(uu.x & 0xffffu) * (acc[4 * gq] + bias), bf2f(uu.x >> 16) * (acc[4 * gq + 1] + bias));
                w.y = pg8::cvt_pk_bf16(bf2f(uu.y & 0xffffu) * (acc[4 * gq + 2] + bias), bf2f(uu.y >> 16) * (acc[4 * gq + 3] + bias));
                *(u32x2*)(op + 8 * gq) = w; } }
        WG_BAR();
    }
}
constexpr int NPHASE = 31, PH_FINAL = 30;
__global__ void __launch_bounds__(NTHR, 2) mk_fwd(Args args) {
    extern __shared__ __attribute__((aligned(16))) unsigned char lds_raw[];
    Frame F;
    F.lds = (LAS unsigned char*)lds_raw;
    F.tid = threadIdx.x; F.lane = F.tid & 63; F.wave = __builtin_amdgcn_readfirstlane(F.tid >> 6);
    F.G = gridDim.x; { const int bx = blockIdx.x; F.vcu = (F.G % 8 == 0) ? (bx % 8) * (F.G / 8) + bx / 8 : bx; }
    unsigned char* ws = args.ws;
    gu32* ctl = (gu32*)(ws + WS_CTL);
    for (int u = F.tid; u < (LDS_BYTES - LDSCTL_OFF) / 4; u += NTHR) ((LAS unsigned*)(F.lds + LDSCTL_OFF))[u] = 0u;
    __syncthreads();
    XcdBarrier bar = xcd_barrier_post((unsigned*)(ctl + CW_BAR), (volatile LAS unsigned*)(F.lds + MISC_OFF) + 8);
    const int lo = args.ph_lo, hi = args.ph_hi;
#define IN(k) (lo <= (k) && (k) < hi)
#ifndef PROBE_REPEAT
#define PROBE_REPEAT 0
#endif
#define REP(c) _Pragma("unroll 1") for (int rep_ = 0; rep_ <= ((PROBE_REPEAT >> (c)) & 1); ++rep_)
#define SEAM(k) do { if (IN(k) && IN((k) + 1)) xcd_barrier(bar); } while (0)
    bf16* Hb = (bf16*)(ws + WS_H); bf16* Pb = (bf16*)(ws + WS_PROJ); bf16* Ob = (bf16*)(ws + WS_O); bf16* Yb = (bf16*)(ws + WS_Y);
    float* XA = (float*)(ws + WS_XA); float* ystat = (float*)(ws + WS_YSTAT); float* vstat = (float*)(ws + WS_VSTAT);
    const float* vec = (const float*)(ws + WS_VEC);
    float* logf = (float*)(ws + WS_LOGF); float* cum = (float*)(ws + WS_CUM);

    if (IN(0)) { REP(0) { p0_prologue(F, args); __syncthreads(); } } SEAM(0);
    if (IN(1)) { p1_modvec(F, args); } SEAM(1);

#pragma unroll 1
    for (int s = 0; s < 2 * DEPTH; ++s) {
        const int l = s >> 1, half = s & 1, kind = l % 3, jj = l / 3, base = 2 + 7 * l + 4 * half;
        if (IN(base)) {
            const float* xin = (s == 0 || s == 1) ? args.in[0] : (((s - 1) & 1) ? XA : args.out);
            float* xout = (s == 0) ? nullptr : ((s & 1) ? XA : args.out);
            const float* lv = vec + (size_t)l * 12 * DM;
            const float* gsrc = (s == 0) ? nullptr : (half ? lv + 2 * DM : vec + (size_t)(l - 1) * 12 * DM + 5 * DM);
            const float* av = half ? lv + 3 * DM : lv + 0 * DM; const float* sv = half ? lv + 4 * DM : lv + 1 * DM;
            const bool fox = (half == 0 && kind == 0);
            REP(1) norm_phase(F, xin, xout, s == 0 ? nullptr : Yb, ystat, gsrc, av, sv, Hb, fox ? (const float*)(ws + WS_WFG) + (size_t)jj * 16 * DM : nullptr, args.in[12] + jj * 16, logf);
        }
        SEAM(base);
        if (half == 0) {
            if (IN(base + 1)) {
                if (kind == 1) {
                    pg8::Gemm g{Hb, (const bf16*)(ws + WS_WSGUIN), M, SGU_N, DM}; pg8::StaticOrder S; S.init(M, SGU_N, F.G, (int)blockIdx.x);
                    pg8::EpiSguIn E{Pb, SGU_N, vstat};
                    REP(2) pg8::gemm_phase<pg8::EpiSguIn, pg8::StaticOrder, true, true>(F.lds, g, S, E);
                } else {
                    if (kind == 0) fox_scan(F, logf, cum);
                    const int N = kind == 0 ? FOX_N : SWA_N;
                    const bf16* Bt = kind == 0 ? (const bf16*)(ws + WS_WFOXIN + jj * WFOXIN_BYTES) : (const bf16*)(ws + WS_WSWAIN);
                    pg8::Gemm g{Hb, Bt, M, N, DM}; pg8::StaticOrder S; S.init(M, N, F.G, (int)blockIdx.x);
                    pg8::EpiProj E{Pb, N, kind == 0 ? 2048 : 0, FOX_QSCALE};
                    REP(2) pg8::gemm_phase<pg8::EpiProj, pg8::StaticOrder, true, true>(F.lds, g, S, E);
                }
            }
            SEAM(base + 1);
            if (IN(base + 2)) {
                if (kind == 0) { REP(3) fox_attn_phase(F, Pb, cum, Ob); }
                else if (kind == 1) REP(4) sgu_phase(F, Pb, vstat, args.in[15], args.in[16], (const bf16*)(ws + WS_WSM), args.in[18], Ob);
                else REP(5) swa_phase(F, Pb, (const float*)(ws + WS_ROPE), args.in[21], Ob);
            }
            SEAM(base + 2);
        } else {
            if (IN(base + 1)) {
                pg8::Gemm g{Hb, (const bf16*)(ws + WS_WGU + l * WGU_BYTES), M, 2 * DFF, DM}; pg8::StaticOrder S; S.init(M, 2 * DFF, F.G, (int)blockIdx.x);
                pg8::EpiSwiglu E{Pb, DFF};
                REP(2) pg8::gemm_phase<pg8::EpiSwiglu, pg8::StaticOrder, true, true>(F.lds, g, S, E);
            }
            SEAM(base + 1);
        }
        { const int ph = half ? base + 2 : base + 3;
          if (IN(ph)) {
              const bf16* A = half ? Pb : Ob; const int K = half ? DFF : DM;
              const bf16* Bt = half ? (const bf16*)(ws + WS_WDN + l * WDN_BYTES) : (kind == 0 ? (const bf16*)(ws + WS_WFOXOUT + jj * WSQ_BYTES) : kind == 1 ? (const bf16*)(ws + WS_WSGUOUT) : (const bf16*)(ws + WS_WSWAOUT));
              pg8::Gemm g{A, Bt, M, DM, K}; pg8::StaticOrder S; S.init(M, DM, F.G, (int)blockIdx.x);
              pg8::EpiOut E{Yb, DM, ystat};
              REP(2) pg8::gemm_phase<pg8::EpiOut, pg8::StaticOrder, true, true>(F.lds, g, S, E);
          }
          SEAM(ph); }
    }
    if (IN(PH_FINAL)) {
        const float* gsrc = vec + (size_t)3 * 12 * DM + 5 * DM;
        REP(1) norm_phase(F, XA, args.out, Yb, ystat, gsrc, nullptr, nullptr, nullptr, nullptr, nullptr, nullptr);
    }
#undef IN
#undef SEAM
}
#if DBG
static void dbg_checks(int phase, const Args& a, hipStream_t stream);
__global__ void dbg_finalize(Args a);
#endif
extern "C" void kernel_launch(void* const* d_in, const int* in_sizes, int n_in, void* d_out, int out_size, void* d_ws, size_t ws_size, hipStream_t stream) {
    static int grid = 0;
    if (grid == 0) {
        if (n_in != 23 || out_size != M * DM || ws_size < WS_END) { fprintf(stderr, "kernel_launch: unexpected shapes (n_in %d, out %d, ws %zu); nothing launched\n", n_in, out_size, ws_size); grid = -1; return; }
        int dev = 0, cus = 0, per_cu = 0;
        if (hipGetDevice(&dev) != hipSuccess || hipDeviceGetAttribute(&cus, hipDeviceAttributeMultiprocessorCount, dev) != hipSuccess) { grid = -1; return; }
        if (hipFuncSetAttribute((const void*)mk_fwd, hipFuncAttributeMaxDynamicSharedMemorySize, LDS_BYTES) != hipSuccess) { fprintf(stderr, "kernel_launch: hipFuncSetAttribute failed\n"); grid = -1; return; }
        if (hipOccupancyMaxActiveBlocksPerMultiprocessor(&per_cu, (const void*)mk_fwd, NTHR, LDS_BYTES) != hipSuccess || per_cu < 1) { fprintf(stderr, "kernel_launch: occupancy query says %d blocks per CU\n", per_cu); }
        (void)hipGetLastError();
        grid = cus;
        if (grid != 256) { fprintf(stderr, "kernel_launch: built for a 256-CU device, found %d CUs; nothing launched\n", cus); grid = -1; return; }
    }
    if (grid < 0) return;
    (void)hipMemsetAsync((char*)d_ws + WS_CTL, 0, CTL_ZERO_BYTES, stream);
    Args a{};
    for (int i = 0; i < 23; ++i) a.in[i] = (const float*)d_in[i];
    a.out = (float*)d_out; a.ws = (unsigned char*)d_ws;
#if DBG
    for (int ph = 0; ph < NPHASE; ++ph) { a.ph_lo = ph; a.ph_hi = ph + 1; hipLaunchKernelGGL(mk_fwd, dim3(grid), dim3(NTHR), LDS_BYTES, stream, a); dbg_checks(ph, a, stream); }
    hipLaunchKernelGGL(dbg_finalize, dim3(1024), dim3(256), 0, stream, a);
#else
    a.ph_lo = 0; a.ph_hi = NPHASE;
    hipLaunchKernelGGL(mk_fwd, dim3(grid), dim3(NTHR), LDS_BYTES, stream, a);
#endif
    const hipError_t le = hipPeekAtLastError();
    if (le != hipSuccess) fprintf(stderr, "kernel_launch: launch failed: %s\n", hipGetErrorName(le));
}
#if DBG
__device__ __forceinline__ void dbg_fail(unsigned char* ws, unsigned code, float val) {
    unsigned* ctl = (unsigned*)(ws + WS_CTL);
    if (atomicCAS(ctl + CW_ERR, 0u, code) == 0u) ctl[CW_ERRV] = __float_as_uint(val);
}
__device__ __forceinline__ float block_sum256(float v, float* sh) {
    const int t = threadIdx.x; sh[t] = v; __syncthreads();
    for (int o = 128; o > 0; o >>= 1) { if (t < o) sh[t] += sh[t + o]; __syncthreads(); }
    const float r = sh[0]; __syncthreads(); return r;
}
__device__ __forceinline__ float block_max256(float v, float* sh) {
    const int t = threadIdx.x; sh[t] = v; __syncthreads();
    for (int o = 128; o > 0; o >>= 1) { if (t < o) sh[t] = fmaxf(sh[t], sh[t + o]); __syncthreads(); }
    const float r = sh[0]; __syncthreads(); return r;
}
__device__ __forceinline__ unsigned hash32(unsigned x) { x ^= x >> 16; x *= 0x7feb352du; x ^= x >> 15; x *= 0x846ca68bu; x ^= x >> 16; return x; }
__device__ __forceinline__ int dbg_row(int i) { return i * 256 + ((i * 37 + 11) & 255); }

struct ChkW { const float* W; const bf16* WT; int ldw, K, N, gu; };
__global__ void chk_weights(Args a, ChkW c, unsigned code) {
    const unsigned i = blockIdx.x * blockDim.x + threadIdx.x; const unsigned h = hash32(i * 2654435761u + code);
    const int n = h % c.N, k = hash32(h) % c.K;
    int col = n; if (c.gu) { const int tile = n >> 8, bj = (n >> 7) & 1, j = n & 127; col = bj * DFF + tile * 128 + j; }
    const float w = c.W[(size_t)k * c.ldw + col], g = bf2f(c.WT[(size_t)n * c.K + k]);
    if (!(fabsf(g - w) <= 0.004f * fabsf(w) + 1e-30f)) dbg_fail(a.ws, code, (float)n);
}
__global__ void chk_tables(Args a, unsigned code) {
    const int i = blockIdx.x * blockDim.x + threadIdx.x;
    const float* wfg = (const float*)(a.ws + WS_WFG); const bf16* wsm = (const bf16*)(a.ws + WS_WSM); const float* rope = (const float*)(a.ws + WS_ROPE);
    { const int j = i / 32768, hd = (i / 2048) % 16, k = i % 2048; if (wfg[i] != a.in[11][((size_t)j * DM + k) * FOX_IN + FOX_N + hd]) dbg_fail(a.ws, code, 1.f); }
    for (int e = i; e < 16 * 128 * 128; e += 65536) { const int t = (e >> 7) & 127, s = e & 127; const float w = s <= t ? a.in[17][e] : 0.f; if (!(fabsf(bf2f(wsm[e]) - w) <= 0.004f * fabsf(w))) dbg_fail(a.ws, code, 2.f); }
    { const int m = i & (M - 1), k = (i >> 14) & 7  ; const int pos = ((const int*)a.in[2])[m]; const float ang = (float)pos * ROPE_INV[k];
      const float c = cosf(ang), s = sinf(ang); if (!(fabsf(rope[m * 16 + k] - c) < 2e-5f && fabsf(rope[m * 16 + 8 + k] - s) < 2e-5f)) dbg_fail(a.ws, code, 3.f); }
}
__global__ void chk_modvec(Args a, unsigned code) {
    const int i = blockIdx.x * blockDim.x + threadIdx.x;
    if (i >= 3072) return;
    const int l = i / 768, b = (i / 384) % 2, slot = (i / 64) % 6, col = ((i % 64) * 32 + (i * 7) % 32) % DM;
    const int part = slot == 0 ? 1 : slot == 1 ? 0 : slot == 2 ? 2 : slot == 3 ? 4 : slot == 4 ? 3 : 5;
    double s = 0.0;
    for (int k = 0; k < DM; ++k) { const double c = (double)a.in[1][b * DM + k]; s += c / (1.0 + exp(-c)) * (double)a.in[3][((size_t)l * DM + k) * 12288 + part * DM + col]; }
    s += (double)a.in[4][l * 12288 + part * DM + col];
    double v;
    if (slot == 0) v = (double)a.in[5][l * DM + col] * (1.0 + s); else if (slot == 1) v = s; else if (slot == 2) v = s * (double)a.in[6][l * DM + col];
    else if (slot == 3) v = (double)a.in[7][l * DM + col] * (1.0 + s); else if (slot == 4) v = s; else v = s * (double)a.in[8][l * DM + col];
    const float got = ((const float*)(a.ws + WS_VEC))[((size_t)(l * 2 + b) * 6 + slot) * DM + col];
    if (!(fabs((double)got - v) <= 1e-3 * fabs(v) + 1e-4)) dbg_fail(a.ws, code, (float)i);
}
struct ChkN { const float* xin; const float* xout; const bf16* y; const float* g; const float* av; const float* sv; const bf16* h; const float* wfox; const float* bf; const float* logf; };
__global__ void chk_norm(Args a, ChkN c, unsigned code) {
    __shared__ float sh[256]; __shared__ float hrow[DM];
    const int m = dbg_row(blockIdx.x), b = m >> 13, t = threadIdx.x; const size_t vo = (size_t)b * 6 * DM;
    float xn[8];
    float q = 0.f;
    if (c.y) { for (int j = 0; j < 8; ++j) { const float yv = bf2f(c.y[(size_t)m * DM + t + 256 * j]); q += yv * yv; } }
    q = block_sum256(q, sh);
    const float rstdy = 1.0f / sqrtf(q / DM + EPS);
    float e2 = 0.f, r2 = 0.f;
    for (int j = 0; j < 8; ++j) { const int col = t + 256 * j; float x = c.xin[(size_t)m * DM + col];
        if (c.y) { x += c.g[vo + col] * bf2f(c.y[(size_t)m * DM + col]) * rstdy; if (c.xout) { const float d = c.xout[(size_t)m * DM + col] - x; e2 += d * d; r2 += x * x; } }
        xn[j] = x; }
    e2 = block_sum256(e2, sh); r2 = block_sum256(r2, sh);
    if (c.y && c.xout && !(e2 <= 1e-4f * r2)) dbg_fail(a.ws, code, sqrtf(e2 / (r2 + 1e-30f)));
    if (!c.h) return;
    float qx = 0.f; for (int j = 0; j < 8; ++j) qx += xn[j] * xn[j];
    qx = block_sum256(qx, sh);
    const float rstdx = 1.0f / sqrtf(qx / DM + EPS);
    e2 = 0.f; r2 = 0.f;
    for (int j = 0; j < 8; ++j) { const int col = t + 256 * j; const float hv = xn[j] * rstdx * c.av[vo + col] + c.sv[vo + col]; hrow[col] = hv; const float d = bf2f(c.h[(size_t)m * DM + col]) - hv; e2 += d * d; r2 += hv * hv; }
    e2 = block_sum256(e2, sh); r2 = block_sum256(r2, sh);
    if (!(e2 <= 1e-4f * r2)) dbg_fail(a.ws, code + 40, sqrtf(e2 / (r2 + 1e-30f)));
    if (!c.wfox) return;
    __syncthreads();
    for (int hd = 0; hd < 16; ++hd) { float p = 0.f; for (int j = 0; j < 8; ++j) { const int k = t + 256 * j; p += hrow[k] * c.wfox[(size_t)k * FOX_IN + FOX_N + hd]; }
        p = block_sum256(p, sh);
        if (t == 0) { const float x = p + c.bf[hd]; const float ls = (float)(-log1p(exp(-(double)x))); const float got = c.logf[(size_t)(b * 16 + hd) * SEQ + (m & (SEQ - 1))];
            if (!(fabsf(got - ls) <= 5e-3f)) dbg_fail(a.ws, code + 80, got - ls); } }
}
struct ChkG { const bf16* A; const float* W; const bf16* out; const float* stat; int K, ldw, N, mode, ldo, qcols; float qscale; int pad; };
static ChkG mkG(const bf16* A, int K, const float* W, int ldw, int N, int mode, const bf16* out, int ldo, int qcols, float qscale, const float* stat) { ChkG c{}; c.A = A; c.W = W; c.out = out; c.stat = stat; c.K = K; c.ldw = ldw; c.N = N; c.mode = mode; c.ldo = ldo; c.qcols = qcols; c.qscale = qscale; c.pad = 0; return c; }
__global__ void chk_gemm(Args a, ChkG c, unsigned code) {
    __shared__ float sh[256]; __shared__ float arow[DFF];
    const int m = dbg_row(blockIdx.x), t = threadIdx.x;
    for (int k = t; k < c.K; k += 256) arow[k] = bf2f(c.A[(size_t)m * c.K + k]);
    __syncthreads();
    float e2 = 0.f, r2 = 0.f, s1 = 0.f, s2 = 0.f, emax = 0.f;
    for (int col = t; col < c.N; col += 256) {
        float d0 = 0.f, d1 = 0.f;
        for (int k = 0; k < c.K; ++k) { d0 += arow[k] * c.W[(size_t)k * c.ldw + col]; if (c.mode == 2) d1 += arow[k] * c.W[(size_t)k * c.ldw + DFF + col]; }
        float ex;
        if (c.mode == 0) ex = d0 * (col < c.qcols ? c.qscale : 1.0f);
        else if (c.mode == 1) ex = 0.5f * d0 * (1.0f + tanhf(0.7978845608028654f * (d0 + 0.044715f * d0 * d0 * d0)));
        else if (c.mode == 2) ex = d0 / (1.0f + expf(-d0)) * d1;
        else ex = d0;
        const float got = bf2f(c.out[(size_t)m * c.ldo + col]), d = got - ex; e2 += d * d; r2 += ex * ex; emax = fmaxf(emax, fabsf(d));
        if (c.mode == 3) s2 += ex * ex;
        if (c.mode == 1 && col >= 2048) { s1 += ex; s2 += ex * ex; }
    }
    e2 = block_sum256(e2, sh); r2 = block_sum256(r2, sh); emax = block_max256(emax, sh); s1 = block_sum256(s1, sh); s2 = block_sum256(s2, sh);
    const float rms = sqrtf(r2 / c.N);
    if (!(e2 <= 4e-4f * r2) || !(emax <= 0.15f * rms + 1e-6f)) dbg_fail(a.ws, code, sqrtf(e2 / (r2 + 1e-30f)));
    if (t == 0 && c.stat) {
        if (c.mode == 3) { float q = 0.f; for (int i = 0; i < 32; ++i) q += c.stat[(size_t)m * 32 + i]; if (!(fabsf(q - s2) <= 0.02f * s2)) dbg_fail(a.ws, code + 40, q / s2); }
        if (c.mode == 1) { float s = 0.f, q = 0.f; for (int i = 0; i < 32; ++i) { s += c.stat[((size_t)m * 32 + i) * 2]; q += c.stat[((size_t)m * 32 + i) * 2 + 1]; }
            if (!(fabsf(q - s2) <= 0.02f * s2) || !(fabsf(s - s1) <= 0.02f * fabsf(s1) + 1.0f)) dbg_fail(a.ws, code + 40, q / s2); }
    }
}
__global__ void chk_scan(Args a, unsigned code) {
    const int i = blockIdx.x * blockDim.x + threadIdx.x; if (i >= 128) return;
    const int bh = i >> 2, which = i & 3, t = which == 0 ? 0 : which == 1 ? 1000 + 13 * bh : which == 2 ? 4096 + bh : 8191;
    const float* lf = (const float*)(a.ws + WS_LOGF) + (size_t)bh * SEQ; double s = 0.0;
    for (int j = 0; j <= t; ++j) s += (double)lf[j];
    const float got = ((const float*)(a.ws + WS_CUM))[(size_t)bh * SEQ + t];
    if (!(fabs((double)got - s) <= 1e-3 + 1e-5 * fabs(s))) dbg_fail(a.ws, code, (float)((double)got - s));
}
__global__ void chk_fox(Args a, unsigned code) {
    __shared__ float sh[256]; __shared__ float sc[SEQ]; __shared__ float qv[FOX_D];
    const int bh = blockIdx.x >> 2, which = blockIdx.x & 3, b = bh >> 4, hd = bh & 15, t = threadIdx.x;
    const int i = which == 0 ? (bh % 3) : which == 1 ? 63 + 64 * (bh % 5) + (bh & 1) : which == 2 ? 3000 + 97 * bh : 8191 - (bh % 7) * 256;
    const bf16* P = (const bf16*)(a.ws + WS_PROJ); const float* cum = (const float*)(a.ws + WS_CUM) + (size_t)bh * SEQ; const size_t rb = (size_t)b * SEQ;
    if (t < FOX_D) qv[t] = bf2f(P[(rb + i) * FOX_N + hd * FOX_D + t]);
    __syncthreads();
    float mx = -INFINITY;
    for (int j = t; j <= i; j += 256) { const bf16* kp = P + (rb + j) * FOX_N + 2048 + hd * FOX_D; float d = 0.f; for (int e = 0; e < FOX_D; ++e) d += qv[e] * bf2f(kp[e]);
        d += (cum[i] - cum[j]) * LOG2E; sc[j] = d; mx = fmaxf(mx, d); }
    mx = block_max256(mx, sh);
    float l = 0.f;
    for (int j = t; j <= i; j += 256) { const float p = exp2f(sc[j] - mx); sc[j] = p; l += p; }
    l = block_sum256(l, sh);
    float e2 = 0.f, r2 = 0.f;
    if (t < FOX_D) { float o = 0.f; for (int j = 0; j <= i; ++j) o += sc[j] * bf2f(P[(rb + j) * FOX_N + 4096 + hd * FOX_D + t]); o /= l;
        const float got = bf2f(((const bf16*)(a.ws + WS_O))[(rb + i) * DM + hd * FOX_D + t]), d = got - o; e2 = d * d; r2 = o * o; }
    e2 = block_sum256(e2, sh); r2 = block_sum256(r2, sh);
    if (!(e2 <= 1e-3f * r2)) dbg_fail(a.ws, code, sqrtf(e2 / (r2 + 1e-30f)) + 10.f * which);
}
__global__ void chk_swa(Args a, unsigned code) {
    __shared__ float qv[64]; __shared__ float sc[128]; __shared__ float red[2];
    const int smp = blockIdx.x, t = threadIdx.x;
    const int b = smp & 1, hq = (smp * 5 + 3) & 31, hk = hq >> 2;
    const int i = (smp < 8) ? smp * 17 : (smp < 16) ? 127 + (smp - 8) * 128 : (smp * 131 + 29) & (SEQ - 1);
    const bf16* P = (const bf16*)(a.ws + WS_PROJ); const int* pos = (const int*)a.in[2]; const size_t rb = (size_t)b * SEQ;
    { const bf16* qp = P + (rb + i) * SWA_N + hq * SWA_D; float v = bf2f(qp[t]);
      if (t < 16) { const int k = t & 7; const float ang = (float)pos[rb + i] * ROPE_INV[k], c = cosf(ang), s = sinf(ang); const float x1 = bf2f(qp[k]), x2 = bf2f(qp[8 + k]); v = (t < 8) ? x1 * c - x2 * s : x2 * c + x1 * s; }
      qv[t] = v; }
    __syncthreads();
    const int blk = i >> 7;
    for (int jj = t; jj < 128; jj += 64) { const int j = i - jj; float d = -INFINITY;
        if (j >= 0 && j >= (blk - 1) * 128) { const bf16* kp = P + (rb + j) * SWA_N + 2048 + hk * SWA_D; d = 0.f;
            for (int e = 0; e < 64; ++e) { float kv = bf2f(kp[e]);
                if (e < 16) { const int k = e & 7; const float ang = (float)pos[rb + j] * ROPE_INV[k], c = cosf(ang), s = sinf(ang); const float x1 = bf2f(kp[k]), x2 = bf2f(kp[8 + k]); kv = (e < 8) ? x1 * c - x2 * s : x2 * c + x1 * s; }
                d += qv[e] * kv; }
            d *= 0.125f; }
        sc[jj] = d; }
    __syncthreads();
    if (t == 0) { float mx = a.in[21][hq]; for (int jj = 0; jj < 128; ++jj) mx = fmaxf(mx, sc[jj]); float l = expf(a.in[21][hq] - mx); for (int jj = 0; jj < 128; ++jj) l += expf(sc[jj] - mx); red[0] = mx; red[1] = l; }
    __syncthreads();
    float o = 0.f;
    for (int jj = 0; jj < 128; ++jj) { const int j = i - jj; if (sc[jj] > -INFINITY) o += expf(sc[jj] - red[0]) * bf2f(P[(rb + j) * SWA_N + 2560 + hk * SWA_D + t]); }
    o /= red[1];
    const float got = bf2f(((const bf16*)(a.ws + WS_O))[(rb + i) * DM + hq * SWA_D + t]);
    float e2 = (got - o) * (got - o), r2 = o * o;
    for (int of = 32; of > 0; of >>= 1) { e2 += __shfl_xor(e2, of); r2 += __shfl_xor(r2, of); }
    if (t == 0 && !(e2 <= 1e-3f * r2)) dbg_fail(a.ws, code, sqrtf(e2 / (r2 + 1e-30f)));
}
__global__ void chk_sgu(Args a, unsigned code) {
    __shared__ float mean[128], rstd[128]; __shared__ float sh[128];
    const int smp = blockIdx.x, d = threadIdx.x;
    const int g = (smp * 7 + 1) & 15, m = (smp < 4) ? smp * 128 + (smp == 0 ? 0 : 127) : (smp * 1031 + 77) & (M - 1), tt = m & 127; const size_t m0 = (size_t)(m - tt);
    const bf16* P = (const bf16*)(a.ws + WS_PROJ);
    for (int s = 0; s <= tt; ++s) { float su = 0.f, sq = 0.f; for (int c = d; c < DM; c += 128) { const float v = bf2f(P[(m0 + s) * SGU_N + 2048 + c]); su += v; sq += v * v; }
        sh[d] = su; __syncthreads(); for (int o = 64; o > 0; o >>= 1) { if (d < o) sh[d] += sh[d + o]; __syncthreads(); } const float mu = sh[0] / DM; __syncthreads();
        sh[d] = sq; __syncthreads(); for (int o = 64; o > 0; o >>= 1) { if (d < o) sh[d] += sh[d + o]; __syncthreads(); } const float var = sh[0] / DM - mu * mu; __syncthreads();
        if (d == 0) { mean[s] = mu; rstd[s] = 1.0f / sqrtf(fmaxf(var, 0.f) + EPS); } }
    __syncthreads();
    float f = 0.f; const int col = g * 128 + d;
    for (int s = 0; s <= tt; ++s) { const float vn = (bf2f(P[(m0 + s) * SGU_N + 2048 + col]) - mean[s]) * rstd[s] * a.in[15][col] + a.in[16][col]; f += a.in[17][((size_t)g * 128 + tt) * 128 + s] * vn; }
    f += a.in[18][g * 128 + tt];
    const float ex = bf2f(P[(size_t)m * SGU_N + col]) * f, got = bf2f(((const bf16*)(a.ws + WS_O))[(size_t)m * DM + col]);
    float e2 = (got - ex) * (got - ex), r2 = ex * ex;
    sh[d] = e2; __syncthreads(); for (int o = 64; o > 0; o >>= 1) { if (d < o) sh[d] += sh[d + o]; __syncthreads(); } e2 = sh[0]; __syncthreads();
    sh[d] = r2; __syncthreads(); for (int o = 64; o > 0; o >>= 1) { if (d < o) sh[d] += sh[d + o]; __syncthreads(); } r2 = sh[0];
    if (d == 0 && !(e2 <= 1e-3f * r2)) dbg_fail(a.ws, code, sqrtf(e2 / (r2 + 1e-30f)));
}
__global__ void dbg_finalize(Args a) {
    const unsigned* ctl = (const unsigned*)(a.ws + WS_CTL); const unsigned code = ctl[CW_ERR], tmo = ctl[CW_TMO] | ctl[CW_BAR + XB_TMO];
#ifdef DBG_REPORT_VALUE
    const float v = code ? 1000.f * fabsf(__uint_as_float(ctl[CW_ERRV])) : 0.f;
#else
    const float v = code ? 1000.f * (float)code : (tmo ? 999000.f : 0.f);
#endif
    if (v != 0.f) for (size_t i = (size_t)blockIdx.x * blockDim.x + threadIdx.x; i < (size_t)M * DM; i += (size_t)gridDim.x * blockDim.x) a.out[i] = v;
}
static void dbg_checks(int ph, const Args& a, hipStream_t st) {
    unsigned char* ws = a.ws; const unsigned code = (unsigned)ph + 1;
    const bf16* Hb = (const bf16*)(ws + WS_H); const bf16* Pb = (const bf16*)(ws + WS_PROJ); const bf16* Ob = (const bf16*)(ws + WS_O); const bf16* Yb = (const bf16*)(ws + WS_Y);
    const float* XA = (const float*)(ws + WS_XA); const float* vec = (const float*)(ws + WS_VEC);
    if (ph == 0) {
        for (int l = 0; l < 4; ++l) { ChkW c{a.in[9] + (size_t)l * DM * 2 * DFF, (const bf16*)(ws + WS_WGU + l * WGU_BYTES), 2 * DFF, DM, 2 * DFF, 1}; hipLaunchKernelGGL(chk_weights, dim3(64), dim3(256), 0, st, a, c, code); }
        for (int l = 0; l < 4; ++l) { ChkW c{a.in[10] + (size_t)l * DFF * DM, (const bf16*)(ws + WS_WDN + l * WDN_BYTES), DM, DFF, DM, 0}; hipLaunchKernelGGL(chk_weights, dim3(64), dim3(256), 0, st, a, c, code); }
        for (int l = 0; l < 2; ++l) { ChkW c{a.in[11] + (size_t)l * DM * FOX_IN, (const bf16*)(ws + WS_WFOXIN + l * WFOXIN_BYTES), FOX_IN, DM, FOX_N, 0}; hipLaunchKernelGGL(chk_weights, dim3(64), dim3(256), 0, st, a, c, code); }
        for (int l = 0; l < 2; ++l) { ChkW c{a.in[13] + (size_t)l * DM * DM, (const bf16*)(ws + WS_WFOXOUT + l * WSQ_BYTES), DM, DM, DM, 0}; hipLaunchKernelGGL(chk_weights, dim3(64), dim3(256), 0, st, a, c, code); }
        { ChkW c{a.in[14], (const bf16*)(ws + WS_WSGUIN), SGU_N, DM, SGU_N, 0}; hipLaunchKernelGGL(chk_weights, dim3(64), dim3(256), 0, st, a, c, code); }
        { ChkW c{a.in[19], (const bf16*)(ws + WS_WSGUOUT), DM, DM, DM, 0}; hipLaunchKernelGGL(chk_weights, dim3(64), dim3(256), 0, st, a, c, code); }
        { ChkW c{a.in[20], (const bf16*)(ws + WS_WSWAIN), SWA_N, DM, SWA_N, 0}; hipLaunchKernelGGL(chk_weights, dim3(64), dim3(256), 0, st, a, c, code); }
        { ChkW c{a.in[22], (const bf16*)(ws + WS_WSWAOUT), DM, DM, DM, 0}; hipLaunchKernelGGL(chk_weights, dim3(64), dim3(256), 0, st, a, c, code); }
        hipLaunchKernelGGL(chk_tables, dim3(256), dim3(256), 0, st, a, code + 40);
        return;
    }
    if (ph == 1) { hipLaunchKernelGGL(chk_modvec, dim3(12), dim3(256), 0, st, a, code); return; }
    if (ph == PH_FINAL) { ChkN c{XA, a.out, Yb, vec + (size_t)3 * 12 * DM + 5 * DM, nullptr, nullptr, nullptr, nullptr, nullptr, nullptr}; hipLaunchKernelGGL(chk_norm, dim3(64), dim3(256), 0, st, a, c, code); return; }
    const int r = ph - 2, l = r / 7, j = r % 7, kind = l % 3, jj = l / 3, half = j >= 4, s = 2 * l + half;
    const float* lv = vec + (size_t)l * 12 * DM;
    if (j == 0 || j == 4) {
        const float* xin = (s == 0 || s == 1) ? a.in[0] : (((s - 1) & 1) ? XA : (const float*)a.out); const float* xout = (s == 0) ? nullptr : ((s & 1) ? XA : (const float*)a.out);
        const float* gsrc = (s == 0) ? nullptr : (half ? lv + 2 * DM : vec + (size_t)(l - 1) * 12 * DM + 5 * DM);
        const bool fox = (!half && kind == 0);
        ChkN c{xin, xout, s == 0 ? nullptr : Yb, gsrc, half ? lv + 3 * DM : lv, half ? lv + 4 * DM : lv + DM, Hb, fox ? a.in[11] + (size_t)jj * DM * FOX_IN : nullptr, a.in[12] + jj * 16, (const float*)(ws + WS_LOGF)};
        hipLaunchKernelGGL(chk_norm, dim3(64), dim3(256), 0, st, a, c, code); return;
    }
    if (j == 1) {
        if (kind == 0) { hipLaunchKernelGGL(chk_scan, dim3(1), dim3(128), 0, st, a, code + 80);
            ChkG c = mkG(Hb, DM, a.in[11] + (size_t)jj * DM * FOX_IN, FOX_IN, FOX_N, 0, Pb, FOX_N, 2048, FOX_QSCALE, nullptr); hipLaunchKernelGGL(chk_gemm, dim3(64), dim3(256), 0, st, a, c, code); }
        else if (kind == 1) { ChkG c = mkG(Hb, DM, a.in[14], SGU_N, SGU_N, 1, Pb, SGU_N, 0, 1.f, (const float*)(ws + WS_VSTAT)); hipLaunchKernelGGL(chk_gemm, dim3(64), dim3(256), 0, st, a, c, code); }
        else { ChkG c = mkG(Hb, DM, a.in[20], SWA_N, SWA_N, 0, Pb, SWA_N, 0, 1.f, nullptr); hipLaunchKernelGGL(chk_gemm, dim3(64), dim3(256), 0, st, a, c, code); }
        return;
    }
    if (j == 2) { if (kind == 0) hipLaunchKernelGGL(chk_fox, dim3(128), dim3(256), 0, st, a, code); else if (kind == 1) hipLaunchKernelGGL(chk_sgu, dim3(48), dim3(128), 0, st, a, code); else hipLaunchKernelGGL(chk_swa, dim3(64), dim3(64), 0, st, a, code); return; }
    if (j == 3) { const float* W = kind == 0 ? a.in[13] + (size_t)jj * DM * DM : kind == 1 ? a.in[19] : a.in[22];
        ChkG c = mkG(Ob, DM, W, DM, DM, 3, Yb, DM, 0, 1.f, (const float*)(ws + WS_YSTAT)); hipLaunchKernelGGL(chk_gemm, dim3(64), dim3(256), 0, st, a, c, code); return; }
    if (j == 5) { ChkG c = mkG(Hb, DM, a.in[9] + (size_t)l * DM * 2 * DFF, 2 * DFF, DFF, 2, Pb, DFF, 0, 1.f, nullptr); hipLaunchKernelGGL(chk_gemm, dim3(64), dim3(256), 0, st, a, c, code); return; }
    if (j == 6) { ChkG c = mkG(Pb, DFF, a.in[10] + (size_t)l * DFF * DM, DM, DM, 3, Yb, DM, 0, 1.f, (const float*)(ws + WS_YSTAT)); hipLaunchKernelGGL(chk_gemm, dim3(64), dim3(256), 0, st, a, c, code); return; }
}
#endif
```

```cpp
#include <hip/hip_runtime.h>
#include <cstdio>
#include <cstdint>
#include <cmath>

#define PROBE_REPEAT 0
#ifndef DBG
#define DBG 0
#endif

namespace pg8 {
#define PG8_LAS __attribute__((address_space(3)))
typedef unsigned short bf16_t;
typedef short bf16x8 __attribute__((ext_vector_type(8)));
typedef float f32x4 __attribute__((ext_vector_type(4)));
typedef unsigned u32x4 __attribute__((ext_vector_type(4)));
constexpr int BM = 256, BK = 64, HALF = 128, HTB = HALF * BK * 2  , STAGE_BYTES = 8 * HTB, NXCD = 8, WGM = 8;

__host__ __device__ __forceinline__ int lds_byte(int r, int c) { const int st = (r >> 4) * 2 + (c >> 5), rr = r & 15, cc = c & 31, ob = rr * 64 + cc * 2; return st * 1024 + (ob ^ (((ob >> 9) & 1) << 5)); }
__host__ __device__ __forceinline__ void stage_rc(int b, int& R, int& C) { const int st = b / 1024, sb = b % 1024, swz = sb ^ (((sb >> 9) & 1) << 5); R = (st >> 1) * 16 + swz / 64; C = (st & 1) * 32 + (swz % 64) / 2; }
__host__ __device__ __forceinline__ int perm32(int rho) { const int n = rho >> 4, i = rho & 15; return 8 * (i >> 2) + 4 * n + (i & 3); }

struct Unit { int pm, pn; };
struct Gemm { const bf16_t* A; const bf16_t* Bt; int M, N, K; };

struct StaticOrder {
    int nM, nN, nwg, G, c;
    __host__ __device__ void init(int M, int N, int G_, int c_) { nM = M / BM; nN = N / BM; nwg = nM * nN; G = G_; c = c_; }
    __host__ __device__ bool next(int i, Unit& u) const {
        const long L = (long)i * G + c; if (L >= nwg) return false;
        int wgid = (int)L; { const int q = nwg / NXCD, r = nwg % NXCD, xcd = wgid % NXCD, off = wgid / NXCD; wgid = (xcd < r ? xcd * (q + 1) : r * (q + 1) + (xcd - r) * q) + off; }
        const int nig = WGM * nN, gid = wgid / nig, fm = gid * WGM, gsz = (nM - fm) < WGM ? (nM - fm) : WGM;
        u.pm = fm + ((wgid % nig) % gsz); u.pn = (wgid % nig) / gsz; return true;
    }
    __device__ __forceinline__ void a_ready(const Unit&) const {}
    __device__ __forceinline__ void done(const Unit&) const {}
};

__device__ __forceinline__ unsigned cvt_pk_bf16(float lo, float hi) { unsigned r; asm volatile("v_cvt_pk_bf16_f32 %0, %1, %2" : "=v"(r) : "v"(lo), "v"(hi)); return r; }
typedef float f32x2 __attribute__((ext_vector_type(2)));
typedef unsigned u32x2 __attribute__((ext_vector_type(2)));
__device__ __forceinline__ float fast_sigmoid(float x) { return __builtin_amdgcn_rcpf(1.0f + __builtin_amdgcn_exp2f(-1.4426950408889634f * x)); }
struct EpiProj {
    static constexpr bool PERM = true, AFTER_DRAIN = false;
    bf16_t* O; int ldc; int qcols; float qscale; float* knorm;
    __device__ __forceinline__ void operator()(const f32x4 (&acc)[2][2][4][2], const Unit& u, int wr, int wc, int fr, int fq) const {
        const int row0 = u.pm * BM + wr * 64 + fr, colt = u.pn * BM, col0 = colt + wc * 32 + 8 * fq;
        const float sc = colt < qcols ? qscale : 1.0f;
#pragma unroll
        for (int ai = 0; ai < 2; ++ai)
#pragma unroll
            for (int m = 0; m < 4; ++m) { bf16_t* rowp = O + (size_t)(row0 + ai * HALF + m * 16) * ldc + col0;
#pragma unroll
                for (int bj = 0; bj < 2; ++bj) { const f32x4 v0 = acc[ai][bj][m][0] * sc, v1 = acc[ai][bj][m][1] * sc;
                    u32x4 w; w.x = cvt_pk_bf16(v0[0], v0[1]); w.y = cvt_pk_bf16(v0[2], v0[3]); w.z = cvt_pk_bf16(v1[0], v1[1]); w.w = cvt_pk_bf16(v1[2], v1[3]);
                    *(u32x4*)(rowp + bj * HALF) = w; } }
        if (knorm && colt >= 2048 && colt < 4096) {
#pragma unroll
            for (int ai = 0; ai < 2; ++ai)
#pragma unroll
                for (int bj = 0; bj < 2; ++bj) { float mx = 0.f;
#pragma unroll
                    for (int m = 0; m < 4; ++m) { const f32x4 v0 = acc[ai][bj][m][0], v1 = acc[ai][bj][m][1];
                        float q = (v0[0] * v0[0] + v0[1] * v0[1]) + (v0[2] * v0[2] + v0[3] * v0[3]) + (v1[0] * v1[0] + v1[1] * v1[1]) + (v1[2] * v1[2] + v1[3] * v1[3]);
                        q += __shfl_xor(q, 16); q += __shfl_xor(q, 32); mx = fmaxf(mx, q); }
                    mx = fmaxf(mx, __shfl_xor(mx, 1)); mx = fmaxf(mx, __shfl_xor(mx, 2)); mx = fmaxf(mx, __shfl_xor(mx, 4)); mx = fmaxf(mx, __shfl_xor(mx, 8));
                    const int rowt = u.pm * BM + ai * HALF + wr * 64, bb = rowt >> 13, tile = (rowt & 8191) >> 6, head = ((colt - 2048) >> 7) + bj;
                    if (fr == 0 && fq == 0) knorm[((size_t)(bb * 16 + head) * 128 + tile) * 4 + wc] = mx; }
        }
    }
};
struct EpiSwiglu {
    static constexpr bool PERM = true, AFTER_DRAIN = false;
    bf16_t* Z; int ldz;
    __device__ __forceinline__ void operator()(const f32x4 (&acc)[2][2][4][2], const Unit& u, int wr, int wc, int fr, int fq) const {
        const int row0 = u.pm * BM + wr * 64 + fr, col0 = u.pn * HALF + wc * 32 + 8 * fq;
#pragma unroll
        for (int ai = 0; ai < 2; ++ai)
#pragma unroll
            for (int m = 0; m < 4; ++m) { bf16_t* rowp = Z + (size_t)(row0 + ai * HALF + m * 16) * ldz + col0;
                f32x4 z0, z1;
#pragma unroll
                for (int i = 0; i < 4; ++i) { const float g0 = acc[ai][0][m][0][i], g1 = acc[ai][0][m][1][i];
                    z0[i] = g0 * fast_sigmoid(g0) * acc[ai][1][m][0][i]; z1[i] = g1 * fast_sigmoid(g1) * acc[ai][1][m][1][i]; }
                u32x4 w; w.x = cvt_pk_bf16(z0[0], z0[1]); w.y = cvt_pk_bf16(z0[2], z0[3]); w.z = cvt_pk_bf16(z1[0], z1[1]); w.w = cvt_pk_bf16(z1[2], z1[3]);
                *(u32x4*)rowp = w; }
    }
};
struct EpiOut {
    static constexpr bool PERM = true, AFTER_DRAIN = false;
    bf16_t* Y; int ldc; float* stat;
    __device__ __forceinline__ void operator()(const f32x4 (&acc)[2][2][4][2], const Unit& u, int wr, int wc, int fr, int fq) const {
        const int row0 = u.pm * BM + wr * 64 + fr, col0 = u.pn * BM + wc * 32 + 8 * fq;
#pragma unroll
        for (int ai = 0; ai < 2; ++ai)
#pragma unroll
            for (int m = 0; m < 4; ++m) { const int row = row0 + ai * HALF + m * 16; bf16_t* rowp = Y + (size_t)row * ldc + col0; float q = 0.f;
#pragma unroll
                for (int bj = 0; bj < 2; ++bj) { const f32x4 v0 = acc[ai][bj][m][0], v1 = acc[ai][bj][m][1];
                    q += (v0[0] * v0[0] + v0[1] * v0[1]) + (v0[2] * v0[2] + v0[3] * v0[3]) + (v1[0] * v1[0] + v1[1] * v1[1]) + (v1[2] * v1[2] + v1[3] * v1[3]);
                    u32x4 w; w.x = cvt_pk_bf16(v0[0], v0[1]); w.y = cvt_pk_bf16(v0[2], v0[3]); w.z = cvt_pk_bf16(v1[0], v1[1]); w.w = cvt_pk_bf16(v1[2], v1[3]);
                    *(u32x4*)(rowp + bj * HALF) = w; }
                q += __shfl_xor(q, 16); q += __shfl_xor(q, 32);
                if (fq == 0) stat[(size_t)row * 32 + 4 * u.pn + wc] = q; }
    }
};
__device__ __forceinline__ float gelu_tanh_f(float x) { const float t = 1.5957691216057308f * (x + 0.044715f * x * x * x); return x * fast_sigmoid(t); }
struct EpiSguIn {
    static constexpr bool PERM = true, AFTER_DRAIN = false;
    bf16_t* O; int ldc; float* stat2;
    __device__ __forceinline__ void operator()(const f32x4 (&acc)[2][2][4][2], const Unit& u, int wr, int wc, int fr, int fq) const {
        const int row0 = u.pm * BM + wr * 64 + fr, col0 = u.pn * BM + wc * 32 + 8 * fq; const bool vhalf = u.pn >= 8;
#pragma unroll
        for (int ai = 0; ai < 2; ++ai)
#pragma unroll
            for (int m = 0; m < 4; ++m) { const int row = row0 + ai * HALF + m * 16; bf16_t* rowp = O + (size_t)row * ldc + col0; float s = 0.f, q = 0.f;
#pragma unroll
                for (int bj = 0; bj < 2; ++bj) { f32x4 v0, v1;
#pragma unroll
                    for (int i = 0; i < 4; ++i) { v0[i] = gelu_tanh_f(acc[ai][bj][m][0][i]); v1[i] = gelu_tanh_f(acc[ai][bj][m][1][i]); }
                    s += (v0[0] + v0[1]) + (v0[2] + v0[3]) + (v1[0] + v1[1]) + (v1[2] + v1[3]);
                    q += (v0[0] * v0[0] + v0[1] * v0[1]) + (v0[2] * v0[2] + v0[3] * v0[3]) + (v1[0] * v1[0] + v1[1] * v1[1]) + (v1[2] * v1[2] + v1[3] * v1[3]);
                    u32x4 w; w.x = cvt_pk_bf16(v0[0], v0[1]); w.y = cvt_pk_bf16(v0[2], v0[3]); w.z = cvt_pk_bf16(v1[0], v1[1]); w.w = cvt_pk_bf16(v1[2], v1[3]);
                    *(u32x4*)(rowp + bj * HALF) = w; }
                if (vhalf) { s += __shfl_xor(s, 16); s += __shfl_xor(s, 32); q += __shfl_xor(q, 16); q += __shfl_xor(q, 32);
                    if (fq == 0) { float* sp = stat2 + ((size_t)row * 32 + 4 * (u.pn - 8) + wc) * 2; sp[0] = s; sp[1] = q; } } }
    }
};
template <class Epi, class Sched, bool ALIGN_EPI = false, bool SP2 = false>
__device__ __forceinline__ void gemm_phase(PG8_LAS unsigned char* lds, const Gemm g, const Sched& S, const Epi& E) {
    int tid_ = threadIdx.x; asm volatile("" : "+v"(tid_));
    const int tid = tid_, wid = __builtin_amdgcn_readfirstlane(tid >> 6), lane = tid & 63, wr = wid >> 2, wc = wid & 3, fr = lane & 15, fq = lane >> 4;
    const int K = g.K, nt = K / BK;
    unsigned voffA[2], voffB[2];
#pragma unroll
    for (int i = 0; i < 2; ++i) { int R, C; stage_rc(tid * 16 + i * 8192, R, C); const int Rb = Epi::PERM ? ((R & ~31) + perm32(R & 31)) : R;
        voffA[i] = (unsigned)(R * K + C) * 2u; voffB[i] = (unsigned)(Rb * K + C) * 2u; }
    const size_t kstep = (size_t)(BK * 2);
    const size_t hstep = (size_t)HALF * K * 2;
    const size_t tstep = 2 * hstep;
    const unsigned ldsw = (unsigned)wid * 1024u;
    const int aoff = lds_byte(wr * 64 + fr, fq * 8), boff = lds_byte(wc * 32 + fr, fq * 8);
#define PG8_SA(b, h) (((b) * 2 + (h)) * HTB)
#define PG8_SB(b, h) ((4 + (b) * 2 + (h)) * HTB)
#define PG8_STAGE(bufoff, gbase, voff) do { _Pragma("unroll") for (int _i = 0; _i < 2; ++_i) \
        __builtin_amdgcn_global_load_lds((const unsigned*)((const char*)(gbase) + (voff)[_i]), (PG8_LAS unsigned*)(lds + (bufoff) + ldsw + _i * 8192), 16, 0, 0); } while (0)
#define PG8_LDA(dst, b, h) do { _Pragma("unroll") for (int m = 0; m < 4; ++m) _Pragma("unroll") for (int k = 0; k < 2; ++k) dst[m][k] = *(const PG8_LAS bf16x8*)(lds + PG8_SA(b, h) + aoff + m * 2048 + k * 1024); } while (0)
#define PG8_LDB(dst, b, h) do { _Pragma("unroll") for (int n = 0; n < 2; ++n) _Pragma("unroll") for (int k = 0; k < 2; ++k) dst[n][k] = *(const PG8_LAS bf16x8*)(lds + PG8_SB(b, h) + boff + n * 2048 + k * 1024); } while (0)
#define PG8_MMA(ai, bj, At, Bt) do { __builtin_amdgcn_s_setprio(1); _Pragma("unroll") for (int m = 0; m < 4; ++m) _Pragma("unroll") for (int n = 0; n < 2; ++n) _Pragma("unroll") for (int k = 0; k < 2; ++k) \
        acc[ai][bj][m][n] = __builtin_amdgcn_mfma_f32_16x16x32_bf16(Bt[n][k], At[m][k], acc[ai][bj][m][n], 0, 0, 0); __builtin_amdgcn_s_setprio(0); } while (0)
#define PG8_WAIT_V(n) asm volatile("s_waitcnt vmcnt(" #n ")" ::: "memory")
#define PG8_WAIT_L(n) asm volatile("s_waitcnt lgkmcnt(" #n ")" ::: "memory")
#define PG8_BAR __builtin_amdgcn_s_barrier()
#define PG8_SCHED __builtin_amdgcn_sched_barrier(0)
    Unit cur, nxt; int ui = 0;
    if (!S.next(0, cur)) return;
    f32x4 acc[2][2][4][2];
#pragma unroll
    for (int a = 0; a < 2; ++a)
#pragma unroll
        for (int b = 0; b < 2; ++b)
#pragma unroll
            for (int m = 0; m < 4; ++m)
#pragma unroll
                for (int n = 0; n < 2; ++n) acc[a][b][m][n] = (f32x4){0.f, 0.f, 0.f, 0.f};
    bf16x8 At[4][2], B0[2][2], B1[2][2];
    const char* cA = (const char*)g.A + (size_t)cur.pm * tstep; const char* cB = (const char*)g.Bt + (size_t)cur.pn * tstep;
    S.a_ready(cur);
    if constexpr (SP2) {
        PG8_STAGE(PG8_SB(0, 0), cB, voffB); PG8_STAGE(PG8_SB(0, 1), cB + hstep, voffB); PG8_STAGE(PG8_SA(0, 0), cA, voffA); PG8_STAGE(PG8_SA(0, 1), cA + hstep, voffA);
        if (wr == 1) PG8_BAR;
        PG8_WAIT_V(2); PG8_BAR;
        PG8_STAGE(PG8_SB(1, 0), cB + kstep, voffB); PG8_STAGE(PG8_SA(1, 0), cA + kstep, voffA); PG8_STAGE(PG8_SB(1, 1), cB + hstep + kstep, voffB);
        PG8_WAIT_V(6); PG8_BAR;
    } else {
        PG8_STAGE(PG8_SB(0, 0), cB, voffB); PG8_STAGE(PG8_SA(0, 0), cA, voffA); PG8_STAGE(PG8_SB(0, 1), cB + hstep, voffB); PG8_STAGE(PG8_SA(0, 1), cA + hstep, voffA);
        if (wr == 1) PG8_BAR;
        PG8_WAIT_V(4); PG8_BAR;
        PG8_STAGE(PG8_SB(1, 0), cB + kstep, voffB); PG8_STAGE(PG8_SA(1, 0), cA + kstep, voffA); PG8_STAGE(PG8_SB(1, 1), cB + hstep + kstep, voffB);
        PG8_WAIT_V(6); PG8_BAR;
    }
    for (;;) {
        const bool has_next = S.next(ui + 1, nxt);
        const char* nA = has_next ? (const char*)g.A + (size_t)nxt.pm * tstep : cA; const char* nB = has_next ? (const char*)g.Bt + (size_t)nxt.pn * tstep : cB;
        for (int t = 0; t < nt; t += 2) {
            const bool last = (t == nt - 2);
            const char* a1 = cA + (size_t)(t + 1) * kstep;
            const char* a2 = last ? nA : cA + (size_t)(t + 2) * kstep; const char* b2 = last ? nB : cB + (size_t)(t + 2) * kstep;
            const char* a3 = a2 + kstep; const char* b3 = b2 + kstep;
            if (last && has_next) S.a_ready(nxt);
            if constexpr (SP2) {
            PG8_LDB(B0, 0, 0); PG8_LDB(B1, 0, 1); PG8_SCHED; PG8_LDA(At, 0, 0); PG8_STAGE(PG8_SA(1, 1), a1 + hstep, voffA);
            PG8_WAIT_V(8); PG8_WAIT_L(0); PG8_BAR; PG8_MMA(0, 0, At, B0); PG8_MMA(0, 1, At, B1); PG8_BAR; PG8_SCHED;
            PG8_LDA(At, 0, 1); PG8_STAGE(PG8_SB(0, 0), b2, voffB); PG8_STAGE(PG8_SB(0, 1), b2 + hstep, voffB); PG8_STAGE(PG8_SA(0, 0), a2, voffA);
            PG8_WAIT_V(8); PG8_WAIT_L(0); PG8_BAR; PG8_MMA(1, 0, At, B0); PG8_MMA(1, 1, At, B1); PG8_BAR; PG8_SCHED;
            PG8_LDB(B0, 1, 0); PG8_LDB(B1, 1, 1); PG8_SCHED; PG8_LDA(At, 1, 0); PG8_STAGE(PG8_SA(0, 1), a2 + hstep, voffA);
            PG8_WAIT_V(8); PG8_WAIT_L(0); PG8_BAR; PG8_MMA(0, 0, At, B0); PG8_MMA(0, 1, At, B1); PG8_BAR; PG8_SCHED;
            PG8_LDA(At, 1, 1); PG8_STAGE(PG8_SB(1, 0), b3, voffB); PG8_STAGE(PG8_SB(1, 1), b3 + hstep, voffB); PG8_STAGE(PG8_SA(1, 0), a3, voffA);
            PG8_WAIT_V(8); PG8_WAIT_L(0); PG8_BAR; PG8_MMA(1, 0, At, B0); PG8_MMA(1, 1, At, B1); PG8_BAR; PG8_SCHED;
            } else {
            PG8_LDB(B0, 0, 0); PG8_SCHED; PG8_LDA(At, 0, 0); PG8_STAGE(PG8_SA(1, 1), a1 + hstep, voffA);
            PG8_WAIT_L(8); PG8_BAR; PG8_WAIT_L(0); PG8_MMA(0, 0, At, B0); PG8_BAR; PG8_SCHED;
            PG8_LDB(B1, 0, 1); PG8_STAGE(PG8_SB(0, 0), b2, voffB);
            PG8_BAR; PG8_WAIT_L(0); PG8_MMA(0, 1, At, B1); PG8_BAR;
            PG8_LDA(At, 0, 1); PG8_STAGE(PG8_SA(0, 0), a2, voffA);
            PG8_BAR; PG8_WAIT_L(0); PG8_MMA(1, 0, At, B0); PG8_BAR; PG8_SCHED;
            PG8_STAGE(PG8_SB(0, 1), b2 + hstep, voffB);
            PG8_WAIT_V(6); PG8_BAR; PG8_MMA(1, 1, At, B1); PG8_BAR;
            PG8_LDB(B0, 1, 0); PG8_SCHED; PG8_LDA(At, 1, 0); PG8_STAGE(PG8_SA(0, 1), a2 + hstep, voffA);
            PG8_WAIT_L(8); PG8_BAR; PG8_WAIT_L(0); PG8_MMA(0, 0, At, B0); PG8_BAR; PG8_SCHED;
            PG8_LDB(B1, 1, 1); PG8_STAGE(PG8_SB(1, 0), b3, voffB);
            PG8_BAR; PG8_WAIT_L(0); PG8_MMA(0, 1, At, B1); PG8_BAR;
            PG8_LDA(At, 1, 1); PG8_STAGE(PG8_SA(1, 0), a3, voffA);
            PG8_BAR; PG8_WAIT_L(0); PG8_MMA(1, 0, At, B0); PG8_BAR; PG8_SCHED;
            PG8_STAGE(PG8_SB(1, 1), b3 + hstep, voffB);
            PG8_WAIT_V(6); PG8_BAR; PG8_MMA(1, 1, At, B1); PG8_BAR;
            }
        }
        if constexpr (ALIGN_EPI) { if (wr == 0) PG8_BAR; }
        if constexpr (!Epi::AFTER_DRAIN) { E(acc, cur, wr, wc, fr, fq); S.done(cur); }
        if (!has_next) break;
#pragma unroll
        for (int a = 0; a < 2; ++a)
#pragma unroll
            for (int b = 0; b < 2; ++b)
#pragma unroll
                for (int m = 0; m < 4; ++m)
#pragma unroll
                    for (int n = 0; n < 2; ++n) acc[a][b][m][n] = (f32x4){0.f, 0.f, 0.f, 0.f};
        cur = nxt; cA = nA; cB = nB; ++ui;
        if constexpr (ALIGN_EPI) { if (wr == 1) PG8_BAR; }
    }
    PG8_WAIT_V(0);
    if constexpr (!ALIGN_EPI) { if (wr == 0) PG8_BAR; }
    PG8_BAR;
    if constexpr (Epi::AFTER_DRAIN) { E.fused(acc, cur, wr, wc, fr, fq, lds, wid, lane); S.done(cur); }
#undef PG8_SA
#undef PG8_SB
#undef PG8_STAGE
#undef PG8_LDA
#undef PG8_LDB
#undef PG8_MMA
#undef PG8_WAIT_V
#undef PG8_WAIT_L
#undef PG8_BAR
#undef PG8_SCHED
}
}
#define GAS __attribute__((address_space(1)))
#define LAS __attribute__((address_space(3)))
typedef unsigned short bf16;
typedef unsigned v4u __attribute__((ext_vector_type(4)));
typedef float f32x4 __attribute__((ext_vector_type(4)));
typedef short bf16x8 __attribute__((ext_vector_type(8)));
typedef GAS unsigned gu32;
typedef GAS unsigned long long gu64;
#define RLX_AGENT __ATOMIC_RELAXED, __HIP_MEMORY_SCOPE_AGENT
#define LDS_WAIT() asm volatile("s_waitcnt lgkmcnt(0)" ::: "memory")
#define VM_WAIT() asm volatile("s_waitcnt vmcnt(0)" ::: "memory")
__device__ __forceinline__ unsigned long long rt() { return __builtin_amdgcn_s_memrealtime(); }
__device__ __forceinline__ unsigned f2bf(float f) { unsigned u = __builtin_bit_cast(unsigned, f); return (u + 0x7fffu + ((u >> 16) & 1u)) >> 16; }
__device__ __forceinline__ unsigned pk2(float lo, float hi) { return f2bf(lo) | (f2bf(hi) << 16); }
#define XB_TMO      128
#define XB_XCNT(j)  (256  + 64 * (j))
#define XB_XSUB(j)  (1280 + 64 * (j))
#define XB_XGEN(j)  (2304 + 64 * (j))
#define XB_TOP      3328
#define XB_TOPGEN   3392
#define XCD_BAR_WORDS 3456
#define XB_SPIN_CAP (1u << 18)

__device__ __forceinline__ unsigned xb_ld(unsigned* p)              { return __hip_atomic_load(p, __ATOMIC_RELAXED, __HIP_MEMORY_SCOPE_AGENT); }
__device__ __forceinline__ unsigned xb_add(unsigned* p, unsigned v) { return __hip_atomic_fetch_add(p, v, __ATOMIC_RELAXED, __HIP_MEMORY_SCOPE_AGENT); }
__device__ __forceinline__ unsigned xb_xcc_id() { return (unsigned)__builtin_amdgcn_s_getreg((3 << 11) | 20) & 0xFu; }
#define XB_SPIN(cond, bar) do { unsigned _sp = 0; while (cond) { __builtin_amdgcn_s_sleep(1); \
    if ((++_sp & 255u) == 0u) { if (xb_ld(&(bar)[XB_TMO])) break; if (_sp > XB_SPIN_CAP) { atomicAdd(&(bar)[XB_TMO], 1u); break; } } } } while (0)

struct XcdBarrier {
    unsigned* bar; unsigned x;
    volatile LAS unsigned* st;
};

__device__ __forceinline__ XcdBarrier xcd_barrier_post(unsigned* bar, volatile LAS unsigned* st) {
    XcdBarrier b; b.bar = bar; b.x = xb_xcc_id(); b.st = st;
    if (threadIdx.x == 0) (void)xb_add(&bar[XB_XCNT(b.x)], 1u);
    return b;
}
__device__ __forceinline__ void xcd_barrier_complete(unsigned* bar, unsigned x, unsigned& nloc, unsigned& nx) {
    const unsigned G = gridDim.x * gridDim.y * gridDim.z;
    unsigned sum, cnt, mine, sp = 0u;
    for (;;) {
        sum = 0u; cnt = 0u; mine = 0u;
#pragma unroll
        for (unsigned j = 0; j < 16; ++j) { const unsigned c = xb_ld(&bar[XB_XCNT(j)]); sum += c; cnt += (c > 0u) ? 1u : 0u; mine = (j == x) ? c : mine; }
        if (sum == G) break;
        __builtin_amdgcn_s_sleep(1);
        if ((++sp & 255u) == 0u) { if (xb_ld(&bar[XB_TMO])) break; if (sp > XB_SPIN_CAP) { atomicAdd(&bar[XB_TMO], 1u); break; } }
    }
    nloc = mine > 0u ? mine : 1u; nx = cnt > 0u ? cnt : 1u;
}

__device__ __forceinline__ void xcd_barrier(const XcdBarrier& b) {
    asm volatile("s_waitcnt vmcnt(0)" ::: "memory");
    __syncthreads();
    if (threadIdx.x == 0) {
        unsigned* bar = b.bar;
        __builtin_amdgcn_s_waitcnt(0);
        unsigned nloc = b.st[0], nx = b.st[1];
        if (nloc == 0u) { xcd_barrier_complete(bar, b.x, nloc, nx); b.st[0] = nloc; b.st[1] = nx; }
        const unsigned old = xb_add(&bar[XB_XSUB(b.x)], 1u);
        const unsigned gen = old / nloc;
        if (old + 1u == (gen + 1u) * nloc) {
            __builtin_amdgcn_fence(__ATOMIC_RELEASE, "agent");
            asm volatile("s_waitcnt vmcnt(0)" ::: "memory");
            const unsigned og = xb_add(&bar[XB_TOP], 1u);
            const unsigned tg = og / nx;
            if (og + 1u == (tg + 1u) * nx) xb_add(&bar[XB_TOPGEN], 1u);
            else XB_SPIN(xb_ld(&bar[XB_TOPGEN]) == tg, bar);
            __builtin_amdgcn_fence(__ATOMIC_ACQUIRE, "agent");
            xb_add(&bar[XB_XGEN(b.x)], 1u);
            asm volatile("s_waitcnt vmcnt(0)" ::: "memory");
        } else {
            XB_SPIN(xb_ld(&bar[XB_XGEN(b.x)]) == gen, bar);
            __builtin_amdgcn_fence(__ATOMIC_ACQUIRE, "agent");
            asm volatile("s_waitcnt vmcnt(0)" ::: "memory");
        }
    }
    __syncthreads();
}
typedef float f32x16 __attribute__((ext_vector_type(16)));
typedef unsigned u32x2 __attribute__((ext_vector_type(2)));
typedef short s16x4 __attribute__((ext_vector_type(4)));
typedef unsigned u32x4 __attribute__((ext_vector_type(4)));
__device__ __forceinline__ float bf2f(unsigned h) { return __builtin_bit_cast(float, h << 16); }

constexpr int NWAVES = 8, NTHR = 512;
constexpr int BATCH = 2, SEQ = 8192, DM = 2048, M = BATCH * SEQ, DEPTH = 4, DFF = 5632;
constexpr int FOX_H = 16, FOX_D = 128, FOX_IN = 6160, FOX_N = 6144;
constexpr int SWA_D = 64, SWA_HQ = 32, SWA_HK = 8, SWA_N = 3072;
constexpr int SGU_N = 4096;
constexpr float EPS = 1e-6f, LOG2E = 1.4426950408889634f;
constexpr float FOX_QSCALE = 0.08838834764831845f * LOG2E;
constexpr float SWA_QSCALE = 0.125f * LOG2E;
constexpr int MOD_KS = 32;

constexpr size_t MiB = 1u << 20;
constexpr size_t WS_CTL = 0, CTL_ZERO_BYTES = 1 * MiB;
constexpr size_t WS_VEC = 1 * MiB;
constexpr size_t WS_ROPE = 2 * MiB;
constexpr size_t WS_WFG = 3 * MiB;
constexpr size_t WS_WSM = 3 * MiB + 512 * 1024;
constexpr size_t WS_LOGF = 4 * MiB;
constexpr size_t WS_CUM = 5 * MiB;
constexpr size_t WS_KNORM = 1 * MiB + 512 * 1024;
constexpr size_t WS_YSTAT = 6 * MiB;
constexpr size_t WS_VSTAT = 8 * MiB;
constexpr size_t WS_MODP = 12 * MiB;
constexpr size_t WS_WGU = 24 * MiB, WGU_BYTES = 44 * MiB;
constexpr size_t WS_WDN = 200 * MiB, WDN_BYTES = 22 * MiB;
constexpr size_t WS_WFOXIN = 288 * MiB, WFOXIN_BYTES = 24 * MiB;
constexpr size_t WS_WFOXOUT = 336 * MiB, WSQ_BYTES = 8 * MiB;
constexpr size_t WS_WSGUIN = 352 * MiB, WS_WSGUOUT = 368 * MiB, WS_WSWAIN = 376 * MiB, WS_WSWAOUT = 388 * MiB;
constexpr size_t WS_H = 396 * MiB;
constexpr size_t WS_PROJ = 460 * MiB;
constexpr size_t WS_O = 652 * MiB;
constexpr size_t WS_Y = 716 * MiB;
constexpr size_t WS_XA = 780 * MiB;
constexpr size_t WS_END = 908 * MiB;
constexpr int CW_TMO = 0, CW_CODE = 1, CW_BAR = 4096, CW_ERR = 8192, CW_ERRV = 8193, CW_NCHK = 8194, CW_TICKET = 8256;

constexpr int RING_BYTES = 131072, LDSCTL_OFF = RING_BYTES, MISC_OFF = LDSCTL_OFF + 320, LDS_BYTES = 147456;

struct Args { const float* in[23]; float* out; unsigned char* ws; int ph_lo, ph_hi; };
static_assert(sizeof(Args) == 25 * 8 + 8, "Args has no padding");

struct Frame {
    LAS unsigned char* lds;
    int tid, lane, wave, vcu, G;
};
__device__ __forceinline__ Frame launder(const Frame& Fi) { Frame F = Fi; asm volatile("" : "+v"(F.tid)); F.lane = F.tid & 63; F.wave = __builtin_amdgcn_readfirstlane(F.tid >> 6); asm volatile("" : "+s"(F.vcu)); return F; }
__device__ __forceinline__ float wave_sum(float v) {
#pragma unroll
    for (int o = 1; o < 64; o <<= 1) v += __shfl_xor(v, o);
    return v;
}
__device__ __forceinline__ float wave_max(float v) {
#pragma unroll
    for (int o = 1; o < 64; o <<= 1) v = fmaxf(v, __shfl_xor(v, o));
    return v;
}

__device__ __forceinline__ void p0_transpose_item(const float* W, int ldw, int K, bf16* WT, int k0, int n0, int c0, LAS float* scr, int lane) {
#pragma unroll 8
    for (int i = 0; i < 32; ++i) { const int kk = 2 * i + (lane >> 5); scr[kk * 33 + (lane & 31)] = W[(size_t)(k0 + kk) * ldw + c0 + (lane & 31)]; }
    LDS_WAIT(); asm volatile("" ::: "memory");
    const int c = lane & 7;
#pragma unroll
    for (int j = 0; j < 4; ++j) { const int n = (lane >> 3) + 8 * j; const LAS float* s = scr + (8 * c) * 33 + n;
        v4u o; o.x = pk2(s[0 * 33], s[1 * 33]); o.y = pk2(s[2 * 33], s[3 * 33]); o.z = pk2(s[4 * 33], s[5 * 33]); o.w = pk2(s[6 * 33], s[7 * 33]);
        *(GAS v4u*)(WT + (size_t)(n0 + n) * K + k0 + 8 * c) = o; }
    LDS_WAIT(); asm volatile("" ::: "memory");
}
constexpr int IT_GU = 32 * 352, IT_DN = 88 * 64, IT_FOXIN = 32 * 192, IT_SQ = 32 * 64, IT_SGUIN = 32 * 128, IT_SWAIN = 32 * 96;
constexpr int IT_TOTAL = 4 * IT_GU + 4 * IT_DN + 2 * IT_FOXIN + 2 * IT_SQ + IT_SGUIN + IT_SQ + IT_SWAIN + IT_SQ;
constexpr int MOD_CHUNKS = 12288 / 256;
constexpr int IT_MOD = DEPTH * MOD_KS * MOD_CHUNKS;
__device__ __forceinline__ void conv_item(const Args& a, int r, LAS float* scr, int lane) {
    unsigned char* ws = a.ws;
    const float* W; int ldw, K, N; bf16* WT; int gu = 0;
    if (r < 4 * IT_GU) { const int l = r / IT_GU; r -= l * IT_GU; W = a.in[9] + (size_t)l * DM * 2 * DFF; ldw = 2 * DFF; K = DM; N = 2 * DFF; WT = (bf16*)(ws + WS_WGU + l * WGU_BYTES); gu = 1; }
    else { r -= 4 * IT_GU;
    if (r < 4 * IT_DN) { const int l = r / IT_DN; r -= l * IT_DN; W = a.in[10] + (size_t)l * DFF * DM; ldw = DM; K = DFF; N = DM; WT = (bf16*)(ws + WS_WDN + l * WDN_BYTES); }
    else { r -= 4 * IT_DN;
    if (r < 2 * IT_FOXIN) { const int l = r / IT_FOXIN; r -= l * IT_FOXIN; W = a.in[11] + (size_t)l * DM * FOX_IN; ldw = FOX_IN; K = DM; N = FOX_N; WT = (bf16*)(ws + WS_WFOXIN + l * WFOXIN_BYTES); }
    else { r -= 2 * IT_FOXIN;
    if (r < 2 * IT_SQ) { const int l = r / IT_SQ; r -= l * IT_SQ; W = a.in[13] + (size_t)l * DM * DM; ldw = DM; K = DM; N = DM; WT = (bf16*)(ws + WS_WFOXOUT + l * WSQ_BYTES); }
    else { r -= 2 * IT_SQ;
    if (r < IT_SGUIN) { W = a.in[14]; ldw = SGU_N; K = DM; N = SGU_N; WT = (bf16*)(ws + WS_WSGUIN); }
    else { r -= IT_SGUIN;
    if (r < IT_SQ) { W = a.in[19]; ldw = DM; K = DM; N = DM; WT = (bf16*)(ws + WS_WSGUOUT); }
    else { r -= IT_SQ;
    if (r < IT_SWAIN) { W = a.in[20]; ldw = SWA_N; K = DM; N = SWA_N; WT = (bf16*)(ws + WS_WSWAIN); }
    else { r -= IT_SWAIN; W = a.in[22]; ldw = DM; K = DM; N = DM; WT = (bf16*)(ws + WS_WSWAOUT); } } } } } } }
    const int nblk = N / 32, kb = r / nblk, nb = r % nblk, n0 = 32 * nb;
    int c0 = n0;
    if (gu) { const int tile = n0 >> 8, bj = (n0 >> 7) & 1, j = n0 & 127; c0 = bj * DFF + tile * 128 + j; }
    p0_transpose_item(W, ldw, K, WT, 64 * kb, n0, c0, scr, lane);
}
__device__ __forceinline__ void mod_item(const Args& a, int r, const LAS float* sc, int lane) {
    const int l = r / (MOD_KS * MOD_CHUNKS), ks = (r / MOD_CHUNKS) % MOD_KS, ch = r % MOD_CHUNKS;
    const float* W = a.in[3] + ((size_t)l * DM + ks * 64) * 12288 + ch * 256 + lane * 4;
    f32x4 a0 = {0.f, 0.f, 0.f, 0.f}, a1 = {0.f, 0.f, 0.f, 0.f};
#pragma unroll 8
    for (int k = 0; k < 64; ++k) { const f32x4 w = *(const f32x4*)(W + (size_t)k * 12288); const float s0 = sc[ks * 64 + k], s1 = sc[DM + ks * 64 + k]; a0 += w * s0; a1 += w * s1; }
    float* P = (float*)(a.ws + WS_MODP) + ((size_t)(l * MOD_KS + ks) * 2) * 12288 + ch * 256 + lane * 4;
    *(f32x4*)P = a0; *(f32x4*)(P + 12288) = a1;
}
__device__ __forceinline__ double sin_poly(double r) { const double r2 = r * r; return r * (1.0 + r2 * (-1.0 / 6 + r2 * (1.0 / 120 + r2 * (-1.0 / 5040 + r2 * (1.0 / 362880 + r2 * (-1.0 / 39916800 + r2 * (1.0 / 6227020800.0 + r2 * (-1.0 / 1307674368000.0)))))))); }
__device__ __forceinline__ double cos_poly(double r) { const double r2 = r * r; return 1.0 + r2 * (-0.5 + r2 * (1.0 / 24 + r2 * (-1.0 / 720 + r2 * (1.0 / 40320 + r2 * (-1.0 / 3628800 + r2 * (1.0 / 479001600.0 + r2 * (-1.0 / 87178291200.0 + r2 * (1.0 / 20922789888000.0)))))))); }
__device__ __forceinline__ void sincos_f32angle(float ang, float& c, float& s) {
    const double x = (double)ang, q = rint(x * 0.6366197723675814);
    const double r = (x - q * 1.5707963267948966) - q * 6.123233995736766e-17;
    const int n = ((int)(long long)q) & 3;
    const double sr = sin_poly(r), cr = cos_poly(r);
    const double ss = (n == 0) ? sr : (n == 1) ? cr : (n == 2) ? -sr : -cr;
    const double cc = (n == 0) ? cr : (n == 1) ? -sr : (n == 2) ? -cr : sr;
    c = (float)cc; s = (float)ss;
}
__constant__ float ROPE_INV[8] = {1.0f, 0.193922743f, 0.0376060307f, 0.00729266461f, 0.00141421356f, 0.000274248188f, 5.3182961e-05f, 1.03133862e-05f};
__device__ __forceinline__ void p0_prologue(const Frame& Fi, const Args& a) {
    Frame F = launder(Fi);
    unsigned char* ws = a.ws;
    LAS float* sc = (LAS float*)(F.lds + 8 * 8704);
    for (int i = F.tid; i < 2 * DM; i += NTHR) { const float v = a.in[1][i]; sc[i] = v / (1.0f + expf(-v)); }
    __syncthreads();
    LAS float* scr = (LAS float*)(F.lds + F.wave * 8704);
    const int gw = F.vcu * NWAVES + F.wave, NGW = F.G * NWAVES;
    for (int it = gw; it < IT_MOD + IT_TOTAL; it += NGW) { if (it < IT_MOD) mod_item(a, it, sc, F.lane); else conv_item(a, it - IT_MOD, scr, F.lane); }
    const int gt = F.vcu * NTHR + F.tid, NGT = F.G * NTHR;
    float* rope = (float*)(ws + WS_ROPE); const int* pos = (const int*)a.in[2];
    for (int i = gt; i < M * 8; i += NGT) { const int m = i >> 3, k = i & 7; const float ang = (float)pos[m] * ROPE_INV[k]; float c, s; sincos_f32angle(ang, c, s); rope[m * 16 + k] = c; rope[m * 16 + 8 + k] = s; }
    float* wfg = (float*)(ws + WS_WFG);
    for (int i = gt; i < 2 * 16 * DM; i += NGT) { const int j = i / (16 * DM), hd = (i / DM) % 16, k = i % DM; wfg[i] = a.in[11][((size_t)j * DM + k) * FOX_IN + FOX_N + hd]; }
    bf16* wsm = (bf16*)(ws + WS_WSM);
    for (int i = gt; i < 16 * 128 * 128; i += NGT) { const int t = (i >> 7) & 127, s = i & 127; wsm[i] = (bf16)(s <= t ? f2bf(a.in[17][i]) : 0u); }
}
__device__ __forceinline__ void p1_modvec(const Frame& Fi, const Args& a) {
    Frame F = launder(Fi);
    const int gt = F.vcu * NTHR + F.tid, NGT = F.G * NTHR;
    const float* modp = (const float*)(a.ws + WS_MODP); float* vec = (float*)(a.ws + WS_VEC);
    for (int i = gt; i < DEPTH * 2 * 6 * DM; i += NGT) {
        const int col = i % DM, part = (i / DM) % 6, b = (i / (6 * DM)) % 2, l = i / (12 * DM);
        float s = 0.f;
        for (int ks = 0; ks < MOD_KS; ++ks) s += modp[((size_t)(l * MOD_KS + ks) * 2 + b) * 12288 + part * DM + col];
        s += a.in[4][l * 12288 + part * DM + col];
        float v; int slot;
        if (part == 0) { v = s; slot = 1; } else if (part == 1) { v = a.in[5][l * DM + col] * (1.0f + s); slot = 0; } else if (part == 2) { v = s * a.in[6][l * DM + col]; slot = 2; }
        else if (part == 3) { v = s; slot = 4; } else if (part == 4) { v = a.in[7][l * DM + col] * (1.0f + s); slot = 3; } else { v = s * a.in[8][l * DM + col]; slot = 5; }
        vec[((size_t)(l * 2 + b) * 6 + slot) * DM + col] = v;
    }
}
__device__ __forceinline__ float log_sigmoidf(float x) { return x < 0.f ? x - log1pf(expf(x)) : -log1pf(expf(-x)); }
__device__ __forceinline__ void norm_phase(const Frame& Fi, const float* xin, float* xout, const bf16* y, const float* ystat, const float* gvec, const float* avec, const float* shvec,
                                           bf16* hout, const float* wfg, const float* bfv, float* logf) {
    Frame F = launder(Fi);
    const int lane = F.lane;
    if (wfg) { for (int i = F.tid; i < 16 * DM / 4; i += NTHR) ((LAS f32x4*)F.lds)[i] = ((const f32x4*)wfg)[i]; __syncthreads(); }
    const int gw = F.vcu * NWAVES + F.wave, NGW = F.G * NWAVES;
    int curb = -1; f32x4 av[8], sv[8], gv[8];
#pragma unroll
    for (int j = 0; j < 8; ++j) { av[j] = (f32x4){0.f, 0.f, 0.f, 0.f}; sv[j] = av[j]; gv[j] = av[j]; }
    for (int m = gw; m < M; m += NGW) {
        const int b = m >> 13;
        if (b != curb) { curb = b; const size_t vo = (size_t)b * 6 * DM;
#pragma unroll
            for (int j = 0; j < 8; ++j) { if (hout) { av[j] = ((const f32x4*)(avec + vo))[64 * j + lane]; sv[j] = ((const f32x4*)(shvec + vo))[64 * j + lane]; } if (y) gv[j] = ((const f32x4*)(gvec + vo))[64 * j + lane]; } }
        f32x4 xv[8];
        const f32x4* xr = (const f32x4*)(xin + (size_t)m * DM);
#pragma unroll
        for (int j = 0; j < 8; ++j) xv[j] = xr[64 * j + lane];
        if (y) {
            float q = lane < 32 ? ystat[(size_t)m * 32 + lane] : 0.f; q = wave_sum(q);
            const float rstdy = 1.0f / sqrtf(q * (1.0f / DM) + EPS);
            const u32x2* yr = (const u32x2*)(y + (size_t)m * DM);
#pragma unroll
            for (int j = 0; j < 8; ++j) { const u32x2 w = yr[64 * j + lane]; f32x4 yf; yf[0] = bf2f(w.x & 0xffffu); yf[1] = bf2f(w.x >> 16); yf[2] = bf2f(w.y & 0xffffu); yf[3] = bf2f(w.y >> 16);
                xv[j] += gv[j] * (yf * rstdy); }
            if (xout) { f32x4* xo = (f32x4*)(xout + (size_t)m * DM);
#pragma unroll
                for (int j = 0; j < 8; ++j) xo[64 * j + lane] = xv[j]; }
        }
        if (hout) {
            float q = 0.f;
#pragma unroll
            for (int j = 0; j < 8; ++j) q += (xv[j][0] * xv[j][0] + xv[j][1] * xv[j][1]) + (xv[j][2] * xv[j][2] + xv[j][3] * xv[j][3]);
            q = wave_sum(q);
            const float rstdx = 1.0f / sqrtf(q * (1.0f / DM) + EPS);
            u32x2* ho = (u32x2*)(hout + (size_t)m * DM);
#pragma unroll
            for (int j = 0; j < 8; ++j) { xv[j] = xv[j] * rstdx * av[j] + sv[j]; u32x2 w; w.x = pk2(xv[j][0], xv[j][1]); w.y = pk2(xv[j][2], xv[j][3]); ho[64 * j + lane] = w; }
            if (wfg) {
                float mine = 0.f;
#pragma unroll 1
                for (int hd = 0; hd < 16; ++hd) { const LAS f32x4* wr = (const LAS f32x4*)F.lds + hd * (DM / 4); float p = 0.f;
#pragma unroll
                    for (int j = 0; j < 8; ++j) { const f32x4 w = wr[64 * j + lane]; p += (xv[j][0] * w[0] + xv[j][1] * w[1]) + (xv[j][2] * w[2] + xv[j][3] * w[3]); }
                    p = wave_sum(p); if (lane == hd) mine = p; }
                if (lane < 16) logf[(size_t)(b * 16 + lane) * SEQ + (m & (SEQ - 1))] = log_sigmoidf(mine + bfv[lane]);
            }
        }
    }
    if (wfg) __syncthreads();
}
__device__ __forceinline__ void fox_scan(const Frame& Fi, const float* logf, float* cum) {
    Frame F = launder(Fi);
    if (blockIdx.x < 32) {
        const float* src = logf + (size_t)blockIdx.x * SEQ + 16 * F.tid; float* dst = cum + (size_t)blockIdx.x * SEQ + 16 * F.tid;
        f32x4 v[4];
#pragma unroll
        for (int j = 0; j < 4; ++j) v[j] = ((const f32x4*)src)[j];
        double tot = 0.0;
#pragma unroll
        for (int j = 0; j < 4; ++j) { tot += (double)v[j][0]; tot += (double)v[j][1]; tot += (double)v[j][2]; tot += (double)v[j][3]; }
        LAS double* sd = (LAS double*)F.lds;
        sd[F.tid] = tot; __syncthreads();
        if (F.tid == 0) { double run = 0.0; for (int i = 0; i < NTHR; ++i) { const double t = sd[i]; sd[i] = run; run += t; } }
        __syncthreads();
        double run = sd[F.tid];
#pragma unroll
        for (int j = 0; j < 4; ++j) { f32x4 o; run += (double)v[j][0]; o[0] = (float)run; run += (double)v[j][1]; o[1] = (float)run; run += (double)v[j][2]; o[2] = (float)run; run += (double)v[j][3]; o[3] = (float)run; ((f32x4*)dst)[j] = o; }
        __syncthreads();
    }
}
#define MFMA32(a, b, c) __builtin_amdgcn_mfma_f32_32x32x16_bf16((a), (b), (c), 0, 0, 0)
typedef short v4i16_t __attribute__((ext_vector_type(4)));
__device__ __forceinline__ s16x4 lds_tr16(const LAS unsigned char* p) { return __builtin_bit_cast(s16x4, __builtin_amdgcn_ds_read_tr16_b64_v4i16((LAS v4i16_t*)p)); }
__device__ __forceinline__ int crow(int r, int hi) { return (r & 3) + 8 * (r >> 2) + 4 * hi; }
__device__ __forceinline__ bf16x8 pack8(const f32x16& p, int s) {
    u32x4 w; w.x = pg8::cvt_pk_bf16(p[8 * s + 0], p[8 * s + 1]); w.y = pg8::cvt_pk_bf16(p[8 * s + 2], p[8 * s + 3]); w.z = pg8::cvt_pk_bf16(p[8 * s + 4], p[8 * s + 5]); w.w = pg8::cvt_pk_bf16(p[8 * s + 6], p[8 * s + 7]);
    return __builtin_bit_cast(bf16x8, w);
}
__device__ __forceinline__ bf16x8 cat44(s16x4 lo, s16x4 hi) { return (bf16x8){lo[0], lo[1], lo[2], lo[3], hi[0], hi[1], hi[2], hi[3]}; }
#define WG_BAR() do { asm volatile("s_waitcnt vmcnt(0) lgkmcnt(0)" ::: "memory"); __builtin_amdgcn_s_barrier(); asm volatile("" ::: "memory"); } while (0)

constexpr int FA_KROW = 272, FA_VROW = 320, FA_KBUF = 64 * FA_KROW, FA_VBUF = 64 * FA_VROW, FA_K0 = 0, FA_V0 = 2 * FA_KBUF, FA_B0 = FA_V0 + 2 * FA_VBUF, FA_PM0 = FA_B0 + 512, FA_RED0 = FA_PM0 + 512;
constexpr float FA_THR2 = 72.0f;
__device__ __forceinline__ void fox_attn_phase(const Frame& Fi, const bf16* P, const float* cum, const float* knorm, unsigned* ticket, bf16* O) {
    Frame F = launder(Fi);
    const int tid = F.tid, lane = F.lane, wave = F.wave, r32 = lane & 31, hi = lane >> 5;
    LAS unsigned char* lds = F.lds;
    const int srow = tid >> 3, sc16 = (tid & 7) * 16;
    const int trq = (lane & 15) >> 2, trp = lane & 3, trc = (lane >> 4) & 1;
    LAS int* ordv = (LAS int*)(lds + FA_PM0); LAS float* red = (LAS float*)(lds + FA_RED0); LAS int* tk = (LAS int*)(lds + FA_RED0 + 128);
    if (tid < 32) { const float key = cum[(size_t)tid * SEQ + SEQ - 1]; int rank = 0;
        for (int h2 = 0; h2 < 32; ++h2) { const float k2 = cum[(size_t)h2 * SEQ + SEQ - 1]; rank += (k2 > key || (k2 == key && h2 < tid)) ? 1 : 0; }
        ordv[rank] = tid; }
    WG_BAR();
#pragma unroll 1
    for (;;) {
        if (tid == 0) tk[0] = (int)__hip_atomic_fetch_add(ticket, 1u, __ATOMIC_RELAXED, __HIP_MEMORY_SCOPE_AGENT);
        WG_BAR();
        const int tkv = tk[0];
        if (tkv >= 1024) break;
        const int bh = ordv[tkv >> 5], qb = 31 - (tkv & 31), b = bh >> 4, hd = bh & 15;
        const size_t rowbase = (size_t)b * SEQ;
        { float pmx = 0.f;
          if (tid < 4 * qb) { const f32x4 kn = *(const f32x4*)(knorm + ((size_t)bh * 128 + tid) * 4); pmx = (kn[0] + kn[1]) + (kn[2] + kn[3]); }
          pmx = wave_max(pmx); if (lane == 0) red[8 + wave] = pmx; }
        const int q0 = 256 * qb, T0 = 4 * qb + 3, tw = 4 * qb + (wave >> 1);
        const int qrow = q0 + 32 * wave + r32;
        bf16x8 qf[8];
        { const bf16* qp = P + (rowbase + qrow) * FOX_N + hd * FOX_D + 8 * hi;
#pragma unroll
          for (int d0 = 0; d0 < 8; ++d0) qf[d0] = *(const bf16x8*)(qp + 16 * d0); }
        float nq;
        { float q2 = 0.f;
#pragma unroll
          for (int d0 = 0; d0 < 8; ++d0)
#pragma unroll
              for (int j = 0; j < 8; ++j) { const float v = bf2f((unsigned)(unsigned short)qf[d0][j]); q2 += v * v; }
          q2 += __shfl_xor(q2, 32); nq = sqrtf(q2) * 1.001f; }
        const float* cumh = cum + (size_t)bh * SEQ;
        const float Fref = cumh[q0];
        const bf16* Kg = P + rowbase * FOX_N + 2048 + hd * FOX_D + sc16;
        const bf16* Vg = P + rowbase * FOX_N + 4096 + hd * FOX_D + sc16;
        u32x4 kr0, kr1, vr0, vr1; float br = 0.f;
#define FA_LOAD(t) do { const size_t ro = (size_t)(64 * (t) + srow) * FOX_N; kr0 = *(const u32x4*)(Kg + ro); kr1 = *(const u32x4*)(Kg + ro + 8); vr0 = *(const u32x4*)(Vg + ro); vr1 = *(const u32x4*)(Vg + ro + 8); \
            if (tid < 64) br = cumh[64 * (t) + tid]; } while (0)
#define FA_STORE(buf) do { LAS unsigned char* kd = lds + FA_K0 + (buf) * FA_KBUF + srow * FA_KROW + sc16 * 2; *(LAS u32x4*)kd = kr0; *(LAS u32x4*)(kd + 16) = kr1; \
            LAS unsigned char* vd = lds + FA_V0 + (buf) * FA_VBUF + srow * FA_VROW + sc16 * 2; *(LAS u32x4*)vd = vr0; *(LAS u32x4*)(vd + 16) = vr1; \
            if (tid < 64) ((LAS float*)(lds + FA_B0))[(buf) * 64 + tid] = (Fref - br) * LOG2E; } while (0)
        f32x16 o[4];
#pragma unroll
        for (int d = 0; d < 4; ++d)
#pragma unroll
            for (int r = 0; r < 16; ++r) o[d][r] = 0.f;
        float mrun = -INFINITY, lrun = 0.f;
        FA_LOAD(T0); FA_STORE(0); WG_BAR();
        int cur = 0;
        const int tb = 4 * qb; float dstar = 0.f;
#define FA_COND(tt) ((Fref - cumh[64 * (tt) + 63]) * LOG2E + dstar >= -FA_THR2)
        int t = T0;
#pragma unroll 1
        for (;;) {
            const bool nxt = (t > tb) ? true : (t == tb) ? false : (t > 0 && FA_COND(t - 1));
            if (nxt) FA_LOAD(t - 1);
            if (t <= tw) {
                const LAS unsigned char* kb = lds + FA_K0 + cur * FA_KBUF + r32 * FA_KROW + 16 * hi;
                const LAS float* bb = (const LAS float*)(lds + FA_B0) + cur * 64 + 4 * hi;
                f32x16 s0, s1;
#pragma unroll
                for (int g = 0; g < 4; ++g) { const f32x4 b0 = *(const LAS f32x4*)(bb + 8 * g), b1 = *(const LAS f32x4*)(bb + 32 + 8 * g);
#pragma unroll
                    for (int i = 0; i < 4; ++i) { s0[4 * g + i] = b0[i]; s1[4 * g + i] = b1[i]; } }
#pragma unroll
                for (int d0 = 0; d0 < 8; ++d0) { const bf16x8 k0 = *(const LAS bf16x8*)(kb + 32 * d0), k1 = *(const LAS bf16x8*)(kb + 32 * FA_KROW + 32 * d0);
                    s0 = MFMA32(k0, qf[d0], s0); s1 = MFMA32(k1, qf[d0], s1); }
                if (t == tw) {
#pragma unroll
                    for (int r = 0; r < 16; ++r) { const int key = 64 * t + crow(r, hi); if (key > qrow) s0[r] = -INFINITY; if (key + 32 > qrow) s1[r] = -INFINITY; }
                }
                float mx = fmaxf(s0[0], s1[0]);
#pragma unroll
                for (int r = 1; r < 16; ++r) mx = fmaxf(mx, fmaxf(s0[r], s1[r]));
                mx = fmaxf(mx, __shfl_xor(mx, 32));
                const float mnew = fmaxf(mrun, mx), alpha = __builtin_amdgcn_exp2f(mrun - mnew);
                mrun = mnew;
                float ps = 0.f;
#pragma unroll
                for (int r = 0; r < 16; ++r) { s0[r] = __builtin_amdgcn_exp2f(s0[r] - mnew); s1[r] = __builtin_amdgcn_exp2f(s1[r] - mnew); ps += s0[r] + s1[r]; }
                lrun = lrun * alpha + ps;
#pragma unroll
                for (int d = 0; d < 4; ++d)
#pragma unroll
                    for (int r = 0; r < 16; ++r) o[d][r] *= alpha;
                bf16x8 pf[4]; pf[0] = pack8(s0, 0); pf[1] = pack8(s0, 1); pf[2] = pack8(s1, 0); pf[3] = pack8(s1, 1);
                const LAS unsigned char* vb = lds + FA_V0 + cur * FA_VBUF + (4 * hi + trq) * FA_VROW + (16 * trc + 4 * trp) * 2;
#pragma unroll
                for (int ks = 0; ks < 4; ++ks) {
#pragma unroll
                    for (int d = 0; d < 4; ++d) { const s16x4 lo = lds_tr16(vb + 16 * ks * FA_VROW + 64 * d), hh = lds_tr16(vb + (16 * ks + 8) * FA_VROW + 64 * d);
                        o[d] = MFMA32(cat44(lo, hh), pf[ks], o[d]); }
                }
            }
            if (nxt) FA_STORE(cur ^ 1);
            WG_BAR();
            if (nxt) { cur ^= 1; --t; continue; }
            if (t == tb && tb > 0) {
                const float pm2 = fmaxf(fmaxf(fmaxf(red[8], red[9]), fmaxf(red[10], red[11])), fmaxf(fmaxf(red[12], red[13]), fmaxf(red[14], red[15])));
                float val = nq * (sqrtf(pm2) * 1.004f) - mrun; val = wave_max(val);
                if (lane == 0) red[wave] = val;
                WG_BAR();
                dstar = fmaxf(fmaxf(fmaxf(red[0], red[1]), fmaxf(red[2], red[3])), fmaxf(fmaxf(red[4], red[5]), fmaxf(red[6], red[7])));
                if (!FA_COND(tb - 1)) break;
                FA_LOAD(tb - 1); FA_STORE(cur ^ 1); WG_BAR(); cur ^= 1; --t; continue;
            }
            break;
        }
#undef FA_COND
        const float ltot = lrun + __shfl_xor(lrun, 32), inv = 1.0f / ltot;
        bf16* op = O + (rowbase + qrow) * DM + hd * FOX_D + 4 * hi;
#pragma unroll
        for (int d = 0; d < 4; ++d)
#pragma unroll
            for (int g = 0; g < 4; ++g) { u32x2 w; w.x = pg8::cvt_pk_bf16(o[d][4 * g] * inv, o[d][4 * g + 1] * inv); w.y = pg8::cvt_pk_bf16(o[d][4 * g + 2] * inv, o[d][4 * g + 3] * inv);
                *(u32x2*)(op + 32 * d + 8 * g) = w; }
#undef FA_LOAD
#undef FA_STORE
    }
}
constexpr int SW_KROW = 144, SW_VROW = 192, SW_K0 = 0, SW_V0 = 256 * SW_KROW;
__device__ __forceinline__ void swa_phase(const Frame& Fi, const bf16* P, const float* rope, const float* sinks, bf16* O) {
    Frame F = launder(Fi);
    const int tid = F.tid, lane = F.lane, wave = F.wave, r32 = lane & 31, hi = lane >> 5;
    LAS unsigned char* lds = F.lds;
    const int trq = (lane & 15) >> 2, trp = lane & 3, trc = (lane >> 4) & 1;
#pragma unroll 1
    for (int u = F.vcu; u < BATCH * 64 * SWA_HK; u += F.G) {
        const int hk = u & 7, n = (u >> 3) & 63, b = u >> 9;
        const size_t blk0 = (size_t)b * SEQ + (size_t)n * 128;
#pragma unroll
        for (int it = 0; it < 2; ++it) { const int item = tid + it * NTHR, row = item >> 2, pr = item & 3;
            u32x4 k0 = {0u, 0u, 0u, 0u}, k1 = k0, v0 = k0, v1 = k0;
            if (n > 0 || row >= 128) { const size_t m = blk0 - 128 + row; const bf16* kp = P + m * SWA_N + 2048 + hk * SWA_D + 16 * pr; const bf16* vp = P + m * SWA_N + 2560 + hk * SWA_D + 16 * pr;
                k0 = *(const u32x4*)kp; k1 = *(const u32x4*)(kp + 8); v0 = *(const u32x4*)vp; v1 = *(const u32x4*)(vp + 8);
                if (pr == 0) { const f32x4* cs = (const f32x4*)(rope + m * 16); const f32x4 c0 = cs[0], c1 = cs[1], s0 = cs[2], s1 = cs[3];
                    u32x4 n0, n1;
#pragma unroll
                    for (int i = 0; i < 4; ++i) { const float c_lo = (i < 2) ? c0[2 * i] : c1[2 * i - 4], c_hi = (i < 2) ? c0[2 * i + 1] : c1[2 * i - 3], s_lo = (i < 2) ? s0[2 * i] : s1[2 * i - 4], s_hi = (i < 2) ? s0[2 * i + 1] : s1[2 * i - 3];
                        const float a_lo = bf2f(k0[i] & 0xffffu), a_hi = bf2f(k0[i] >> 16), b_lo = bf2f(k1[i] & 0xffffu), b_hi = bf2f(k1[i] >> 16);
                        n0[i] = pk2(a_lo * c_lo - b_lo * s_lo, a_hi * c_hi - b_hi * s_hi); n1[i] = pk2(b_lo * c_lo + a_lo * s_lo, b_hi * c_hi + a_hi * s_hi); }
                    k0 = n0; k1 = n1; } }
            LAS unsigned char* kd = lds + SW_K0 + row * SW_KROW + 32 * pr; *(LAS u32x4*)kd = k0; *(LAS u32x4*)(kd + 16) = k1;
            LAS unsigned char* vd = lds + SW_V0 + row * SW_VROW + 32 * pr; *(LAS u32x4*)vd = v0; *(LAS u32x4*)(vd + 16) = v1; }
        WG_BAR();
#pragma unroll 1
        for (int it = 0; it < 2; ++it) {
            const int g = wave & 3, rb = (wave >> 2) + 2 * it, hq = hk * 4 + g;
            const int qi = 32 * rb + r32; const size_t m = blk0 + qi;
            bf16x8 qf[4];
            { const bf16* qp = P + m * SWA_N + hq * SWA_D;
              const u32x4 x1 = *(const u32x4*)qp, x2 = *(const u32x4*)(qp + 8);
              const f32x4* cs = (const f32x4*)(rope + m * 16); const f32x4 c0 = cs[0], c1 = cs[1], s0 = cs[2], s1 = cs[3];
              u32x4 w;
#pragma unroll
              for (int i = 0; i < 4; ++i) { const float c_lo = (i < 2) ? c0[2 * i] : c1[2 * i - 4], c_hi = (i < 2) ? c0[2 * i + 1] : c1[2 * i - 3], s_lo = (i < 2) ? s0[2 * i] : s1[2 * i - 4], s_hi = (i < 2) ? s0[2 * i + 1] : s1[2 * i - 3];
                  const float a_lo = bf2f(x1[i] & 0xffffu), a_hi = bf2f(x1[i] >> 16), b_lo = bf2f(x2[i] & 0xffffu), b_hi = bf2f(x2[i] >> 16);
                  const float r_lo = hi ? (b_lo * c_lo + a_lo * s_lo) : (a_lo * c_lo - b_lo * s_lo), r_hi = hi ? (b_hi * c_hi + a_hi * s_hi) : (a_hi * c_hi - b_hi * s_hi);
                  w[i] = pk2(r_lo * SWA_QSCALE, r_hi * SWA_QSCALE); }
              qf[0] = __builtin_bit_cast(bf16x8, w);
#pragma unroll
              for (int d0 = 1; d0 < 4; ++d0) { const u32x4 x = *(const u32x4*)(qp + 16 * d0 + 8 * hi); u32x4 ww;
#pragma unroll
                  for (int i = 0; i < 4; ++i) ww[i] = pk2(bf2f(x[i] & 0xffffu) * SWA_QSCALE, bf2f(x[i] >> 16) * SWA_QSCALE);
                  qf[d0] = __builtin_bit_cast(bf16x8, ww); } }
            f32x16 s[5];
#pragma unroll
            for (int j = 0; j < 5; ++j) {
#pragma unroll
                for (int r = 0; r < 16; ++r) s[j][r] = 0.f;
                const LAS unsigned char* kb = lds + SW_K0 + (32 * (rb + j) + r32) * SW_KROW + 16 * hi;
#pragma unroll
                for (int d0 = 0; d0 < 4; ++d0) s[j] = MFMA32(*(const LAS bf16x8*)(kb + 32 * d0), qf[d0], s[j]);
#pragma unroll
                for (int r = 0; r < 16; ++r) { const int kk = 32 * (rb + j) + crow(r, hi), ki = kk - 128, rel = qi - ki; const bool ok = (rel >= 0) && (rel < 128) && (n * 128 + ki >= 0); if (!ok) s[j][r] = -INFINITY; }
            }
            const float sink2 = sinks[hq] * LOG2E;
            float mx = sink2;
#pragma unroll
            for (int j = 0; j < 5; ++j)
#pragma unroll
                for (int r = 0; r < 16; ++r) mx = fmaxf(mx, s[j][r]);
            mx = fmaxf(mx, __shfl_xor(mx, 32));
            float ps = 0.f;
#pragma unroll
            for (int j = 0; j < 5; ++j)
#pragma unroll
                for (int r = 0; r < 16; ++r) { s[j][r] = __builtin_amdgcn_exp2f(s[j][r] - mx); ps += s[j][r]; }
            ps += __shfl_xor(ps, 32);
            const float inv = 1.0f / (ps + __builtin_amdgcn_exp2f(sink2 - mx));
            f32x16 o[2];
#pragma unroll
            for (int d = 0; d < 2; ++d)
#pragma unroll
                for (int r = 0; r < 16; ++r) o[d][r] = 0.f;
            const LAS unsigned char* vb = lds + SW_V0 + (32 * rb + 4 * hi + trq) * SW_VROW + (16 * trc + 4 * trp) * 2;
#pragma unroll
            for (int j = 0; j < 5; ++j)
#pragma unroll
                for (int ks = 0; ks < 2; ++ks) { const bf16x8 pf = pack8(s[j], ks);
#pragma unroll
                    for (int d = 0; d < 2; ++d) { const s16x4 lo = lds_tr16(vb + (32 * j + 16 * ks) * SW_VROW + 64 * d), hh = lds_tr16(vb + (32 * j + 16 * ks + 8) * SW_VROW + 64 * d);
                        o[d] = MFMA32(cat44(lo, hh), pf, o[d]); } }
            bf16* op = O + m * DM + hq * SWA_D + 4 * hi;
#pragma unroll
            for (int d = 0; d < 2; ++d)
#pragma unroll
                for (int gq = 0; gq < 4; ++gq) { u32x2 w; w.x = pg8::cvt_pk_bf16(o[d][4 * gq] * inv, o[d][4 * gq + 1] * inv); w.y = pg8::cvt_pk_bf16(o[d][4 * gq + 2] * inv, o[d][4 * gq + 3] * inv);
                    *(u32x2*)(op + 32 * d + 8 * gq) = w; }
        }
        WG_BAR();
    }
}
constexpr int SG_VROW = 320, SG_V0 = 0, SG_ST = 128 * SG_VROW;
__device__ __forceinline__ void sgu_phase(const Frame& Fi, const bf16* P, const float* vstat, const float* lng, const float* lnb, const bf16* wsm, const float* bs, bf16* O) {
    Frame F = launder(Fi);
    const int tid = F.tid, lane = F.lane, wave = F.wave, r32 = lane & 31, hi = lane >> 5;
    LAS unsigned char* lds = F.lds;
    const int trq = (lane & 15) >> 2, trp = lane & 3, trc = (lane >> 4) & 1;
    LAS float* rst = (LAS float*)(lds + SG_ST);
#pragma unroll 1
    for (int u = F.vcu; u < BATCH * 64 * 16; u += F.G) {
        const int g = u & 15, ch = (u >> 4) & 63, b = u >> 10;
        const size_t m0 = (size_t)b * SEQ + (size_t)ch * 128;
        if (tid < 128) { const float* sp = vstat + (m0 + tid) * 64; float s = 0.f, q = 0.f;
#pragma unroll 8
            for (int i = 0; i < 32; ++i) { s += sp[2 * i]; q += sp[2 * i + 1]; }
            const float mean = s * (1.0f / DM), var = fmaxf(q * (1.0f / DM) - mean * mean, 0.f);
            rst[2 * tid] = mean; rst[2 * tid + 1] = 1.0f / sqrtf(var + EPS); }
        WG_BAR();
#pragma unroll
        for (int it = 0; it < 4; ++it) { const int item = tid + it * NTHR, row = item >> 4, c8 = (item & 15) * 8;
            const u32x4 x = *(const u32x4*)(P + (m0 + row) * SGU_N + 2048 + g * 128 + c8);
            const f32x4 g0 = *(const f32x4*)(lng + g * 128 + c8), g1 = *(const f32x4*)(lng + g * 128 + c8 + 4), b0 = *(const f32x4*)(lnb + g * 128 + c8), b1 = *(const f32x4*)(lnb + g * 128 + c8 + 4);
            const float mean = rst[2 * row], rstd = rst[2 * row + 1]; u32x4 w;
#pragma unroll
            for (int i = 0; i < 4; ++i) { const float ga = (i < 2) ? g0[2 * i] : g1[2 * i - 4], gb = (i < 2) ? g0[2 * i + 1] : g1[2 * i - 3], ba = (i < 2) ? b0[2 * i] : b1[2 * i - 4], bb = (i < 2) ? b0[2 * i + 1] : b1[2 * i - 3];
                w[i] = pk2((bf2f(x[i] & 0xffffu) - mean) * rstd * ga + ba, (bf2f(x[i] >> 16) - mean) * rstd * gb + bb); }
            *(LAS u32x4*)(lds + SG_V0 + row * SG_VROW + c8 * 2) = w; }
        WG_BAR();
        const int tb = wave & 3;
        const bf16* wrow = wsm + ((size_t)g * 128 + 32 * tb + r32) * 128 + 8 * hi;
#pragma unroll 1
        for (int it = 0; it < 2; ++it) { const int db = (wave >> 2) + 2 * it;
            f32x16 acc;
#pragma unroll
            for (int r = 0; r < 16; ++r) acc[r] = 0.f;
            const LAS unsigned char* vb = lds + SG_V0 + (8 * hi + trq) * SG_VROW + (32 * db + 16 * trc + 4 * trp) * 2;
#pragma unroll 1
            for (int ks = 0; ks < 2 * tb + 2; ++ks) { const bf16x8 wf = *(const bf16x8*)(wrow + 16 * ks);
                const s16x4 lo = lds_tr16(vb + 16 * ks * SG_VROW), hh = lds_tr16(vb + (16 * ks + 4) * SG_VROW);
                acc = MFMA32(cat44(lo, hh), wf, acc); }
            const int t = 32 * tb + r32; const float bias = bs[g * 128 + t];
            const bf16* up = P + (m0 + t) * SGU_N + g * 128 + 32 * db + 4 * hi; bf16* op = O + (m0 + t) * DM + g * 128 + 32 * db + 4 * hi;
#pragma unroll
            for (int gq = 0; gq < 4; ++gq) { const u32x2 uu = *(const u32x2*)(up + 8 * gq); u32x2 w;
                w.x = pg8::cvt_pk_bf16(bf2f(uu.x & 0xffffu) * (acc[4 * gq] + bias), bf2f(uu.x >> 16) * (acc[4 * gq + 1] + bias));
                w.y = pg8::cvt_pk_bf16(bf2f(uu.y & 0xffffu) * (acc[4 * gq + 2] + bias), bf2f(uu.y >> 16) * (acc[4 * gq + 3] + bias));
                *(u32x2*)(op + 8 * gq) = w; } }
        WG_BAR();
    }
}
constexpr int NPHASE = 31, PH_FINAL = 30;
__global__ void __launch_bounds__(NTHR, 2) mk_fwd(Args args) {
    extern __shared__ __attribute__((aligned(16))) unsigned char lds_raw[];
    Frame F;
    F.lds = (LAS unsigned char*)lds_raw;
    F.tid = threadIdx.x; F.lane = F.tid & 63; F.wave = __builtin_amdgcn_readfirstlane(F.tid >> 6);
    F.G = gridDim.x; { const int bx = blockIdx.x; F.vcu = (F.G % 8 == 0) ? (bx % 8) * (F.G / 8) + bx / 8 : bx; }
    unsigned char* ws = args.ws;
    gu32* ctl = (gu32*)(ws + WS_CTL);
    for (int u = F.tid; u < (LDS_BYTES - LDSCTL_OFF) / 4; u += NTHR) ((LAS unsigned*)(F.lds + LDSCTL_OFF))[u] = 0u;
    __syncthreads();
    XcdBarrier bar = xcd_barrier_post((unsigned*)(ctl + CW_BAR), (volatile LAS unsigned*)(F.lds + MISC_OFF) + 8);
    const int lo = args.ph_lo, hi = args.ph_hi;
#define IN(k) (lo <= (k) && (k) < hi)
#ifndef PROBE_REPEAT
#define PROBE_REPEAT 0
#endif
#define REP(c) _Pragma("unroll 1") for (int rep_ = 0; rep_ <= ((PROBE_REPEAT >> (c)) & 1); ++rep_)
#define SEAM(k) do { if (IN(k) && IN((k) + 1)) xcd_barrier(bar); } while (0)
    bf16* Hb = (bf16*)(ws + WS_H); bf16* Pb = (bf16*)(ws + WS_PROJ); bf16* Ob = (bf16*)(ws + WS_O); bf16* Yb = (bf16*)(ws + WS_Y);
    float* XA = (float*)(ws + WS_XA); float* ystat = (float*)(ws + WS_YSTAT); float* vstat = (float*)(ws + WS_VSTAT);
    const float* vec = (const float*)(ws + WS_VEC);
    float* logf = (float*)(ws + WS_LOGF); float* cum = (float*)(ws + WS_CUM);

    if (IN(0)) { REP(0) { p0_prologue(F, args); __syncthreads(); } } SEAM(0);
    if (IN(1)) { p1_modvec(F, args); } SEAM(1);

#pragma unroll 1
    for (int s = 0; s < 2 * DEPTH; ++s) {
        const int l = s >> 1, half = s & 1, kind = l % 3, jj = l / 3, base = 2 + 7 * l + 4 * half;
        if (IN(base)) {
            const float* xin = (s == 0 || s == 1) ? args.in[0] : (((s - 1) & 1) ? XA : args.out);
            float* xout = (s == 0) ? nullptr : ((s & 1) ? XA : args.out);
            const float* lv = vec + (size_t)l * 12 * DM;
            const float* gsrc = (s == 0) ? nullptr : (half ? lv + 2 * DM : vec + (size_t)(l - 1) * 12 * DM + 5 * DM);
            const float* av = half ? lv + 3 * DM : lv + 0 * DM; const float* sv = half ? lv + 4 * DM : lv + 1 * DM;
            const bool fox = (half == 0 && kind == 0);
            REP(1) norm_phase(F, xin, xout, s == 0 ? nullptr : Yb, ystat, gsrc, av, sv, Hb, fox ? (const float*)(ws + WS_WFG) + (size_t)jj * 16 * DM : nullptr, args.in[12] + jj * 16, logf);
        }
        SEAM(base);
        if (half == 0) {
            if (IN(base + 1)) {
                if (kind == 1) {
                    pg8::Gemm g{Hb, (const bf16*)(ws + WS_WSGUIN), M, SGU_N, DM}; pg8::StaticOrder S; S.init(M, SGU_N, F.G, (int)blockIdx.x);
                    pg8::EpiSguIn E{Pb, SGU_N, vstat};
                    REP(2) pg8::gemm_phase<pg8::EpiSguIn, pg8::StaticOrder, true, true>(F.lds, g, S, E);
                } else {
                    if (kind == 0) fox_scan(F, logf, cum);
                    const int N = kind == 0 ? FOX_N : SWA_N;
                    const bf16* Bt = kind == 0 ? (const bf16*)(ws + WS_WFOXIN + jj * WFOXIN_BYTES) : (const bf16*)(ws + WS_WSWAIN);
                    pg8::Gemm g{Hb, Bt, M, N, DM}; pg8::StaticOrder S; S.init(M, N, F.G, (int)blockIdx.x);
                    pg8::EpiProj E{Pb, N, kind == 0 ? 2048 : 0, FOX_QSCALE, kind == 0 ? (float*)(ws + WS_KNORM) : nullptr};
                    REP(2) pg8::gemm_phase<pg8::EpiProj, pg8::StaticOrder, true, true>(F.lds, g, S, E);
                }
            }
            SEAM(base + 1);
            if (IN(base + 2)) {
                if (kind == 0) { REP(3) fox_attn_phase(F, Pb, cum, (const float*)(ws + WS_KNORM), (unsigned*)(ctl + CW_TICKET + 64 * jj), Ob); }
                else if (kind == 1) REP(4) sgu_phase(F, Pb, vstat, args.in[15], args.in[16], (const bf16*)(ws + WS_WSM), args.in[18], Ob);
                else REP(5) swa_phase(F, Pb, (const float*)(ws + WS_ROPE), args.in[21], Ob);
            }
            SEAM(base + 2);
        } else {
            if (IN(base + 1)) {
                pg8::Gemm g{Hb, (const bf16*)(ws + WS_WGU + l * WGU_BYTES), M, 2 * DFF, DM}; pg8::StaticOrder S; S.init(M, 2 * DFF, F.G, (int)blockIdx.x);
                pg8::EpiSwiglu E{Pb, DFF};
                REP(2) pg8::gemm_phase<pg8::EpiSwiglu, pg8::StaticOrder, true, true>(F.lds, g, S, E);
            }
            SEAM(base + 1);
        }
        { const int ph = half ? base + 2 : base + 3;
          if (IN(ph)) {
              const bf16* A = half ? Pb : Ob; const int K = half ? DFF : DM;
              const bf16* Bt = half ? (const bf16*)(ws + WS_WDN + l * WDN_BYTES) : (kind == 0 ? (const bf16*)(ws + WS_WFOXOUT + jj * WSQ_BYTES) : kind == 1 ? (const bf16*)(ws + WS_WSGUOUT) : (const bf16*)(ws + WS_WSWAOUT));
              pg8::Gemm g{A, Bt, M, DM, K}; pg8::StaticOrder S; S.init(M, DM, F.G, (int)blockIdx.x);
              pg8::EpiOut E{Yb, DM, ystat};
              REP(2) pg8::gemm_phase<pg8::EpiOut, pg8::StaticOrder, true, true>(F.lds, g, S, E);
          }
          SEAM(ph); }
    }
    if (IN(PH_FINAL)) {
        const float* gsrc = vec + (size_t)3 * 12 * DM + 5 * DM;
        REP(1) norm_phase(F, XA, args.out, Yb, ystat, gsrc, nullptr, nullptr, nullptr, nullptr, nullptr, nullptr);
    }
#undef IN
#undef SEAM
}
#if DBG
static void dbg_checks(int phase, const Args& a, hipStream_t stream);
__global__ void dbg_finalize(Args a);
#endif
extern "C" void kernel_launch(void* const* d_in, const int* in_sizes, int n_in, void* d_out, int out_size, void* d_ws, size_t ws_size, hipStream_t stream) {
    static int grid = 0;
    if (grid == 0) {
        if (n_in != 23 || out_size != M * DM || ws_size < WS_END) { fprintf(stderr, "kernel_launch: unexpected shapes (n_in %d, out %d, ws %zu); nothing launched\n", n_in, out_size, ws_size); grid = -1; return; }
        int dev = 0, cus = 0, per_cu = 0;
        if (hipGetDevice(&dev) != hipSuccess || hipDeviceGetAttribute(&cus, hipDeviceAttributeMultiprocessorCount, dev) != hipSuccess) { grid = -1; return; }
        if (hipFuncSetAttribute((const void*)mk_fwd, hipFuncAttributeMaxDynamicSharedMemorySize, LDS_BYTES) != hipSuccess) { fprintf(stderr, "kernel_launch: hipFuncSetAttribute failed\n"); grid = -1; return; }
        if (hipOccupancyMaxActiveBlocksPerMultiprocessor(&per_cu, (const void*)mk_fwd, NTHR, LDS_BYTES) != hipSuccess || per_cu < 1) { fprintf(stderr, "kernel_launch: occupancy query says %d blocks per CU\n", per_cu); }
        (void)hipGetLastError();
        grid = cus;
        if (grid != 256) { fprintf(stderr, "kernel_launch: built for a 256-CU device, found %d CUs; nothing launched\n", cus); grid = -1; return; }
    }
    if (grid < 0) return;
    (void)hipMemsetAsync((char*)d_ws + WS_CTL, 0, CTL_ZERO_BYTES, stream);
    Args a{};
    for (int i = 0; i < 23; ++i) a.in[i] = (const float*)d_in[i];
    a.out = (float*)d_out; a.ws = (unsigned char*)d_ws;
#if DBG
    for (int ph = 0; ph < NPHASE; ++ph) { a.ph_lo = ph; a.ph_hi = ph + 1; hipLaunchKernelGGL(mk_fwd, dim3(grid), dim3(NTHR), LDS_BYTES, stream, a); dbg_checks(ph, a, stream); }
    hipLaunchKernelGGL(dbg_finalize, dim3(1024), dim3(256), 0, stream, a);
#else
    a.ph_lo = 0; a.ph_hi = NPHASE;
    hipLaunchKernelGGL(mk_fwd, dim3(grid), dim3(NTHR), LDS_BYTES, stream, a);
#endif
    const hipError_t le = hipPeekAtLastError();
    if (le != hipSuccess) fprintf(stderr, "kernel_launch: launch failed: %s\n", hipGetErrorName(le));
}
#if DBG
__device__ __forceinline__ void dbg_fail(unsigned char* ws, unsigned code, float val) {
    unsigned* ctl = (unsigned*)(ws + WS_CTL);
    if (atomicCAS(ctl + CW_ERR, 0u, code) == 0u) ctl[CW_ERRV] = __float_as_uint(val);
}
__device__ __forceinline__ float block_sum256(float v, float* sh) {
    const int t = threadIdx.x; sh[t] = v; __syncthreads();
    for (int o = 128; o > 0; o >>= 1) { if (t < o) sh[t] += sh[t + o]; __syncthreads(); }
    const float r = sh[0]; __syncthreads(); return r;
}
__device__ __forceinline__ float block_max256(float v, float* sh) {
    const int t = threadIdx.x; sh[t] = v; __syncthreads();
    for (int o = 128; o > 0; o >>= 1) { if (t < o) sh[t] = fmaxf(sh[t], sh[t + o]); __syncthreads(); }
    const float r = sh[0]; __syncthreads(); return r;
}
__device__ __forceinline__ unsigned hash32(unsigned x) { x ^= x >> 16; x *= 0x7feb352du; x ^= x >> 15; x *= 0x846ca68bu; x ^= x >> 16; return x; }
__device__ __forceinline__ int dbg_row(int i) { return i * 256 + ((i * 37 + 11) & 255); }

struct ChkW { const float* W; const bf16* WT; int ldw, K, N, gu; };
__global__ void chk_weights(Args a, ChkW c, unsigned code) {
    const unsigned i = blockIdx.x * blockDim.x + threadIdx.x; const unsigned h = hash32(i * 2654435761u + code);
    const int n = h % c.N, k = hash32(h) % c.K;
    int col = n; if (c.gu) { const int tile = n >> 8, bj = (n >> 7) & 1, j = n & 127; col = bj * DFF + tile * 128 + j; }
    const float w = c.W[(size_t)k * c.ldw + col], g = bf2f(c.WT[(size_t)n * c.K + k]);
    if (!(fabsf(g - w) <= 0.004f * fabsf(w) + 1e-30f)) dbg_fail(a.ws, code, (float)n);
}
__global__ void chk_tables(Args a, unsigned code) {
    const int i = blockIdx.x * blockDim.x + threadIdx.x;
    const float* wfg = (const float*)(a.ws + WS_WFG); const bf16* wsm = (const bf16*)(a.ws + WS_WSM); const float* rope = (const float*)(a.ws + WS_ROPE);
    { const int j = i / 32768, hd = (i / 2048) % 16, k = i % 2048; if (wfg[i] != a.in[11][((size_t)j * DM + k) * FOX_IN + FOX_N + hd]) dbg_fail(a.ws, code, 1.f); }
    for (int e = i; e < 16 * 128 * 128; e += 65536) { const int t = (e >> 7) & 127, s = e & 127; const float w = s <= t ? a.in[17][e] : 0.f; if (!(fabsf(bf2f(wsm[e]) - w) <= 0.004f * fabsf(w))) dbg_fail(a.ws, code, 2.f); }
    { const int m = i & (M - 1), k = (i >> 14) & 7  ; const int pos = ((const int*)a.in[2])[m]; const float ang = (float)pos * ROPE_INV[k];
      const float c = cosf(ang), s = sinf(ang); if (!(fabsf(rope[m * 16 + k] - c) < 2e-5f && fabsf(rope[m * 16 + 8 + k] - s) < 2e-5f)) dbg_fail(a.ws, code, 3.f); }
}
__global__ void chk_modvec(Args a, unsigned code) {
    const int i = blockIdx.x * blockDim.x + threadIdx.x;
    if (i >= 3072) return;
    const int l = i / 768, b = (i / 384) % 2, slot = (i / 64) % 6, col = ((i % 64) * 32 + (i * 7) % 32) % DM;
    const int part = slot == 0 ? 1 : slot == 1 ? 0 : slot == 2 ? 2 : slot == 3 ? 4 : slot == 4 ? 3 : 5;
    double s = 0.0;
    for (int k = 0; k < DM; ++k) { const double c = (double)a.in[1][b * DM + k]; s += c / (1.0 + exp(-c)) * (double)a.in[3][((size_t)l * DM + k) * 12288 + part * DM + col]; }
    s += (double)a.in[4][l * 12288 + part * DM + col];
    double v;
    if (slot == 0) v = (double)a.in[5][l * DM + col] * (1.0 + s); else if (slot == 1) v = s; else if (slot == 2) v = s * (double)a.in[6][l * DM + col];
    else if (slot == 3) v = (double)a.in[7][l * DM + col] * (1.0 + s); else if (slot == 4) v = s; else v = s * (double)a.in[8][l * DM + col];
    const float got = ((const float*)(a.ws + WS_VEC))[((size_t)(l * 2 + b) * 6 + slot) * DM + col];
    if (!(fabs((double)got - v) <= 1e-3 * fabs(v) + 1e-4)) dbg_fail(a.ws, code, (float)i);
}
struct ChkN { const float* xin; const float* xout; const bf16* y; const float* g; const float* av; const float* sv; const bf16* h; const float* wfox; const float* bf; const float* logf; };
__global__ void chk_norm(Args a, ChkN c, unsigned code) {
    __shared__ float sh[256]; __shared__ float hrow[DM];
    const int m = dbg_row(blockIdx.x), b = m >> 13, t = threadIdx.x; const size_t vo = (size_t)b * 6 * DM;
    float xn[8];
    float q = 0.f;
    if (c.y) { for (int j = 0; j < 8; ++j) { const float yv = bf2f(c.y[(size_t)m * DM + t + 256 * j]); q += yv * yv; } }
    q = block_sum256(q, sh);
    const float rstdy = 1.0f / sqrtf(q / DM + EPS);
    float e2 = 0.f, r2 = 0.f;
    for (int j = 0; j < 8; ++j) { const int col = t + 256 * j; float x = c.xin[(size_t)m * DM + col];
        if (c.y) { x += c.g[vo + col] * bf2f(c.y[(size_t)m * DM + col]) * rstdy; if (c.xout) { const float d = c.xout[(size_t)m * DM + col] - x; e2 += d * d; r2 += x * x; } }
        xn[j] = x; }
    e2 = block_sum256(e2, sh); r2 = block_sum256(r2, sh);
    if (c.y && c.xout && !(e2 <= 1e-4f * r2)) dbg_fail(a.ws, code, sqrtf(e2 / (r2 + 1e-30f)));
    if (!c.h) return;
    float qx = 0.f; for (int j = 0; j < 8; ++j) qx += xn[j] * xn[j];
    qx = block_sum256(qx, sh);
    const float rstdx = 1.0f / sqrtf(qx / DM + EPS);
    e2 = 0.f; r2 = 0.f;
    for (int j = 0; j < 8; ++j) { const int col = t + 256 * j; const float hv = xn[j] * rstdx * c.av[vo + col] + c.sv[vo + col]; hrow[col] = hv; const float d = bf2f(c.h[(size_t)m * DM + col]) - hv; e2 += d * d; r2 += hv * hv; }
    e2 = block_sum256(e2, sh); r2 = block_sum256(r2, sh);
    if (!(e2 <= 1e-4f * r2)) dbg_fail(a.ws, code + 40, sqrtf(e2 / (r2 + 1e-30f)));
    if (!c.wfox) return;
    __syncthreads();
    for (int hd = 0; hd < 16; ++hd) { float p = 0.f; for (int j = 0; j < 8; ++j) { const int k = t + 256 * j; p += hrow[k] * c.wfox[(size_t)k * FOX_IN + FOX_N + hd]; }
        p = block_sum256(p, sh);
        if (t == 0) { const float x = p + c.bf[hd]; const float ls = (float)(-log1p(exp(-(double)x))); const float got = c.logf[(size_t)(b * 16 + hd) * SEQ + (m & (SEQ - 1))];
            if (!(fabsf(got - ls) <= 5e-3f)) dbg_fail(a.ws, code + 80, got - ls); } }
}
struct ChkG { const bf16* A; const float* W; const bf16* out; const float* stat; int K, ldw, N, mode, ldo, qcols; float qscale; int pad; };
static ChkG mkG(const bf16* A, int K, const float* W, int ldw, int N, int mode, const bf16* out, int ldo, int qcols, float qscale, const float* stat) { ChkG c{}; c.A = A; c.W = W; c.out = out; c.stat = stat; c.K = K; c.ldw = ldw; c.N = N; c.mode = mode; c.ldo = ldo; c.qcols = qcols; c.qscale = qscale; c.pad = 0; return c; }
__global__ void chk_gemm(Args a, ChkG c, unsigned code) {
    __shared__ float sh[256]; __shared__ float arow[DFF];
    const int m = dbg_row(blockIdx.x), t = threadIdx.x;
    for (int k = t; k < c.K; k += 256) arow[k] = bf2f(c.A[(size_t)m * c.K + k]);
    __syncthreads();
    float e2 = 0.f, r2 = 0.f, s1 = 0.f, s2 = 0.f, emax = 0.f;
    for (int col = t; col < c.N; col += 256) {
        float d0 = 0.f, d1 = 0.f;
        for (int k = 0; k < c.K; ++k) { d0 += arow[k] * c.W[(size_t)k * c.ldw + col]; if (c.mode == 2) d1 += arow[k] * c.W[(size_t)k * c.ldw + DFF + col]; }
        float ex;
        if (c.mode == 0) ex = d0 * (col < c.qcols ? c.qscale : 1.0f);
        else if (c.mode == 1) ex = 0.5f * d0 * (1.0f + tanhf(0.7978845608028654f * (d0 + 0.044715f * d0 * d0 * d0)));
        else if (c.mode == 2) ex = d0 / (1.0f + expf(-d0)) * d1;
        else ex = d0;
        const float got = bf2f(c.out[(size_t)m * c.ldo + col]), d = got - ex; e2 += d * d; r2 += ex * ex; emax = fmaxf(emax, fabsf(d));
        if (c.mode == 3) s2 += ex * ex;
        if (c.mode == 1 && col >= 2048) { s1 += ex; s2 += ex * ex; }
    }
    e2 = block_sum256(e2, sh); r2 = block_sum256(r2, sh); emax = block_max256(emax, sh); s1 = block_sum256(s1, sh); s2 = block_sum256(s2, sh);
    const float rms = sqrtf(r2 / c.N);
    if (!(e2 <= 4e-4f * r2) || !(emax <= 0.15f * rms + 1e-6f)) dbg_fail(a.ws, code, sqrtf(e2 / (r2 + 1e-30f)));
    if (t == 0 && c.stat) {
        if (c.mode == 3) { float q = 0.f; for (int i = 0; i < 32; ++i) q += c.stat[(size_t)m * 32 + i]; if (!(fabsf(q - s2) <= 0.02f * s2)) dbg_fail(a.ws, code + 40, q / s2); }
        if (c.mode == 1) { float s = 0.f, q = 0.f; for (int i = 0; i < 32; ++i) { s += c.stat[((size_t)m * 32 + i) * 2]; q += c.stat[((size_t)m * 32 + i) * 2 + 1]; }
            if (!(fabsf(q - s2) <= 0.02f * s2) || !(fabsf(s - s1) <= 0.02f * fabsf(s1) + 1.0f)) dbg_fail(a.ws, code + 40, q / s2); }
    }
}
__global__ void chk_scan(Args a, unsigned code) {
    const int i = blockIdx.x * blockDim.x + threadIdx.x; if (i >= 128) return;
    const int bh = i >> 2, which = i & 3, t = which == 0 ? 0 : which == 1 ? 1000 + 13 * bh : which == 2 ? 4096 + bh : 8191;
    const float* lf = (const float*)(a.ws + WS_LOGF) + (size_t)bh * SEQ; double s = 0.0;
    for (int j = 0; j <= t; ++j) s += (double)lf[j];
    const float got = ((const float*)(a.ws + WS_CUM))[(size_t)bh * SEQ + t];
    if (!(fabs((double)got - s) <= 1e-3 + 1e-5 * fabs(s))) dbg_fail(a.ws, code, (float)((double)got - s));
}
__global__ void chk_fox(Args a, unsigned code) {
    __shared__ float sh[256]; __shared__ float sc[SEQ]; __shared__ float qv[FOX_D];
    const int bh = blockIdx.x >> 2, which = blockIdx.x & 3, b = bh >> 4, hd = bh & 15, t = threadIdx.x;
    const int i = which == 0 ? (bh % 3) : which == 1 ? 63 + 64 * (bh % 5) + (bh & 1) : which == 2 ? 3000 + 97 * bh : 8191 - (bh % 7) * 256;
    const bf16* P = (const bf16*)(a.ws + WS_PROJ); const float* cum = (const float*)(a.ws + WS_CUM) + (size_t)bh * SEQ; const size_t rb = (size_t)b * SEQ;
    if (t < FOX_D) qv[t] = bf2f(P[(rb + i) * FOX_N + hd * FOX_D + t]);
    __syncthreads();
    float mx = -INFINITY;
    for (int j = t; j <= i; j += 256) { const bf16* kp = P + (rb + j) * FOX_N + 2048 + hd * FOX_D; float d = 0.f; for (int e = 0; e < FOX_D; ++e) d += qv[e] * bf2f(kp[e]);
        d += (cum[i] - cum[j]) * LOG2E; sc[j] = d; mx = fmaxf(mx, d); }
    mx = block_max256(mx, sh);
    float l = 0.f;
    for (int j = t; j <= i; j += 256) { const float p = exp2f(sc[j] - mx); sc[j] = p; l += p; }
    l = block_sum256(l, sh);
    float e2 = 0.f, r2 = 0.f;
    if (t < FOX_D) { float o = 0.f; for (int j = 0; j <= i; ++j) o += sc[j] * bf2f(P[(rb + j) * FOX_N + 4096 + hd * FOX_D + t]); o /= l;
        const float got = bf2f(((const bf16*)(a.ws + WS_O))[(rb + i) * DM + hd * FOX_D + t]), d = got - o; e2 = d * d; r2 = o * o; }
    e2 = block_sum256(e2, sh); r2 = block_sum256(r2, sh);
    if (!(e2 <= 1e-3f * r2)) dbg_fail(a.ws, code, sqrtf(e2 / (r2 + 1e-30f)) + 10.f * which);
}
__global__ void chk_swa(Args a, unsigned code) {
    __shared__ float qv[64]; __shared__ float sc[128]; __shared__ float red[2];
    const int smp = blockIdx.x, t = threadIdx.x;
    const int b = smp & 1, hq = (smp * 5 + 3) & 31, hk = hq >> 2;
    const int i = (smp < 8) ? smp * 17 : (smp < 16) ? 127 + (smp - 8) * 128 : (smp * 131 + 29) & (SEQ - 1);
    const bf16* P = (const bf16*)(a.ws + WS_PROJ); const int* pos = (const int*)a.in[2]; const size_t rb = (size_t)b * SEQ;
    { const bf16* qp = P + (rb + i) * SWA_N + hq * SWA_D; float v = bf2f(qp[t]);
      if (t < 16) { const int k = t & 7; const float ang = (float)pos[rb + i] * ROPE_INV[k], c = cosf(ang), s = sinf(ang); const float x1 = bf2f(qp[k]), x2 = bf2f(qp[8 + k]); v = (t < 8) ? x1 * c - x2 * s : x2 * c + x1 * s; }
      qv[t] = v; }
    __syncthreads();
    const int blk = i >> 7;
    for (int jj = t; jj < 128; jj += 64) { const int j = i - jj; float d = -INFINITY;
        if (j >= 0 && j >= (blk - 1) * 128) { const bf16* kp = P + (rb + j) * SWA_N + 2048 + hk * SWA_D; d = 0.f;
            for (int e = 0; e < 64; ++e) { float kv = bf2f(kp[e]);
                if (e < 16) { const int k = e & 7; const float ang = (float)pos[rb + j] * ROPE_INV[k], c = cosf(ang), s = sinf(ang); const float x1 = bf2f(kp[k]), x2 = bf2f(kp[8 + k]); kv = (e < 8) ? x1 * c - x2 * s : x2 * c + x1 * s; }
                d += qv[e] * kv; }
            d *= 0.125f; }
        sc[jj] = d; }
    __syncthreads();
    if (t == 0) { float mx = a.in[21][hq]; for (int jj = 0; jj < 128; ++jj) mx = fmaxf(mx, sc[jj]); float l = expf(a.in[21][hq] - mx); for (int jj = 0; jj < 128; ++jj) l += expf(sc[jj] - mx); red[0] = mx; red[1] = l; }
    __syncthreads();
    float o = 0.f;
    for (int jj = 0; jj < 128; ++jj) { const int j = i - jj; if (sc[jj] > -INFINITY) o += expf(sc[jj] - red[0]) * bf2f(P[(rb + j) * SWA_N + 2560 + hk * SWA_D + t]); }
    o /= red[1];
    const float got = bf2f(((const bf16*)(a.ws + WS_O))[(rb + i) * DM + hq * SWA_D + t]);
    float e2 = (got - o) * (got - o), r2 = o * o;
    for (int of = 32; of > 0; of >>= 1) { e2 += __shfl_xor(e2, of); r2 += __shfl_xor(r2, of); }
    if (t == 0 && !(e2 <= 1e-3f * r2)) dbg_fail(a.ws, code, sqrtf(e2 / (r2 + 1e-30f)));
}
__global__ void chk_sgu(Args a, unsigned code) {
    __shared__ float mean[128], rstd[128]; __shared__ float sh[128];
    const int smp = blockIdx.x, d = threadIdx.x;
    const int g = (smp * 7 + 1) & 15, m = (smp < 4) ? smp * 128 + (smp == 0 ? 0 : 127) : (smp * 1031 + 77) & (M - 1), tt = m & 127; const size_t m0 = (size_t)(m - tt);
    const bf16* P = (const bf16*)(a.ws + WS_PROJ);
    for (int s = 0; s <= tt; ++s) { float su = 0.f, sq = 0.f; for (int c = d; c < DM; c += 128) { const float v = bf2f(P[(m0 + s) * SGU_N + 2048 + c]); su += v; sq += v * v; }
        sh[d] = su; __syncthreads(); for (int o = 64; o > 0; o >>= 1) { if (d < o) sh[d] += sh[d + o]; __syncthreads(); } const float mu = sh[0] / DM; __syncthreads();
        sh[d] = sq; __syncthreads(); for (int o = 64; o > 0; o >>= 1) { if (d < o) sh[d] += sh[d + o]; __syncthreads(); } const float var = sh[0] / DM - mu * mu; __syncthreads();
        if (d == 0) { mean[s] = mu; rstd[s] = 1.0f / sqrtf(fmaxf(var, 0.f) + EPS); } }
    __syncthreads();
    float f = 0.f; const int col = g * 128 + d;
    for (int s = 0; s <= tt; ++s) { const float vn = (bf2f(P[(m0 + s) * SGU_N + 2048 + col]) - mean[s]) * rstd[s] * a.in[15][col] + a.in[16][col]; f += a.in[17][((size_t)g * 128 + tt) * 128 + s] * vn; }
    f += a.in[18][g * 128 + tt];
    const float ex = bf2f(P[(size_t)m * SGU_N + col]) * f, got = bf2f(((const bf16*)(a.ws + WS_O))[(size_t)m * DM + col]);
    float e2 = (got - ex) * (got - ex), r2 = ex * ex;
    sh[d] = e2; __syncthreads(); for (int o = 64; o > 0; o >>= 1) { if (d < o) sh[d] += sh[d + o]; __syncthreads(); } e2 = sh[0]; __syncthreads();
    sh[d] = r2; __syncthreads(); for (int o = 64; o > 0; o >>= 1) { if (d < o) sh[d] += sh[d + o]; __syncthreads(); } r2 = sh[0];
    if (d == 0 && !(e2 <= 1e-3f * r2)) dbg_fail(a.ws, code, sqrtf(e2 / (r2 + 1e-30f)));
}
__global__ void dbg_finalize(Args a) {
    const unsigned* ctl = (const unsigned*)(a.ws + WS_CTL); const unsigned code = ctl[CW_ERR], tmo = ctl[CW_TMO] | ctl[CW_BAR + XB_TMO];
#ifdef DBG_REPORT_VALUE
    const float v = code ? 1000.f * fabsf(__uint_as_float(ctl[CW_ERRV])) : 0.f;
#else
    const float v = code ? 1000.f * (float)code : (tmo ? 999000.f : 0.f);
#endif
    if (v != 0.f) for (size_t i = (size_t)blockIdx.x * blockDim.x + threadIdx.x; i < (size_t)M * DM; i += (size_t)gridDim.x * blockDim.x) a.out[i] = v;
}
static void dbg_checks(int ph, const Args& a, hipStream_t st) {
    unsigned char* ws = a.ws; const unsigned code = (unsigned)ph + 1;
    const bf16* Hb = (const bf16*)(ws + WS_H); const bf16* Pb = (const bf16*)(ws + WS_PROJ); const bf16* Ob = (const bf16*)(ws + WS_O); const bf16* Yb = (const bf16*)(ws + WS_Y);
    const float* XA = (const float*)(ws + WS_XA); const float* vec = (const float*)(ws + WS_VEC);
    if (ph == 0) {
        for (int l = 0; l < 4; ++l) { ChkW c{a.in[9] + (size_t)l * DM * 2 * DFF, (const bf16*)(ws + WS_WGU + l * WGU_BYTES), 2 * DFF, DM, 2 * DFF, 1}; hipLaunchKernelGGL(chk_weights, dim3(64), dim3(256), 0, st, a, c, code); }
        for (int l = 0; l < 4; ++l) { ChkW c{a.in[10] + (size_t)l * DFF * DM, (const bf16*)(ws + WS_WDN + l * WDN_BYTES), DM, DFF, DM, 0}; hipLaunchKernelGGL(chk_weights, dim3(64), dim3(256), 0, st, a, c, code); }
        for (int l = 0; l < 2; ++l) { ChkW c{a.in[11] + (size_t)l * DM * FOX_IN, (const bf16*)(ws + WS_WFOXIN + l * WFOXIN_BYTES), FOX_IN, DM, FOX_N, 0}; hipLaunchKernelGGL(chk_weights, dim3(64), dim3(256), 0, st, a, c, code); }
        for (int l = 0; l < 2; ++l) { ChkW c{a.in[13] + (size_t)l * DM * DM, (const bf16*)(ws + WS_WFOXOUT + l * WSQ_BYTES), DM, DM, DM, 0}; hipLaunchKernelGGL(chk_weights, dim3(64), dim3(256), 0, st, a, c, code); }
        { ChkW c{a.in[14], (const bf16*)(ws + WS_WSGUIN), SGU_N, DM, SGU_N, 0}; hipLaunchKernelGGL(chk_weights, dim3(64), dim3(256), 0, st, a, c, code); }
        { ChkW c{a.in[19], (const bf16*)(ws + WS_WSGUOUT), DM, DM, DM, 0}; hipLaunchKernelGGL(chk_weights, dim3(64), dim3(256), 0, st, a, c, code); }
        { ChkW c{a.in[20], (const bf16*)(ws + WS_WSWAIN), SWA_N, DM, SWA_N, 0}; hipLaunchKernelGGL(chk_weights, dim3(64), dim3(256), 0, st, a, c, code); }
        { ChkW c{a.in[22], (const bf16*)(ws + WS_WSWAOUT), DM, DM, DM, 0}; hipLaunchKernelGGL(chk_weights, dim3(64), dim3(256), 0, st, a, c, code); }
        hipLaunchKernelGGL(chk_tables, dim3(256), dim3(256), 0, st, a, code + 40);
        return;
    }
    if (ph == 1) { hipLaunchKernelGGL(chk_modvec, dim3(12), dim3(256), 0, st, a, code); return; }
    if (ph == PH_FINAL) { ChkN c{XA, a.out, Yb, vec + (size_t)3 * 12 * DM + 5 * DM, nullptr, nullptr, nullptr, nullptr, nullptr, nullptr}; hipLaunchKernelGGL(chk_norm, dim3(64), dim3(256), 0, st, a, c, code); return; }
    const int r = ph - 2, l = r / 7, j = r % 7, kind = l % 3, jj = l / 3, half = j >= 4, s = 2 * l + half;
    const float* lv = vec + (size_t)l * 12 * DM;
    if (j == 0 || j == 4) {
        const float* xin = (s == 0 || s == 1) ? a.in[0] : (((s - 1) & 1) ? XA : (const float*)a.out); const float* xout = (s == 0) ? nullptr : ((s & 1) ? XA : (const float*)a.out);
        const float* gsrc = (s == 0) ? nullptr : (half ? lv + 2 * DM : vec + (size_t)(l - 1) * 12 * DM + 5 * DM);
        const bool fox = (!half && kind == 0);
        ChkN c{xin, xout, s == 0 ? nullptr : Yb, gsrc, half ? lv + 3 * DM : lv, half ? lv + 4 * DM : lv + DM, Hb, fox ? a.in[11] + (size_t)jj * DM * FOX_IN : nullptr, a.in[12] + jj * 16, (const float*)(ws + WS_LOGF)};
        hipLaunchKernelGGL(chk_norm, dim3(64), dim3(256), 0, st, a, c, code); return;
    }
    if (j == 1) {
        if (kind == 0) { hipLaunchKernelGGL(chk_scan, dim3(1), dim3(128), 0, st, a, code + 80);
            ChkG c = mkG(Hb, DM, a.in[11] + (size_t)jj * DM * FOX_IN, FOX_IN, FOX_N, 0, Pb, FOX_N, 2048, FOX_QSCALE, nullptr); hipLaunchKernelGGL(chk_gemm, dim3(64), dim3(256), 0, st, a, c, code); }
        else if (kind == 1) { ChkG c = mkG(Hb, DM, a.in[14], SGU_N, SGU_N, 1, Pb, SGU_N, 0, 1.f, (const float*)(ws + WS_VSTAT)); hipLaunchKernelGGL(chk_gemm, dim3(64), dim3(256), 0, st, a, c, code); }
        else { ChkG c = mkG(Hb, DM, a.in[20], SWA_N, SWA_N, 0, Pb, SWA_N, 0, 1.f, nullptr); hipLaunchKernelGGL(chk_gemm, dim3(64), dim3(256), 0, st, a, c, code); }
        return;
    }
    if (j == 2) { if (kind == 0) hipLaunchKernelGGL(chk_fox, dim3(128), dim3(256), 0, st, a, code); else if (kind == 1) hipLaunchKernelGGL(chk_sgu, dim3(48), dim3(128), 0, st, a, code); else hipLaunchKernelGGL(chk_swa, dim3(64), dim3(64), 0, st, a, code); return; }
    if (j == 3) { const float* W = kind == 0 ? a.in[13] + (size_t)jj * DM * DM : kind == 1 ? a.in[19] : a.in[22];
        ChkG c = mkG(Ob, DM, W, DM, DM, 3, Yb, DM, 0, 1.f, (const float*)(ws + WS_YSTAT)); hipLaunchKernelGGL(chk_gemm, dim3(64), dim3(256), 0, st, a, c, code); return; }
    if (j == 5) { ChkG c = mkG(Hb, DM, a.in[9] + (size_t)l * DM * 2 * DFF, 2 * DFF, DFF, 2, Pb, DFF, 0, 1.f, nullptr); hipLaunchKernelGGL(chk_gemm, dim3(64), dim3(256), 0, st, a, c, code); return; }
    if (j == 6) { ChkG c = mkG(Pb, DFF, a.in[10] + (size_t)l * DFF * DM, DM, DM, 3, Yb, DM, 0, 1.f, (const float*)(ws + WS_YSTAT)); hipLaunchKernelGGL(chk_gemm, dim3(64), dim3(256), 0, st, a, c, code); return; }
}
#endif
```

```cpp
#include <hip/hip_runtime.h>
#include <cstdio>
#include <cstdint>
#include <cmath>

#define PROBE_REPEAT 0
#define PROBE_STAMP 0
#define PROBE_SEL(k) 1
#ifndef DBG
#define DBG 0
#endif

namespace pg8 {
#define PG8_LAS __attribute__((address_space(3)))
typedef unsigned short bf16_t;
typedef short bf16x8 __attribute__((ext_vector_type(8)));
typedef float f32x4 __attribute__((ext_vector_type(4)));
typedef unsigned u32x4 __attribute__((ext_vector_type(4)));
constexpr int BM = 256, BK = 64, HALF = 128, HTB = HALF * BK * 2  , STAGE_BYTES = 8 * HTB, NXCD = 8, WGM = 8;

__host__ __device__ __forceinline__ int lds_byte(int r, int c) { const int st = (r >> 4) * 2 + (c >> 5), rr = r & 15, cc = c & 31, ob = rr * 64 + cc * 2; return st * 1024 + (ob ^ (((ob >> 9) & 1) << 5)); }
__host__ __device__ __forceinline__ void stage_rc(int b, int& R, int& C) { const int st = b / 1024, sb = b % 1024, swz = sb ^ (((sb >> 9) & 1) << 5); R = (st >> 1) * 16 + swz / 64; C = (st & 1) * 32 + (swz % 64) / 2; }
__host__ __device__ __forceinline__ int perm32(int rho) { const int n = rho >> 4, i = rho & 15; return 8 * (i >> 2) + 4 * n + (i & 3); }

struct Unit { int pm, pn; };
struct Gemm { const bf16_t* A; const bf16_t* Bt; int M, N, K; };

struct StaticOrder {
    int nM, nN, nwg, G, c;
    __host__ __device__ void init(int M, int N, int G_, int c_) { nM = M / BM; nN = N / BM; nwg = nM * nN; G = G_; c = c_; }
    __host__ __device__ bool next(int i, Unit& u) const {
        const long L = (long)i * G + c; if (L >= nwg) return false;
        int wgid = (int)L; { const int q = nwg / NXCD, r = nwg % NXCD, xcd = wgid % NXCD, off = wgid / NXCD; wgid = (xcd < r ? xcd * (q + 1) : r * (q + 1) + (xcd - r) * q) + off; }
        const int nig = WGM * nN, gid = wgid / nig, fm = gid * WGM, gsz = (nM - fm) < WGM ? (nM - fm) : WGM;
        u.pm = fm + ((wgid % nig) % gsz); u.pn = (wgid % nig) / gsz; return true;
    }
    __device__ __forceinline__ void a_ready(const Unit&) const {}
    __device__ __forceinline__ void done(const Unit&) const {}
};

__device__ __forceinline__ unsigned cvt_pk_bf16(float lo, float hi) { unsigned r; asm volatile("v_cvt_pk_bf16_f32 %0, %1, %2" : "=v"(r) : "v"(lo), "v"(hi)); return r; }
typedef float f32x2 __attribute__((ext_vector_type(2)));
typedef unsigned u32x2 __attribute__((ext_vector_type(2)));
__device__ __forceinline__ float fast_sigmoid(float x) { return __builtin_amdgcn_rcpf(1.0f + __builtin_amdgcn_exp2f(-1.4426950408889634f * x)); }
struct EpiProj {
    static constexpr bool PERM = true, AFTER_DRAIN = false;
    bf16_t* O; int ldc; int qcols; float qscale; float* knorm;
    __device__ __forceinline__ void operator()(const f32x4 (&acc)[2][2][4][2], const Unit& u, int wr, int wc, int fr, int fq) const {
        const int row0 = u.pm * BM + wr * 64 + fr, colt = u.pn * BM, col0 = colt + wc * 32 + 8 * fq;
        const float sc = colt < qcols ? qscale : 1.0f;
#pragma unroll
        for (int ai = 0; ai < 2; ++ai)
#pragma unroll
            for (int m = 0; m < 4; ++m) { bf16_t* rowp = O + (size_t)(row0 + ai * HALF + m * 16) * ldc + col0;
#pragma unroll
                for (int bj = 0; bj < 2; ++bj) { const f32x4 v0 = acc[ai][bj][m][0] * sc, v1 = acc[ai][bj][m][1] * sc;
                    u32x4 w; w.x = cvt_pk_bf16(v0[0], v0[1]); w.y = cvt_pk_bf16(v0[2], v0[3]); w.z = cvt_pk_bf16(v1[0], v1[1]); w.w = cvt_pk_bf16(v1[2], v1[3]);
                    *(u32x4*)(rowp + bj * HALF) = w; } }
        if (knorm && colt >= 2048 && colt < 4096) {
#pragma unroll
            for (int ai = 0; ai < 2; ++ai)
#pragma unroll
                for (int bj = 0; bj < 2; ++bj) { float mx = 0.f;
#pragma unroll
                    for (int m = 0; m < 4; ++m) { const f32x4 v0 = acc[ai][bj][m][0], v1 = acc[ai][bj][m][1];
                        float q = (v0[0] * v0[0] + v0[1] * v0[1]) + (v0[2] * v0[2] + v0[3] * v0[3]) + (v1[0] * v1[0] + v1[1] * v1[1]) + (v1[2] * v1[2] + v1[3] * v1[3]);
                        q += __shfl_xor(q, 16); q += __shfl_xor(q, 32); mx = fmaxf(mx, q); }
                    mx = fmaxf(mx, __shfl_xor(mx, 1)); mx = fmaxf(mx, __shfl_xor(mx, 2)); mx = fmaxf(mx, __shfl_xor(mx, 4)); mx = fmaxf(mx, __shfl_xor(mx, 8));
                    const int rowt = u.pm * BM + ai * HALF + wr * 64, bb = rowt >> 13, tile = (rowt & 8191) >> 6, head = ((colt - 2048) >> 7) + bj;
                    if (fr == 0 && fq == 0) knorm[((size_t)(bb * 16 + head) * 128 + tile) * 4 + wc] = mx; }
        }
    }
};
struct EpiSwiglu {
    static constexpr bool PERM = true, AFTER_DRAIN = false;
    bf16_t* Z; int ldz;
    __device__ __forceinline__ void operator()(const f32x4 (&acc)[2][2][4][2], const Unit& u, int wr, int wc, int fr, int fq) const {
        const int row0 = u.pm * BM + wr * 64 + fr, col0 = u.pn * HALF + wc * 32 + 8 * fq;
#pragma unroll
        for (int ai = 0; ai < 2; ++ai)
#pragma unroll
            for (int m = 0; m < 4; ++m) { bf16_t* rowp = Z + (size_t)(row0 + ai * HALF + m * 16) * ldz + col0;
                f32x4 z0, z1;
#pragma unroll
                for (int i = 0; i < 4; ++i) { const float g0 = acc[ai][0][m][0][i], g1 = acc[ai][0][m][1][i];
                    z0[i] = g0 * fast_sigmoid(g0) * acc[ai][1][m][0][i]; z1[i] = g1 * fast_sigmoid(g1) * acc[ai][1][m][1][i]; }
                u32x4 w; w.x = cvt_pk_bf16(z0[0], z0[1]); w.y = cvt_pk_bf16(z0[2], z0[3]); w.z = cvt_pk_bf16(z1[0], z1[1]); w.w = cvt_pk_bf16(z1[2], z1[3]);
                *(u32x4*)rowp = w; }
    }
};
struct EpiOut {
    static constexpr bool PERM = true, AFTER_DRAIN = false;
    bf16_t* Y; int ldc; float* stat;
    __device__ __forceinline__ void operator()(const f32x4 (&acc)[2][2][4][2], const Unit& u, int wr, int wc, int fr, int fq) const {
        const int row0 = u.pm * BM + wr * 64 + fr, col0 = u.pn * BM + wc * 32 + 8 * fq;
#pragma unroll
        for (int ai = 0; ai < 2; ++ai)
#pragma unroll
            for (int m = 0; m < 4; ++m) { const int row = row0 + ai * HALF + m * 16; bf16_t* rowp = Y + (size_t)row * ldc + col0; float q = 0.f;
#pragma unroll
                for (int bj = 0; bj < 2; ++bj) { const f32x4 v0 = acc[ai][bj][m][0], v1 = acc[ai][bj][m][1];
                    q += (v0[0] * v0[0] + v0[1] * v0[1]) + (v0[2] * v0[2] + v0[3] * v0[3]) + (v1[0] * v1[0] + v1[1] * v1[1]) + (v1[2] * v1[2] + v1[3] * v1[3]);
                    u32x4 w; w.x = cvt_pk_bf16(v0[0], v0[1]); w.y = cvt_pk_bf16(v0[2], v0[3]); w.z = cvt_pk_bf16(v1[0], v1[1]); w.w = cvt_pk_bf16(v1[2], v1[3]);
                    *(u32x4*)(rowp + bj * HALF) = w; }
                q += __shfl_xor(q, 16); q += __shfl_xor(q, 32);
                if (fq == 0) stat[(size_t)row * 32 + 4 * u.pn + wc] = q; }
    }
};
__device__ __forceinline__ float gelu_tanh_f(float x) { const float t = 1.5957691216057308f * (x + 0.044715f * x * x * x); return x * fast_sigmoid(t); }
struct EpiSguIn {
    static constexpr bool PERM = true, AFTER_DRAIN = false;
    bf16_t* O; int ldc; float* stat2;
    __device__ __forceinline__ void operator()(const f32x4 (&acc)[2][2][4][2], const Unit& u, int wr, int wc, int fr, int fq) const {
        const int row0 = u.pm * BM + wr * 64 + fr, col0 = u.pn * BM + wc * 32 + 8 * fq; const bool vhalf = u.pn >= 8;
#pragma unroll
        for (int ai = 0; ai < 2; ++ai)
#pragma unroll
            for (int m = 0; m < 4; ++m) { const int row = row0 + ai * HALF + m * 16; bf16_t* rowp = O + (size_t)row * ldc + col0; float s = 0.f, q = 0.f;
#pragma unroll
                for (int bj = 0; bj < 2; ++bj) { f32x4 v0, v1;
#pragma unroll
                    for (int i = 0; i < 4; ++i) { v0[i] = gelu_tanh_f(acc[ai][bj][m][0][i]); v1[i] = gelu_tanh_f(acc[ai][bj][m][1][i]); }
                    s += (v0[0] + v0[1]) + (v0[2] + v0[3]) + (v1[0] + v1[1]) + (v1[2] + v1[3]);
                    q += (v0[0] * v0[0] + v0[1] * v0[1]) + (v0[2] * v0[2] + v0[3] * v0[3]) + (v1[0] * v1[0] + v1[1] * v1[1]) + (v1[2] * v1[2] + v1[3] * v1[3]);
                    u32x4 w; w.x = cvt_pk_bf16(v0[0], v0[1]); w.y = cvt_pk_bf16(v0[2], v0[3]); w.z = cvt_pk_bf16(v1[0], v1[1]); w.w = cvt_pk_bf16(v1[2], v1[3]);
                    *(u32x4*)(rowp + bj * HALF) = w; }
                if (vhalf) { s += __shfl_xor(s, 16); s += __shfl_xor(s, 32); q += __shfl_xor(q, 16); q += __shfl_xor(q, 32);
                    if (fq == 0) { float* sp = stat2 + ((size_t)row * 32 + 4 * (u.pn - 8) + wc) * 2; sp[0] = s; sp[1] = q; } } }
    }
};
template <class Epi, class Sched, bool ALIGN_EPI = false, bool SP2 = false>
__device__ __forceinline__ void gemm_phase(PG8_LAS unsigned char* lds, const Gemm g, const Sched& S, const Epi& E) {
    int tid_ = threadIdx.x; asm volatile("" : "+v"(tid_));
    const int tid = tid_, wid = __builtin_amdgcn_readfirstlane(tid >> 6), lane = tid & 63, wr = wid >> 2, wc = wid & 3, fr = lane & 15, fq = lane >> 4;
    const int K = g.K, nt = K / BK;
    unsigned voffA[2], voffB[2];
#pragma unroll
    for (int i = 0; i < 2; ++i) { int R, C; stage_rc(tid * 16 + i * 8192, R, C); const int Rb = Epi::PERM ? ((R & ~31) + perm32(R & 31)) : R;
        voffA[i] = (unsigned)(R * K + C) * 2u; voffB[i] = (unsigned)(Rb * K + C) * 2u; }
    const size_t kstep = (size_t)(BK * 2);
    const size_t hstep = (size_t)HALF * K * 2;
    const size_t tstep = 2 * hstep;
    const unsigned ldsw = (unsigned)wid * 1024u;
    const int aoff = lds_byte(wr * 64 + fr, fq * 8), boff = lds_byte(wc * 32 + fr, fq * 8);
#define PG8_SA(b, h) (((b) * 2 + (h)) * HTB)
#define PG8_SB(b, h) ((4 + (b) * 2 + (h)) * HTB)
#define PG8_STAGE(bufoff, gbase, voff) do { _Pragma("unroll") for (int _i = 0; _i < 2; ++_i) \
        __builtin_amdgcn_global_load_lds((const unsigned*)((const char*)(gbase) + (voff)[_i]), (PG8_LAS unsigned*)(lds + (bufoff) + ldsw + _i * 8192), 16, 0, 0); } while (0)
#define PG8_LDA(dst, b, h) do { _Pragma("unroll") for (int m = 0; m < 4; ++m) _Pragma("unroll") for (int k = 0; k < 2; ++k) dst[m][k] = *(const PG8_LAS bf16x8*)(lds + PG8_SA(b, h) + aoff + m * 2048 + k * 1024); } while (0)
#define PG8_LDB(dst, b, h) do { _Pragma("unroll") for (int n = 0; n < 2; ++n) _Pragma("unroll") for (int k = 0; k < 2; ++k) dst[n][k] = *(const PG8_LAS bf16x8*)(lds + PG8_SB(b, h) + boff + n * 2048 + k * 1024); } while (0)
#define PG8_MMA(ai, bj, At, Bt) do { __builtin_amdgcn_s_setprio(1); _Pragma("unroll") for (int m = 0; m < 4; ++m) _Pragma("unroll") for (int n = 0; n < 2; ++n) _Pragma("unroll") for (int k = 0; k < 2; ++k) \
        acc[ai][bj][m][n] = __builtin_amdgcn_mfma_f32_16x16x32_bf16(Bt[n][k], At[m][k], acc[ai][bj][m][n], 0, 0, 0); __builtin_amdgcn_s_setprio(0); } while (0)
#define PG8_WAIT_V(n) asm volatile("s_waitcnt vmcnt(" #n ")" ::: "memory")
#define PG8_WAIT_L(n) asm volatile("s_waitcnt lgkmcnt(" #n ")" ::: "memory")
#define PG8_BAR __builtin_amdgcn_s_barrier()
#define PG8_SCHED __builtin_amdgcn_sched_barrier(0)
    Unit cur, nxt; int ui = 0;
    if (!S.next(0, cur)) return;
    f32x4 acc[2][2][4][2];
#pragma unroll
    for (int a = 0; a < 2; ++a)
#pragma unroll
        for (int b = 0; b < 2; ++b)
#pragma unroll
            for (int m = 0; m < 4; ++m)
#pragma unroll
                for (int n = 0; n < 2; ++n) acc[a][b][m][n] = (f32x4){0.f, 0.f, 0.f, 0.f};
    bf16x8 At[4][2], B0[2][2], B1[2][2];
    const char* cA = (const char*)g.A + (size_t)cur.pm * tstep; const char* cB = (const char*)g.Bt + (size_t)cur.pn * tstep;
    S.a_ready(cur);
    if constexpr (SP2) {
        PG8_STAGE(PG8_SB(0, 0), cB, voffB); PG8_STAGE(PG8_SB(0, 1), cB + hstep, voffB); PG8_STAGE(PG8_SA(0, 0), cA, voffA); PG8_STAGE(PG8_SA(0, 1), cA + hstep, voffA);
        if (wr == 1) PG8_BAR;
        PG8_WAIT_V(2); PG8_BAR;
        PG8_STAGE(PG8_SB(1, 0), cB + kstep, voffB); PG8_STAGE(PG8_SA(1, 0), cA + kstep, voffA); PG8_STAGE(PG8_SB(1, 1), cB + hstep + kstep, voffB);
        PG8_WAIT_V(6); PG8_BAR;
    } else {
        PG8_STAGE(PG8_SB(0, 0), cB, voffB); PG8_STAGE(PG8_SA(0, 0), cA, voffA); PG8_STAGE(PG8_SB(0, 1), cB + hstep, voffB); PG8_STAGE(PG8_SA(0, 1), cA + hstep, voffA);
        if (wr == 1) PG8_BAR;
        PG8_WAIT_V(4); PG8_BAR;
        PG8_STAGE(PG8_SB(1, 0), cB + kstep, voffB); PG8_STAGE(PG8_SA(1, 0), cA + kstep, voffA); PG8_STAGE(PG8_SB(1, 1), cB + hstep + kstep, voffB);
        PG8_WAIT_V(6); PG8_BAR;
    }
    for (;;) {
        const bool has_next = S.next(ui + 1, nxt);
        const char* nA = has_next ? (const char*)g.A + (size_t)nxt.pm * tstep : cA; const char* nB = has_next ? (const char*)g.Bt + (size_t)nxt.pn * tstep : cB;
        for (int t = 0; t < nt; t += 2) {
            const bool last = (t == nt - 2);
            const char* a1 = cA + (size_t)(t + 1) * kstep;
            const char* a2 = last ? nA : cA + (size_t)(t + 2) * kstep; const char* b2 = last ? nB : cB + (size_t)(t + 2) * kstep;
            const char* a3 = a2 + kstep; const char* b3 = b2 + kstep;
            if (last && has_next) S.a_ready(nxt);
            if constexpr (SP2) {
            PG8_LDB(B0, 0, 0); PG8_LDB(B1, 0, 1); PG8_SCHED; PG8_LDA(At, 0, 0); PG8_STAGE(PG8_SA(1, 1), a1 + hstep, voffA);
            PG8_WAIT_V(8); PG8_WAIT_L(0); PG8_BAR; PG8_MMA(0, 0, At, B0); PG8_MMA(0, 1, At, B1); PG8_BAR; PG8_SCHED;
            PG8_LDA(At, 0, 1); PG8_STAGE(PG8_SB(0, 0), b2, voffB); PG8_STAGE(PG8_SB(0, 1), b2 + hstep, voffB); PG8_STAGE(PG8_SA(0, 0), a2, voffA);
            PG8_WAIT_V(8); PG8_WAIT_L(0); PG8_BAR; PG8_MMA(1, 0, At, B0); PG8_MMA(1, 1, At, B1); PG8_BAR; PG8_SCHED;
            PG8_LDB(B0, 1, 0); PG8_LDB(B1, 1, 1); PG8_SCHED; PG8_LDA(At, 1, 0); PG8_STAGE(PG8_SA(0, 1), a2 + hstep, voffA);
            PG8_WAIT_V(8); PG8_WAIT_L(0); PG8_BAR; PG8_MMA(0, 0, At, B0); PG8_MMA(0, 1, At, B1); PG8_BAR; PG8_SCHED;
            PG8_LDA(At, 1, 1); PG8_STAGE(PG8_SB(1, 0), b3, voffB); PG8_STAGE(PG8_SB(1, 1), b3 + hstep, voffB); PG8_STAGE(PG8_SA(1, 0), a3, voffA);
            PG8_WAIT_V(8); PG8_WAIT_L(0); PG8_BAR; PG8_MMA(1, 0, At, B0); PG8_MMA(1, 1, At, B1); PG8_BAR; PG8_SCHED;
            } else {
            PG8_LDB(B0, 0, 0); PG8_SCHED; PG8_LDA(At, 0, 0); PG8_STAGE(PG8_SA(1, 1), a1 + hstep, voffA);
            PG8_WAIT_L(8); PG8_BAR; PG8_WAIT_L(0); PG8_MMA(0, 0, At, B0); PG8_BAR; PG8_SCHED;
            PG8_LDB(B1, 0, 1); PG8_STAGE(PG8_SB(0, 0), b2, voffB);
            PG8_BAR; PG8_WAIT_L(0); PG8_MMA(0, 1, At, B1); PG8_BAR;
            PG8_LDA(At, 0, 1); PG8_STAGE(PG8_SA(0, 0), a2, voffA);
            PG8_BAR; PG8_WAIT_L(0); PG8_MMA(1, 0, At, B0); PG8_BAR; PG8_SCHED;
            PG8_STAGE(PG8_SB(0, 1), b2 + hstep, voffB);
            PG8_WAIT_V(6); PG8_BAR; PG8_MMA(1, 1, At, B1); PG8_BAR;
            PG8_LDB(B0, 1, 0); PG8_SCHED; PG8_LDA(At, 1, 0); PG8_STAGE(PG8_SA(0, 1), a2 + hstep, voffA);
            PG8_WAIT_L(8); PG8_BAR; PG8_WAIT_L(0); PG8_MMA(0, 0, At, B0); PG8_BAR; PG8_SCHED;
            PG8_LDB(B1, 1, 1); PG8_STAGE(PG8_SB(1, 0), b3, voffB);
            PG8_BAR; PG8_WAIT_L(0); PG8_MMA(0, 1, At, B1); PG8_BAR;
            PG8_LDA(At, 1, 1); PG8_STAGE(PG8_SA(1, 0), a3, voffA);
            PG8_BAR; PG8_WAIT_L(0); PG8_MMA(1, 0, At, B0); PG8_BAR; PG8_SCHED;
            PG8_STAGE(PG8_SB(1, 1), b3 + hstep, voffB);
            PG8_WAIT_V(6); PG8_BAR; PG8_MMA(1, 1, At, B1); PG8_BAR;
            }
        }
        if constexpr (ALIGN_EPI) { if (wr == 0) PG8_BAR; }
        if constexpr (!Epi::AFTER_DRAIN) { E(acc, cur, wr, wc, fr, fq); S.done(cur); }
        if (!has_next) break;
#pragma unroll
        for (int a = 0; a < 2; ++a)
#pragma unroll
            for (int b = 0; b < 2; ++b)
#pragma unroll
                for (int m = 0; m < 4; ++m)
#pragma unroll
                    for (int n = 0; n < 2; ++n) acc[a][b][m][n] = (f32x4){0.f, 0.f, 0.f, 0.f};
        cur = nxt; cA = nA; cB = nB; ++ui;
        if constexpr (ALIGN_EPI) { if (wr == 1) PG8_BAR; }
    }
    PG8_WAIT_V(0);
    if constexpr (!ALIGN_EPI) { if (wr == 0) PG8_BAR; }
    PG8_BAR;
    if constexpr (Epi::AFTER_DRAIN) { E.fused(acc, cur, wr, wc, fr, fq, lds, wid, lane); S.done(cur); }
#undef PG8_SA
#undef PG8_SB
#undef PG8_STAGE
#undef PG8_LDA
#undef PG8_LDB
#undef PG8_MMA
#undef PG8_WAIT_V
#undef PG8_WAIT_L
#undef PG8_BAR
#undef PG8_SCHED
}
}
#define GAS __attribute__((address_space(1)))
#define LAS __attribute__((address_space(3)))
typedef unsigned short bf16;
typedef unsigned v4u __attribute__((ext_vector_type(4)));
typedef float f32x4 __attribute__((ext_vector_type(4)));
typedef short bf16x8 __attribute__((ext_vector_type(8)));
typedef GAS unsigned gu32;
typedef GAS unsigned long long gu64;
#define RLX_AGENT __ATOMIC_RELAXED, __HIP_MEMORY_SCOPE_AGENT
#define LDS_WAIT() asm volatile("s_waitcnt lgkmcnt(0)" ::: "memory")
#define VM_WAIT() asm volatile("s_waitcnt vmcnt(0)" ::: "memory")
__device__ __forceinline__ unsigned long long rt() { return __builtin_amdgcn_s_memrealtime(); }
__device__ __forceinline__ unsigned f2bf(float f) { unsigned u = __builtin_bit_cast(unsigned, f); return (u + 0x7fffu + ((u >> 16) & 1u)) >> 16; }
__device__ __forceinline__ unsigned pk2(float lo, float hi) { return f2bf(lo) | (f2bf(hi) << 16); }
#define XB_TMO      128
#define XB_XCNT(j)  (256  + 64 * (j))
#define XB_XSUB(j)  (1280 + 64 * (j))
#define XB_XGEN(j)  (2304 + 64 * (j))
#define XB_TOP      3328
#define XB_TOPGEN   3392
#define XCD_BAR_WORDS 3456
#define XB_SPIN_CAP (1u << 18)

__device__ __forceinline__ unsigned xb_ld(unsigned* p)              { return __hip_atomic_load(p, __ATOMIC_RELAXED, __HIP_MEMORY_SCOPE_AGENT); }
__device__ __forceinline__ unsigned xb_add(unsigned* p, unsigned v) { return __hip_atomic_fetch_add(p, v, __ATOMIC_RELAXED, __HIP_MEMORY_SCOPE_AGENT); }
__device__ __forceinline__ unsigned xb_xcc_id() { return (unsigned)__builtin_amdgcn_s_getreg((3 << 11) | 20) & 0xFu; }
#define XB_SPIN(cond, bar) do { unsigned _sp = 0; while (cond) { __builtin_amdgcn_s_sleep(1); \
    if ((++_sp & 255u) == 0u) { if (xb_ld(&(bar)[XB_TMO])) break; if (_sp > XB_SPIN_CAP) { atomicAdd(&(bar)[XB_TMO], 1u); break; } } } } while (0)

struct XcdBarrier {
    unsigned* bar; unsigned x;
    volatile LAS unsigned* st;
};

__device__ __forceinline__ XcdBarrier xcd_barrier_post(unsigned* bar, volatile LAS unsigned* st) {
    XcdBarrier b; b.bar = bar; b.x = xb_xcc_id(); b.st = st;
    if (threadIdx.x == 0) (void)xb_add(&bar[XB_XCNT(b.x)], 1u);
    return b;
}
__device__ __forceinline__ void xcd_barrier_complete(unsigned* bar, unsigned x, unsigned& nloc, unsigned& nx) {
    const unsigned G = gridDim.x * gridDim.y * gridDim.z;
    unsigned sum, cnt, mine, sp = 0u;
    for (;;) {
        sum = 0u; cnt = 0u; mine = 0u;
#pragma unroll
        for (unsigned j = 0; j < 16; ++j) { const unsigned c = xb_ld(&bar[XB_XCNT(j)]); sum += c; cnt += (c > 0u) ? 1u : 0u; mine = (j == x) ? c : mine; }
        if (sum == G) break;
        __builtin_amdgcn_s_sleep(1);
        if ((++sp & 255u) == 0u) { if (xb_ld(&bar[XB_TMO])) break; if (sp > XB_SPIN_CAP) { atomicAdd(&bar[XB_TMO], 1u); break; } }
    }
    nloc = mine > 0u ? mine : 1u; nx = cnt > 0u ? cnt : 1u;
}

__device__ __forceinline__ void xcd_barrier(const XcdBarrier& b) {
    asm volatile("s_waitcnt vmcnt(0)" ::: "memory");
    __syncthreads();
    if (threadIdx.x == 0) {
        unsigned* bar = b.bar;
        __builtin_amdgcn_s_waitcnt(0);
        unsigned nloc = b.st[0], nx = b.st[1];
        if (nloc == 0u) { xcd_barrier_complete(bar, b.x, nloc, nx); b.st[0] = nloc; b.st[1] = nx; }
        const unsigned old = xb_add(&bar[XB_XSUB(b.x)], 1u);
        const unsigned gen = old / nloc;
        if (old + 1u == (gen + 1u) * nloc) {
            __builtin_amdgcn_fence(__ATOMIC_RELEASE, "agent");
            asm volatile("s_waitcnt vmcnt(0)" ::: "memory");
            const unsigned og = xb_add(&bar[XB_TOP], 1u);
            const unsigned tg = og / nx;
            if (og + 1u == (tg + 1u) * nx) xb_add(&bar[XB_TOPGEN], 1u);
            else XB_SPIN(xb_ld(&bar[XB_TOPGEN]) == tg, bar);
            __builtin_amdgcn_fence(__ATOMIC_ACQUIRE, "agent");
            xb_add(&bar[XB_XGEN(b.x)], 1u);
            asm volatile("s_waitcnt vmcnt(0)" ::: "memory");
        } else {
            XB_SPIN(xb_ld(&bar[XB_XGEN(b.x)]) == gen, bar);
            __builtin_amdgcn_fence(__ATOMIC_ACQUIRE, "agent");
            asm volatile("s_waitcnt vmcnt(0)" ::: "memory");
        }
    }
    __syncthreads();
}
typedef float f32x16 __attribute__((ext_vector_type(16)));
typedef unsigned u32x2 __attribute__((ext_vector_type(2)));
typedef short s16x4 __attribute__((ext_vector_type(4)));
typedef unsigned u32x4 __attribute__((ext_vector_type(4)));
__device__ __forceinline__ float bf2f(unsigned h) { return __builtin_bit_cast(float, h << 16); }

constexpr int NWAVES = 8, NTHR = 512;
constexpr int BATCH = 2, SEQ = 8192, DM = 2048, M = BATCH * SEQ, DEPTH = 4, DFF = 5632;
constexpr int FOX_H = 16, FOX_D = 128, FOX_IN = 6160, FOX_N = 6144;
constexpr int SWA_D = 64, SWA_HQ = 32, SWA_HK = 8, SWA_N = 3072;
constexpr int SGU_N = 4096;
constexpr float EPS = 1e-6f, LOG2E = 1.4426950408889634f;
constexpr float FOX_QSCALE = 0.08838834764831845f * LOG2E;
constexpr float SWA_QSCALE = 0.125f * LOG2E;
constexpr int MOD_KS = 32;

constexpr size_t MiB = 1u << 20;
constexpr size_t WS_CTL = 0, CTL_ZERO_BYTES = 1 * MiB;
constexpr size_t WS_VEC = 1 * MiB;
constexpr size_t WS_ROPE = 2 * MiB;
constexpr size_t WS_WFG = 3 * MiB;
constexpr size_t WS_WSM = 3 * MiB + 512 * 1024;
constexpr size_t WS_LOGF = 4 * MiB;
constexpr size_t WS_CUM = 5 * MiB;
constexpr size_t WS_KNORM = 1 * MiB + 512 * 1024;
constexpr size_t WS_YSTAT = 6 * MiB;
constexpr size_t WS_VSTAT = 8 * MiB;
constexpr size_t WS_MODP = 12 * MiB;
constexpr size_t WS_WGU = 24 * MiB, WGU_BYTES = 44 * MiB;
constexpr size_t WS_WDN = 200 * MiB, WDN_BYTES = 22 * MiB;
constexpr size_t WS_WFOXIN = 288 * MiB, WFOXIN_BYTES = 24 * MiB;
constexpr size_t WS_WFOXOUT = 336 * MiB, WSQ_BYTES = 8 * MiB;
constexpr size_t WS_WSGUIN = 352 * MiB, WS_WSGUOUT = 368 * MiB, WS_WSWAIN = 376 * MiB, WS_WSWAOUT = 388 * MiB;
constexpr size_t WS_H = 396 * MiB;
constexpr size_t WS_PROJ = 460 * MiB;
constexpr size_t WS_O = 652 * MiB;
constexpr size_t WS_Y = 716 * MiB;
constexpr size_t WS_XA = 780 * MiB;
constexpr size_t WS_END = 908 * MiB;
constexpr int CW_TMO = 0, CW_CODE = 1, CW_BAR = 4096, CW_ERR = 8192, CW_ERRV = 8193, CW_NCHK = 8194, CW_TICKET = 8256;

constexpr int RING_BYTES = 131072, LDSCTL_OFF = RING_BYTES, MISC_OFF = LDSCTL_OFF + 320, LDS_BYTES = 147456;

struct Args { const float* in[23]; float* out; unsigned char* ws; int ph_lo, ph_hi; };
static_assert(sizeof(Args) == 25 * 8 + 8, "Args has no padding");

struct Frame {
    LAS unsigned char* lds;
    int tid, lane, wave, vcu, G;
};
__device__ __forceinline__ Frame launder(const Frame& Fi) { Frame F = Fi; asm volatile("" : "+v"(F.tid)); F.lane = F.tid & 63; F.wave = __builtin_amdgcn_readfirstlane(F.tid >> 6); asm volatile("" : "+s"(F.vcu)); return F; }
__device__ __forceinline__ float wave_sum(float v) {
#pragma unroll
    for (int o = 1; o < 64; o <<= 1) v += __shfl_xor(v, o);
    return v;
}
__device__ __forceinline__ float wave_max(float v) {
#pragma unroll
    for (int o = 1; o < 64; o <<= 1) v = fmaxf(v, __shfl_xor(v, o));
    return v;
}

__device__ __forceinline__ void p0_transpose_item(const float* W, int ldw, int K, bf16* WT, int k0, int n0, int c0, LAS float* scr, int lane) {
#pragma unroll 8
    for (int i = 0; i < 32; ++i) { const int kk = 2 * i + (lane >> 5); scr[kk * 33 + (lane & 31)] = W[(size_t)(k0 + kk) * ldw + c0 + (lane & 31)]; }
    LDS_WAIT(); asm volatile("" ::: "memory");
    const int c = lane & 7;
#pragma unroll
    for (int j = 0; j < 4; ++j) { const int n = (lane >> 3) + 8 * j; const LAS float* s = scr + (8 * c) * 33 + n;
        v4u o; o.x = pk2(s[0 * 33], s[1 * 33]); o.y = pk2(s[2 * 33], s[3 * 33]); o.z = pk2(s[4 * 33], s[5 * 33]); o.w = pk2(s[6 * 33], s[7 * 33]);
        *(GAS v4u*)(WT + (size_t)(n0 + n) * K + k0 + 8 * c) = o; }
    LDS_WAIT(); asm volatile("" ::: "memory");
}
constexpr int IT_GU = 32 * 352, IT_DN = 88 * 64, IT_FOXIN = 32 * 192, IT_SQ = 32 * 64, IT_SGUIN = 32 * 128, IT_SWAIN = 32 * 96;
constexpr int IT_TOTAL = 4 * IT_GU + 4 * IT_DN + 2 * IT_FOXIN + 2 * IT_SQ + IT_SGUIN + IT_SQ + IT_SWAIN + IT_SQ;
constexpr int MOD_CHUNKS = 12288 / 256;
constexpr int IT_MOD = DEPTH * MOD_KS * MOD_CHUNKS;
__device__ __forceinline__ void conv_item(const Args& a, int r, LAS float* scr, int lane) {
    unsigned char* ws = a.ws;
    const float* W; int ldw, K, N; bf16* WT; int gu = 0;
    if (r < 4 * IT_GU) { const int l = r / IT_GU; r -= l * IT_GU; W = a.in[9] + (size_t)l * DM * 2 * DFF; ldw = 2 * DFF; K = DM; N = 2 * DFF; WT = (bf16*)(ws + WS_WGU + l * WGU_BYTES); gu = 1; }
    else { r -= 4 * IT_GU;
    if (r < 4 * IT_DN) { const int l = r / IT_DN; r -= l * IT_DN; W = a.in[10] + (size_t)l * DFF * DM; ldw = DM; K = DFF; N = DM; WT = (bf16*)(ws + WS_WDN + l * WDN_BYTES); }
    else { r -= 4 * IT_DN;
    if (r < 2 * IT_FOXIN) { const int l = r / IT_FOXIN; r -= l * IT_FOXIN; W = a.in[11] + (size_t)l * DM * FOX_IN; ldw = FOX_IN; K = DM; N = FOX_N; WT = (bf16*)(ws + WS_WFOXIN + l * WFOXIN_BYTES); }
    else { r -= 2 * IT_FOXIN;
    if (r < 2 * IT_SQ) { const int l = r / IT_SQ; r -= l * IT_SQ; W = a.in[13] + (size_t)l * DM * DM; ldw = DM; K = DM; N = DM; WT = (bf16*)(ws + WS_WFOXOUT + l * WSQ_BYTES); }
    else { r -= 2 * IT_SQ;
    if (r < IT_SGUIN) { W = a.in[14]; ldw = SGU_N; K = DM; N = SGU_N; WT = (bf16*)(ws + WS_WSGUIN); }
    else { r -= IT_SGUIN;
    if (r < IT_SQ) { W = a.in[19]; ldw = DM; K = DM; N = DM; WT = (bf16*)(ws + WS_WSGUOUT); }
    else { r -= IT_SQ;
    if (r < IT_SWAIN) { W = a.in[20]; ldw = SWA_N; K = DM; N = SWA_N; WT = (bf16*)(ws + WS_WSWAIN); }
    else { r -= IT_SWAIN; W = a.in[22]; ldw = DM; K = DM; N = DM; WT = (bf16*)(ws + WS_WSWAOUT); } } } } } } }
    const int nblk = N / 32, kb = r / nblk, nb = r % nblk, n0 = 32 * nb;
    int c0 = n0;
    if (gu) { const int tile = n0 >> 8, bj = (n0 >> 7) & 1, j = n0 & 127; c0 = bj * DFF + tile * 128 + j; }
    p0_transpose_item(W, ldw, K, WT, 64 * kb, n0, c0, scr, lane);
}
__device__ __forceinline__ void mod_item(const Args& a, int r, const LAS float* sc, int lane) {
    const int l = r / (MOD_KS * MOD_CHUNKS), ks = (r / MOD_CHUNKS) % MOD_KS, ch = r % MOD_CHUNKS;
    const float* W = a.in[3] + ((size_t)l * DM + ks * 64) * 12288 + ch * 256 + lane * 4;
    f32x4 a0 = {0.f, 0.f, 0.f, 0.f}, a1 = {0.f, 0.f, 0.f, 0.f};
#pragma unroll 8
    for (int k = 0; k < 64; ++k) { const f32x4 w = *(const f32x4*)(W + (size_t)k * 12288); const float s0 = sc[ks * 64 + k], s1 = sc[DM + ks * 64 + k]; a0 += w * s0; a1 += w * s1; }
    float* P = (float*)(a.ws + WS_MODP) + ((size_t)(l * MOD_KS + ks) * 2) * 12288 + ch * 256 + lane * 4;
    *(f32x4*)P = a0; *(f32x4*)(P + 12288) = a1;
}
__device__ __forceinline__ double sin_poly(double r) { const double r2 = r * r; return r * (1.0 + r2 * (-1.0 / 6 + r2 * (1.0 / 120 + r2 * (-1.0 / 5040 + r2 * (1.0 / 362880 + r2 * (-1.0 / 39916800 + r2 * (1.0 / 6227020800.0 + r2 * (-1.0 / 1307674368000.0)))))))); }
__device__ __forceinline__ double cos_poly(double r) { const double r2 = r * r; return 1.0 + r2 * (-0.5 + r2 * (1.0 / 24 + r2 * (-1.0 / 720 + r2 * (1.0 / 40320 + r2 * (-1.0 / 3628800 + r2 * (1.0 / 479001600.0 + r2 * (-1.0 / 87178291200.0 + r2 * (1.0 / 20922789888000.0)))))))); }
__device__ __forceinline__ void sincos_f32angle(float ang, float& c, float& s) {
    const double x = (double)ang, q = rint(x * 0.6366197723675814);
    const double r = (x - q * 1.5707963267948966) - q * 6.123233995736766e-17;
    const int n = ((int)(long long)q) & 3;
    const double sr = sin_poly(r), cr = cos_poly(r);
    const double ss = (n == 0) ? sr : (n == 1) ? cr : (n == 2) ? -sr : -cr;
    const double cc = (n == 0) ? cr : (n == 1) ? -sr : (n == 2) ? -cr : sr;
    c = (float)cc; s = (float)ss;
}
__constant__ float ROPE_INV[8] = {1.0f, 0.193922743f, 0.0376060307f, 0.00729266461f, 0.00141421356f, 0.000274248188f, 5.3182961e-05f, 1.03133862e-05f};
__device__ __forceinline__ void p0_prologue(const Frame& Fi, const Args& a) {
    Frame F = launder(Fi);
    unsigned char* ws = a.ws;
    LAS float* sc = (LAS float*)(F.lds + 8 * 8704);
    for (int i = F.tid; i < 2 * DM; i += NTHR) { const float v = a.in[1][i]; sc[i] = v / (1.0f + expf(-v)); }
    __syncthreads();
    LAS float* scr = (LAS float*)(F.lds + F.wave * 8704);
    const int gw = F.vcu * NWAVES + F.wave, NGW = F.G * NWAVES;
    for (int it = gw; it < IT_MOD + IT_TOTAL; it += NGW) { if (it < IT_MOD) mod_item(a, it, sc, F.lane); else conv_item(a, it - IT_MOD, scr, F.lane); }
    const int gt = F.vcu * NTHR + F.tid, NGT = F.G * NTHR;
    float* rope = (float*)(ws + WS_ROPE); const int* pos = (const int*)a.in[2];
    for (int i = gt; i < M * 8; i += NGT) { const int m = i >> 3, k = i & 7; const float ang = (float)pos[m] * ROPE_INV[k]; float c, s; sincos_f32angle(ang, c, s); rope[m * 16 + k] = c; rope[m * 16 + 8 + k] = s; }
    float* wfg = (float*)(ws + WS_WFG);
    for (int i = gt; i < 2 * 16 * DM; i += NGT) { const int j = i / (16 * DM), hd = (i / DM) % 16, k = i % DM; wfg[i] = a.in[11][((size_t)j * DM + k) * FOX_IN + FOX_N + hd]; }
    bf16* wsm = (bf16*)(ws + WS_WSM);
    for (int i = gt; i < 16 * 128 * 128; i += NGT) { const int t = (i >> 7) & 127, s = i & 127; wsm[i] = (bf16)(s <= t ? f2bf(a.in[17][i]) : 0u); }
}
__device__ __forceinline__ void p1_modvec(const Frame& Fi, const Args& a) {
    Frame F = launder(Fi);
    const int gt = F.vcu * NTHR + F.tid, NGT = F.G * NTHR;
    const float* modp = (const float*)(a.ws + WS_MODP); float* vec = (float*)(a.ws + WS_VEC);
    for (int i = gt; i < DEPTH * 2 * 6 * DM; i += NGT) {
        const int col = i % DM, part = (i / DM) % 6, b = (i / (6 * DM)) % 2, l = i / (12 * DM);
        float s = 0.f;
        for (int ks = 0; ks < MOD_KS; ++ks) s += modp[((size_t)(l * MOD_KS + ks) * 2 + b) * 12288 + part * DM + col];
        s += a.in[4][l * 12288 + part * DM + col];
        float v; int slot;
        if (part == 0) { v = s; slot = 1; } else if (part == 1) { v = a.in[5][l * DM + col] * (1.0f + s); slot = 0; } else if (part == 2) { v = s * a.in[6][l * DM + col]; slot = 2; }
        else if (part == 3) { v = s; slot = 4; } else if (part == 4) { v = a.in[7][l * DM + col] * (1.0f + s); slot = 3; } else { v = s * a.in[8][l * DM + col]; slot = 5; }
        vec[((size_t)(l * 2 + b) * 6 + slot) * DM + col] = v;
    }
}
__device__ __forceinline__ float log_sigmoidf(float x) { return x < 0.f ? x - log1pf(expf(x)) : -log1pf(expf(-x)); }
__device__ __forceinline__ void norm_phase(const Frame& Fi, const float* xin, float* xout, const bf16* y, const float* ystat, const float* gvec, const float* avec, const float* shvec,
                                           bf16* hout, const float* wfg, const float* bfv, float* logf) {
    Frame F = launder(Fi);
    const int lane = F.lane;
    if (wfg) { for (int i = F.tid; i < 16 * DM / 4; i += NTHR) ((LAS f32x4*)F.lds)[i] = ((const f32x4*)wfg)[i]; __syncthreads(); }
    const int gw = F.vcu * NWAVES + F.wave, NGW = F.G * NWAVES;
    int curb = -1; f32x4 av[8], sv[8], gv[8];
#pragma unroll
    for (int j = 0; j < 8; ++j) { av[j] = (f32x4){0.f, 0.f, 0.f, 0.f}; sv[j] = av[j]; gv[j] = av[j]; }
    f32x4 nx[8]; u32x2 ny[8]; float nqs = 0.f;
#pragma unroll
    for (int j = 0; j < 8; ++j) { nx[j] = (f32x4){0.f, 0.f, 0.f, 0.f}; ny[j] = (u32x2){0u, 0u}; }
#define NP_LOAD(mm) do { const f32x4* xr_ = (const f32x4*)(xin + (size_t)(mm) * DM); _Pragma("unroll") for (int j = 0; j < 8; ++j) nx[j] = xr_[64 * j + lane]; \
        if (y) { const u32x2* yr_ = (const u32x2*)(y + (size_t)(mm) * DM); _Pragma("unroll") for (int j = 0; j < 8; ++j) ny[j] = yr_[64 * j + lane]; nqs = lane < 32 ? ystat[(size_t)(mm) * 32 + lane] : 0.f; } } while (0)
    if (gw < M) NP_LOAD(gw);
    for (int m = gw; m < M; m += NGW) {
        const int b = m >> 13;
        if (b != curb) { curb = b; const size_t vo = (size_t)b * 6 * DM;
#pragma unroll
            for (int j = 0; j < 8; ++j) { if (hout) { av[j] = ((const f32x4*)(avec + vo))[64 * j + lane]; sv[j] = ((const f32x4*)(shvec + vo))[64 * j + lane]; } if (y) gv[j] = ((const f32x4*)(gvec + vo))[64 * j + lane]; } }
        f32x4 xv[8]; u32x2 yw[8]; float q0 = nqs;
#pragma unroll
        for (int j = 0; j < 8; ++j) { xv[j] = nx[j]; yw[j] = ny[j]; }
        if (m + NGW < M) NP_LOAD(m + NGW);
        if (y) {
            const float q = wave_sum(q0);
            const float rstdy = 1.0f / sqrtf(q * (1.0f / DM) + EPS);
#pragma unroll
            for (int j = 0; j < 8; ++j) { const u32x2 w = yw[j]; f32x4 yf; yf[0] = bf2f(w.x & 0xffffu); yf[1] = bf2f(w.x >> 16); yf[2] = bf2f(w.y & 0xffffu); yf[3] = bf2f(w.y >> 16);
                xv[j] += gv[j] * (yf * rstdy); }
            if (xout) { f32x4* xo = (f32x4*)(xout + (size_t)m * DM);
#pragma unroll
                for (int j = 0; j < 8; ++j) xo[64 * j + lane] = xv[j]; }
        }
        if (hout) {
            float q = 0.f;
#pragma unroll
            for (int j = 0; j < 8; ++j) q += (xv[j][0] * xv[j][0] + xv[j][1] * xv[j][1]) + (xv[j][2] * xv[j][2] + xv[j][3] * xv[j][3]);
            q = wave_sum(q);
            const float rstdx = 1.0f / sqrtf(q * (1.0f / DM) + EPS);
            u32x2* ho = (u32x2*)(hout + (size_t)m * DM);
#pragma unroll
            for (int j = 0; j < 8; ++j) { xv[j] = xv[j] * rstdx * av[j] + sv[j]; u32x2 w; w.x = pk2(xv[j][0], xv[j][1]); w.y = pk2(xv[j][2], xv[j][3]); ho[64 * j + lane] = w; }
            if (wfg) {
                float mine = 0.f;
#pragma unroll 1
                for (int hd = 0; hd < 16; ++hd) { const LAS f32x4* wr = (const LAS f32x4*)F.lds + hd * (DM / 4); float p = 0.f;
#pragma unroll
                    for (int j = 0; j < 8; ++j) { const f32x4 w = wr[64 * j + lane]; p += (xv[j][0] * w[0] + xv[j][1] * w[1]) + (xv[j][2] * w[2] + xv[j][3] * w[3]); }
                    p = wave_sum(p); if (lane == hd) mine = p; }
                if (lane < 16) logf[(size_t)(b * 16 + lane) * SEQ + (m & (SEQ - 1))] = log_sigmoidf(mine + bfv[lane]);
            }
        }
    }
#undef NP_LOAD
    if (wfg) __syncthreads();
}
__device__ __forceinline__ void fox_scan(const Frame& Fi, const float* logf, float* cum) {
    Frame F = launder(Fi);
    if (blockIdx.x < 32) {
        const float* src = logf + (size_t)blockIdx.x * SEQ + 16 * F.tid; float* dst = cum + (size_t)blockIdx.x * SEQ + 16 * F.tid;
        f32x4 v[4];
#pragma unroll
        for (int j = 0; j < 4; ++j) v[j] = ((const f32x4*)src)[j];
        double tot = 0.0;
#pragma unroll
        for (int j = 0; j < 4; ++j) { tot += (double)v[j][0]; tot += (double)v[j][1]; tot += (double)v[j][2]; tot += (double)v[j][3]; }
        LAS double* sd = (LAS double*)F.lds;
        sd[F.tid] = tot; __syncthreads();
        if (F.tid == 0) { double run = 0.0; for (int i = 0; i < NTHR; ++i) { const double t = sd[i]; sd[i] = run; run += t; } }
        __syncthreads();
        double run = sd[F.tid];
#pragma unroll
        for (int j = 0; j < 4; ++j) { f32x4 o; run += (double)v[j][0]; o[0] = (float)run; run += (double)v[j][1]; o[1] = (float)run; run += (double)v[j][2]; o[2] = (float)run; run += (double)v[j][3]; o[3] = (float)run; ((f32x4*)dst)[j] = o; }
        __syncthreads();
    }
}
#define MFMA32(a, b, c) __builtin_amdgcn_mfma_f32_32x32x16_bf16((a), (b), (c), 0, 0, 0)
typedef short v4i16_t __attribute__((ext_vector_type(4)));
__device__ __forceinline__ s16x4 lds_tr16(const LAS unsigned char* p) { return __builtin_bit_cast(s16x4, __builtin_amdgcn_ds_read_tr16_b64_v4i16((LAS v4i16_t*)p)); }
__device__ __forceinline__ int crow(int r, int hi) { return (r & 3) + 8 * (r >> 2) + 4 * hi; }
__device__ __forceinline__ bf16x8 pack8(const f32x16& p, int s) {
    u32x4 w; w.x = pg8::cvt_pk_bf16(p[8 * s + 0], p[8 * s + 1]); w.y = pg8::cvt_pk_bf16(p[8 * s + 2], p[8 * s + 3]); w.z = pg8::cvt_pk_bf16(p[8 * s + 4], p[8 * s + 5]); w.w = pg8::cvt_pk_bf16(p[8 * s + 6], p[8 * s + 7]);
    return __builtin_bit_cast(bf16x8, w);
}
__device__ __forceinline__ bf16x8 cat44(s16x4 lo, s16x4 hi) { return (bf16x8){lo[0], lo[1], lo[2], lo[3], hi[0], hi[1], hi[2], hi[3]}; }
#define WG_BAR() do { asm volatile("s_waitcnt vmcnt(0) lgkmcnt(0)" ::: "memory"); __builtin_amdgcn_s_barrier(); asm volatile("" ::: "memory"); } while (0)

constexpr int FA_KROW = 272, FA_VROW = 320, FA_KBUF = 64 * FA_KROW, FA_VBUF = 64 * FA_VROW, FA_K0 = 0, FA_V0 = 2 * FA_KBUF, FA_B0 = FA_V0 + 2 * FA_VBUF, FA_PM0 = FA_B0 + 512, FA_RED0 = FA_PM0 + 512;
constexpr float FA_THR2 = 72.0f;
__device__ __forceinline__ void fox_attn_phase(const Frame& Fi, const bf16* P, const float* cum, const float* knorm, unsigned* ticket, bf16* O) {
    Frame F = launder(Fi);
    const int tid = F.tid, lane = F.lane, wave = F.wave, r32 = lane & 31, hi = lane >> 5;
    LAS unsigned char* lds = F.lds;
    const int srow = tid >> 3, sc16 = (tid & 7) * 16;
    const int trq = (lane & 15) >> 2, trp = lane & 3, trc = (lane >> 4) & 1;
    LAS int* ordv = (LAS int*)(lds + FA_PM0); LAS float* red = (LAS float*)(lds + FA_RED0); LAS int* tk = (LAS int*)(lds + FA_RED0 + 128);
    if (tid < 32) { const float key = cum[(size_t)tid * SEQ + SEQ - 1]; int rank = 0;
        for (int h2 = 0; h2 < 32; ++h2) { const float k2 = cum[(size_t)h2 * SEQ + SEQ - 1]; rank += (k2 > key || (k2 == key && h2 < tid)) ? 1 : 0; }
        ordv[rank] = tid; }
    WG_BAR();
#pragma unroll 1
    for (;;) {
        if (tid == 0) tk[0] = (int)__hip_atomic_fetch_add(ticket, 1u, __ATOMIC_RELAXED, __HIP_MEMORY_SCOPE_AGENT);
        WG_BAR();
        const int tkv = tk[0];
        if (tkv >= 1024) break;
        const int bh = ordv[tkv >> 5], qb = 31 - (tkv & 31), b = bh >> 4, hd = bh & 15;
        const size_t rowbase = (size_t)b * SEQ;
        { float pmx = 0.f;
          if (tid < 4 * qb) { const f32x4 kn = *(const f32x4*)(knorm + ((size_t)bh * 128 + tid) * 4); pmx = (kn[0] + kn[1]) + (kn[2] + kn[3]); }
          pmx = wave_max(pmx); if (lane == 0) red[8 + wave] = pmx; }
        const int q0 = 256 * qb, T0 = 4 * qb + 3, tw = 4 * qb + (wave >> 1);
        const int qrow = q0 + 32 * wave + r32;
        bf16x8 qf[8];
        { const bf16* qp = P + (rowbase + qrow) * FOX_N + hd * FOX_D + 8 * hi;
#pragma unroll
          for (int d0 = 0; d0 < 8; ++d0) qf[d0] = *(const bf16x8*)(qp + 16 * d0); }
        float nq;
        { float q2 = 0.f;
#pragma unroll
          for (int d0 = 0; d0 < 8; ++d0)
#pragma unroll
              for (int j = 0; j < 8; ++j) { const float v = bf2f((unsigned)(unsigned short)qf[d0][j]); q2 += v * v; }
          q2 += __shfl_xor(q2, 32); nq = sqrtf(q2) * 1.001f; }
        const float* cumh = cum + (size_t)bh * SEQ;
        const float Fref = cumh[q0];
        const bf16* Kg = P + rowbase * FOX_N + 2048 + hd * FOX_D + sc16;
        const bf16* Vg = P + rowbase * FOX_N + 4096 + hd * FOX_D + sc16;
        u32x4 kr0, kr1, vr0, vr1; float br = 0.f;
#define FA_LOAD(t) do { const size_t ro = (size_t)(64 * (t) + srow) * FOX_N; kr0 = *(const u32x4*)(Kg + ro); kr1 = *(const u32x4*)(Kg + ro + 8); vr0 = *(const u32x4*)(Vg + ro); vr1 = *(const u32x4*)(Vg + ro + 8); \
            if (tid < 64) br = cumh[64 * (t) + tid]; } while (0)
#define FA_STORE(buf) do { LAS unsigned char* kd = lds + FA_K0 + (buf) * FA_KBUF + srow * FA_KROW + sc16 * 2; *(LAS u32x4*)kd = kr0; *(LAS u32x4*)(kd + 16) = kr1; \
            LAS unsigned char* vd = lds + FA_V0 + (buf) * FA_VBUF + srow * FA_VROW + sc16 * 2; *(LAS u32x4*)vd = vr0; *(LAS u32x4*)(vd + 16) = vr1; \
            if (tid < 64) ((LAS float*)(lds + FA_B0))[(buf) * 64 + tid] = (Fref - br) * LOG2E; } while (0)
        f32x16 o[4];
#pragma unroll
        for (int d = 0; d < 4; ++d)
#pragma unroll
            for (int r = 0; r < 16; ++r) o[d][r] = 0.f;
        float mrun = -INFINITY, lrun = 0.f;
        FA_LOAD(T0); FA_STORE(0); WG_BAR();
        int cur = 0;
        const int tb = 4 * qb; float dstar = 0.f;
#define FA_COND(tt) ((Fref - cumh[64 * (tt) + 63]) * LOG2E + dstar >= -FA_THR2)
        int t = T0;
#pragma unroll 1
        for (;;) {
            const bool nxt = (t > tb) ? true : (t == tb) ? false : (t > 0 && FA_COND(t - 1));
            if (nxt) FA_LOAD(t - 1);
            if (t <= tw) {
                const LAS unsigned char* kb = lds + FA_K0 + cur * FA_KBUF + r32 * FA_KROW + 16 * hi;
                const LAS float* bb = (const LAS float*)(lds + FA_B0) + cur * 64 + 4 * hi;
                f32x16 s0, s1;
#pragma unroll
                for (int g = 0; g < 4; ++g) { const f32x4 b0 = *(const LAS f32x4*)(bb + 8 * g), b1 = *(const LAS f32x4*)(bb + 32 + 8 * g);
#pragma unroll
                    for (int i = 0; i < 4; ++i) { s0[4 * g + i] = b0[i]; s1[4 * g + i] = b1[i]; } }
#pragma unroll
                for (int d0 = 0; d0 < 8; ++d0) { const bf16x8 k0 = *(const LAS bf16x8*)(kb + 32 * d0), k1 = *(const LAS bf16x8*)(kb + 32 * FA_KROW + 32 * d0);
                    s0 = MFMA32(k0, qf[d0], s0); s1 = MFMA32(k1, qf[d0], s1); }
                if (t == tw) {
#pragma unroll
                    for (int r = 0; r < 16; ++r) { const int key = 64 * t + crow(r, hi); if (key > qrow) s0[r] = -INFINITY; if (key + 32 > qrow) s1[r] = -INFINITY; }
                }
                float mx = fmaxf(s0[0], s1[0]);
#pragma unroll
                for (int r = 1; r < 16; ++r) mx = fmaxf(mx, fmaxf(s0[r], s1[r]));
                mx = fmaxf(mx, __shfl_xor(mx, 32));
                const float mnew = fmaxf(mrun, mx), alpha = __builtin_amdgcn_exp2f(mrun - mnew);
                mrun = mnew;
                float ps = 0.f;
#pragma unroll
                for (int r = 0; r < 16; ++r) { s0[r] = __builtin_amdgcn_exp2f(s0[r] - mnew); s1[r] = __builtin_amdgcn_exp2f(s1[r] - mnew); ps += s0[r] + s1[r]; }
                lrun = lrun * alpha + ps;
#pragma unroll
                for (int d = 0; d < 4; ++d)
#pragma unroll
                    for (int r = 0; r < 16; ++r) o[d][r] *= alpha;
                bf16x8 pf[4]; pf[0] = pack8(s0, 0); pf[1] = pack8(s0, 1); pf[2] = pack8(s1, 0); pf[3] = pack8(s1, 1);
                const LAS unsigned char* vb = lds + FA_V0 + cur * FA_VBUF + (4 * hi + trq) * FA_VROW + (16 * trc + 4 * trp) * 2;
#pragma unroll
                for (int ks = 0; ks < 4; ++ks) {
#pragma unroll
                    for (int d = 0; d < 4; ++d) { const s16x4 lo = lds_tr16(vb + 16 * ks * FA_VROW + 64 * d), hh = lds_tr16(vb + (16 * ks + 8) * FA_VROW + 64 * d);
                        o[d] = MFMA32(cat44(lo, hh), pf[ks], o[d]); }
                }
            }
            if (nxt) FA_STORE(cur ^ 1);
            WG_BAR();
            if (nxt) { cur ^= 1; --t; continue; }
            if (t == tb && tb > 0) {
                const float pm2 = fmaxf(fmaxf(fmaxf(red[8], red[9]), fmaxf(red[10], red[11])), fmaxf(fmaxf(red[12], red[13]), fmaxf(red[14], red[15])));
                float val = nq * (sqrtf(pm2) * 1.004f) - mrun; val = wave_max(val);
                if (lane == 0) red[wave] = val;
                WG_BAR();
                dstar = fmaxf(fmaxf(fmaxf(red[0], red[1]), fmaxf(red[2], red[3])), fmaxf(fmaxf(red[4], red[5]), fmaxf(red[6], red[7])));
                if (!FA_COND(tb - 1)) break;
                FA_LOAD(tb - 1); FA_STORE(cur ^ 1); WG_BAR(); cur ^= 1; --t; continue;
            }
            break;
        }
#undef FA_COND
        const float ltot = lrun + __shfl_xor(lrun, 32), inv = 1.0f / ltot;
        bf16* op = O + (rowbase + qrow) * DM + hd * FOX_D + 4 * hi;
#pragma unroll
        for (int d = 0; d < 4; ++d)
#pragma unroll
            for (int g = 0; g < 4; ++g) { u32x2 w; w.x = pg8::cvt_pk_bf16(o[d][4 * g] * inv, o[d][4 * g + 1] * inv); w.y = pg8::cvt_pk_bf16(o[d][4 * g + 2] * inv, o[d][4 * g + 3] * inv);
                *(u32x2*)(op + 32 * d + 8 * g) = w; }
#undef FA_LOAD
#undef FA_STORE
    }
}
constexpr int SW_KROW = 144, SW_VROW = 192, SW_K0 = 0, SW_V0 = 256 * SW_KROW, SW_NU = BATCH * 64 * SWA_HK;
__device__ __forceinline__ void swa_rope8(u32x4& a, u32x4& bq, const float* cs16, bool both, bool second) {
    const f32x4* cs = (const f32x4*)cs16; const f32x4 c0 = cs[0], c1 = cs[1], s0 = cs[2], s1 = cs[3];
    u32x4 n0, n1;
#pragma unroll
    for (int i = 0; i < 4; ++i) { const float c_lo = (i < 2) ? c0[2 * i] : c1[2 * i - 4], c_hi = (i < 2) ? c0[2 * i + 1] : c1[2 * i - 3], s_lo = (i < 2) ? s0[2 * i] : s1[2 * i - 4], s_hi = (i < 2) ? s0[2 * i + 1] : s1[2 * i - 3];
        const float a_lo = bf2f(a[i] & 0xffffu), a_hi = bf2f(a[i] >> 16), b_lo = bf2f(bq[i] & 0xffffu), b_hi = bf2f(bq[i] >> 16);
        n0[i] = pk2(a_lo * c_lo - b_lo * s_lo, a_hi * c_hi - b_hi * s_hi); n1[i] = pk2(b_lo * c_lo + a_lo * s_lo, b_hi * c_hi + a_hi * s_hi); }
    (void)both; (void)second; a = n0; bq = n1;
}
__device__ __forceinline__ void swa_phase(const Frame& Fi, const bf16* P, const float* rope, const float* sinks, bf16* O) {
    Frame F = launder(Fi);
    const int tid = F.tid, lane = F.lane, wave = F.wave, r32 = lane & 31, hi = lane >> 5;
    LAS unsigned char* lds = F.lds;
    const int trq = (lane & 15) >> 2, trp = lane & 3, trc = (lane >> 4) & 1;
    const int srow0 = tid >> 2, spr = tid & 3;
    u32x4 kr[2][2], vr[2][2];
#define SW_LOAD(uu) do { const int hk_ = (uu) & 7, n_ = ((uu) >> 3) & 63, b_ = (uu) >> 9; const size_t blk_ = (size_t)b_ * SEQ + (size_t)n_ * 128; \
        _Pragma("unroll") for (int it = 0; it < 2; ++it) { const int row = srow0 + 128 * it; \
            if (n_ > 0 || it == 1) { const size_t m_ = blk_ - 128 + row; const bf16* kp = P + m_ * SWA_N + 2048 + hk_ * SWA_D + 16 * spr; const bf16* vp = P + m_ * SWA_N + 2560 + hk_ * SWA_D + 16 * spr; \
                kr[it][0] = *(const u32x4*)kp; kr[it][1] = *(const u32x4*)(kp + 8); vr[it][0] = *(const u32x4*)vp; vr[it][1] = *(const u32x4*)(vp + 8); } \
            else { kr[it][0] = (u32x4){0u, 0u, 0u, 0u}; kr[it][1] = kr[it][0]; vr[it][0] = kr[it][0]; vr[it][1] = kr[it][0]; } } } while (0)
    int u = F.vcu;
    if (u < SW_NU) SW_LOAD(u);
#pragma unroll 1
    for (; u < SW_NU; u += F.G) {
        const int hk = u & 7, n = (u >> 3) & 63, b = u >> 9;
        const size_t blk0 = (size_t)b * SEQ + (size_t)n * 128;
#pragma unroll
        for (int it = 0; it < 2; ++it) { const int row = srow0 + 128 * it;
            u32x4 k0 = kr[it][0], k1 = kr[it][1];
            if (spr == 0 && (n > 0 || it == 1)) swa_rope8(k0, k1, rope + (blk0 - 128 + row) * 16, true, false);
            LAS unsigned char* kd = lds + SW_K0 + row * SW_KROW + 32 * spr; *(LAS u32x4*)kd = k0; *(LAS u32x4*)(kd + 16) = k1;
            LAS unsigned char* vd = lds + SW_V0 + row * SW_VROW + 32 * spr; *(LAS u32x4*)vd = vr[it][0]; *(LAS u32x4*)(vd + 16) = vr[it][1]; }
        const int g = wave & 3, hq = hk * 4 + g;
        bf16x8 qf[2][4];
#pragma unroll
        for (int it = 0; it < 2; ++it) { const int rb = (wave >> 2) + 2 * it; const size_t m = blk0 + 32 * rb + r32;
            const bf16* qp = P + m * SWA_N + hq * SWA_D;
            u32x4 x1 = *(const u32x4*)qp, x2 = *(const u32x4*)(qp + 8);
            swa_rope8(x1, x2, rope + m * 16, true, false);
            const u32x4 xs = hi ? x2 : x1; u32x4 w;
#pragma unroll
            for (int i = 0; i < 4; ++i) w[i] = pk2(bf2f(xs[i] & 0xffffu) * SWA_QSCALE, bf2f(xs[i] >> 16) * SWA_QSCALE);
            qf[it][0] = __builtin_bit_cast(bf16x8, w);
#pragma unroll
            for (int d0 = 1; d0 < 4; ++d0) { const u32x4 x = *(const u32x4*)(qp + 16 * d0 + 8 * hi); u32x4 ww;
#pragma unroll
                for (int i = 0; i < 4; ++i) ww[i] = pk2(bf2f(x[i] & 0xffffu) * SWA_QSCALE, bf2f(x[i] >> 16) * SWA_QSCALE);
                qf[it][d0] = __builtin_bit_cast(bf16x8, ww); } }
        WG_BAR();
        { const int un = u + F.G; if (un < SW_NU) SW_LOAD(un); }
        const float sink2 = sinks[hq] * LOG2E;
#pragma unroll 1
        for (int it = 0; it < 2; ++it) {
            const int rb = (wave >> 2) + 2 * it;
            bf16x8 qs[4];
#pragma unroll
            for (int d0 = 0; d0 < 4; ++d0) qs[d0] = it ? qf[1][d0] : qf[0][d0];
            const int qi = 32 * rb + r32; const size_t m = blk0 + qi;
            f32x16 s[5];
#pragma unroll
            for (int j = 0; j < 5; ++j) {
#pragma unroll
                for (int r = 0; r < 16; ++r) s[j][r] = 0.f;
                const LAS unsigned char* kb = lds + SW_K0 + (32 * (rb + j) + r32) * SW_KROW + 16 * hi;
#pragma unroll
                for (int d0 = 0; d0 < 4; ++d0) s[j] = MFMA32(*(const LAS bf16x8*)(kb + 32 * d0), qs[d0], s[j]);
#pragma unroll
                for (int r = 0; r < 16; ++r) { const int kk = 32 * (rb + j) + crow(r, hi), ki = kk - 128, rel = qi - ki; const bool ok = (rel >= 0) && (rel < 128) && (n * 128 + ki >= 0); if (!ok) s[j][r] = -INFINITY; }
            }
            float mx = sink2;
#pragma unroll
            for (int j = 0; j < 5; ++j)
#pragma unroll
                for (int r = 0; r < 16; ++r) mx = fmaxf(mx, s[j][r]);
            mx = fmaxf(mx, __shfl_xor(mx, 32));
            float ps = 0.f;
#pragma unroll
            for (int j = 0; j < 5; ++j)
#pragma unroll
                for (int r = 0; r < 16; ++r) { s[j][r] = __builtin_amdgcn_exp2f(s[j][r] - mx); ps += s[j][r]; }
            ps += __shfl_xor(ps, 32);
            const float inv = 1.0f / (ps + __builtin_amdgcn_exp2f(sink2 - mx));
            f32x16 o[2];
#pragma unroll
            for (int d = 0; d < 2; ++d)
#pragma unroll
                for (int r = 0; r < 16; ++r) o[d][r] = 0.f;
            const LAS unsigned char* vb = lds + SW_V0 + (32 * rb + 4 * hi + trq) * SW_VROW + (16 * trc + 4 * trp) * 2;
#pragma unroll
            for (int j = 0; j < 5; ++j)
#pragma unroll
                for (int ks = 0; ks < 2; ++ks) { const bf16x8 pf = pack8(s[j], ks);
#pragma unroll
                    for (int d = 0; d < 2; ++d) { const s16x4 lo = lds_tr16(vb + (32 * j + 16 * ks) * SW_VROW + 64 * d), hh = lds_tr16(vb + (32 * j + 16 * ks + 8) * SW_VROW + 64 * d);
                        o[d] = MFMA32(cat44(lo, hh), pf, o[d]); } }
            bf16* op = O + m * DM + hq * SWA_D + 4 * hi;
#pragma unroll
            for (int d = 0; d < 2; ++d)
#pragma unroll
                for (int gq = 0; gq < 4; ++gq) { u32x2 w; w.x = pg8::cvt_pk_bf16(o[d][4 * gq] * inv, o[d][4 * gq + 1] * inv); w.y = pg8::cvt_pk_bf16(o[d][4 * gq + 2] * inv, o[d][4 * gq + 3] * inv);
                    *(u32x2*)(op + 32 * d + 8 * gq) = w; }
        }
        WG_BAR();
    }
#undef SW_LOAD
}
constexpr int SG_VROW = 320, SG_VBUF = 128 * SG_VROW, SG_V0 = 0, SG_ST = 2 * SG_VBUF, SG_LN = SG_ST + 1024;
__device__ __forceinline__ void sgu_phase(const Frame& Fi, const bf16* P, const float* vstat, const float* lng, const float* lnb, const bf16* wsm, const float* bs, bf16* O) {
    Frame F = launder(Fi);
    const int tid = F.tid, lane = F.lane, wave = F.wave, r32 = lane & 31, hi = lane >> 5;
    LAS unsigned char* lds = F.lds;
    const int trq = (lane & 15) >> 2, trp = lane & 3, trc = (lane >> 4) & 1;
    LAS float* rst = (LAS float*)(lds + SG_ST);
    LAS float* lnl = (LAS float*)(lds + SG_LN);
    const int srow = tid >> 4, sc8 = (tid & 15) * 8;
#pragma unroll 1
    for (int u = F.vcu; u < BATCH * 64 * 2; u += F.G) {
        const int gh = u & 1, ch = (u >> 1) & 63, b = u >> 7, c0 = gh * 1024;
        const size_t m0 = (size_t)b * SEQ + (size_t)ch * 128;
        u32x4 vld[4];
#define SG_LOAD(gi_) do { _Pragma("unroll") for (int it = 0; it < 4; ++it) vld[it] = *(const u32x4*)(P + (m0 + srow + 32 * it) * SGU_N + 2048 + c0 + (gi_) * 128 + sc8); } while (0)
        SG_LOAD(0);
        if (tid < 128) { const float* sp = vstat + (m0 + tid) * 64; float s = 0.f, q = 0.f;
#pragma unroll 8
            for (int i = 0; i < 32; ++i) { s += sp[2 * i]; q += sp[2 * i + 1]; }
            const float mean = s * (1.0f / DM), var = fmaxf(q * (1.0f / DM) - mean * mean, 0.f);
            rst[2 * tid] = mean; rst[2 * tid + 1] = 1.0f / sqrtf(var + EPS); }
        if (tid < 256) *(LAS f32x4*)(lnl + 4 * tid) = *(const f32x4*)(lng + c0 + 4 * tid); else *(LAS f32x4*)(lnl + 1024 + 4 * (tid - 256)) = *(const f32x4*)(lnb + c0 + 4 * (tid - 256));
        WG_BAR();
        const int tb = wave & 3, nks = 2 * tb + 2;
#pragma unroll 1
        for (int gi = 0; gi < 8; ++gi) {
            const int g = 8 * gh + gi; LAS unsigned char* vbuf = lds + SG_V0 + (gi & 1) * SG_VBUF;
#pragma unroll
            for (int it = 0; it < 4; ++it) { const int row = srow + 32 * it; const u32x4 x = vld[it];
                const f32x4 g0 = *(const LAS f32x4*)(lnl + gi * 128 + sc8), g1 = *(const LAS f32x4*)(lnl + gi * 128 + sc8 + 4), b0 = *(const LAS f32x4*)(lnl + 1024 + gi * 128 + sc8), b1 = *(const LAS f32x4*)(lnl + 1024 + gi * 128 + sc8 + 4);
                const float mean = rst[2 * row], rstd = rst[2 * row + 1]; u32x4 w;
#pragma unroll
                for (int i = 0; i < 4; ++i) { const float ga = (i < 2) ? g0[2 * i] : g1[2 * i - 4], gb = (i < 2) ? g0[2 * i + 1] : g1[2 * i - 3], ba = (i < 2) ? b0[2 * i] : b1[2 * i - 4], bb = (i < 2) ? b0[2 * i + 1] : b1[2 * i - 3];
                    w[i] = pk2((bf2f(x[i] & 0xffffu) - mean) * rstd * ga + ba, (bf2f(x[i] >> 16) - mean) * rstd * gb + bb); }
                *(LAS u32x4*)(vbuf + row * SG_VROW + sc8 * 2) = w; }
            WG_BAR();
            if (gi < 7) SG_LOAD(gi + 1);
            const bf16* wrow = wsm + ((size_t)g * 128 + 32 * tb + r32) * 128 + 8 * hi;
            bf16x8 wf[8];
#pragma unroll
            for (int ks = 0; ks < 8; ++ks) if (ks < nks) wf[ks] = *(const bf16x8*)(wrow + 16 * ks);
            const int t = 32 * tb + r32; const float bias = bs[g * 128 + t];
            u32x2 uu[2][4];
#pragma unroll
            for (int it = 0; it < 2; ++it) { const bf16* up = P + (m0 + t) * SGU_N + g * 128 + 32 * ((wave >> 2) + 2 * it) + 4 * hi;
#pragma unroll
                for (int gq = 0; gq < 4; ++gq) uu[it][gq] = *(const u32x2*)(up + 8 * gq); }
#pragma unroll
            for (int it = 0; it < 2; ++it) { const int db = (wave >> 2) + 2 * it;
                f32x16 acc;
#pragma unroll
                for (int r = 0; r < 16; ++r) acc[r] = 0.f;
                const LAS unsigned char* vb = vbuf + (8 * hi + trq) * SG_VROW + (32 * db + 16 * trc + 4 * trp) * 2;
#pragma unroll
                for (int ks = 0; ks < 8; ++ks) if (ks < nks) { const s16x4 lo = lds_tr16(vb + 16 * ks * SG_VROW), hh = lds_tr16(vb + (16 * ks + 4) * SG_VROW); acc = MFMA32(cat44(lo, hh), wf[ks], acc); }
                bf16* op = O + (m0 + t) * DM + g * 128 + 32 * db + 4 * hi;
#pragma unroll
                for (int gq = 0; gq < 4; ++gq) { const u32x2 ux = uu[it][gq]; u32x2 w;
                    w.x = pg8::cvt_pk_bf16(bf2f(ux.x & 0xffffu) * (acc[4 * gq] + bias), bf2f(ux.x >> 16) * (acc[4 * gq + 1] + bias));
                    w.y = pg8::cvt_pk_bf16(bf2f(ux.y & 0xffffu) * (acc[4 * gq + 2] + bias), bf2f(ux.y >> 16) * (acc[4 * gq + 3] + bias));
                    *(u32x2*)(op + 8 * gq) = w; } }
        }
        WG_BAR();
#undef SG_LOAD
    }
}
constexpr int NPHASE = 31, PH_FINAL = 30;
__global__ void __launch_bounds__(NTHR, 2) mk_fwd(Args args) {
    extern __shared__ __attribute__((aligned(16))) unsigned char lds_raw[];
    Frame F;
    F.lds = (LAS unsigned char*)lds_raw;
    F.tid = threadIdx.x; F.lane = F.tid & 63; F.wave = __builtin_amdgcn_readfirstlane(F.tid >> 6);
    F.G = gridDim.x; { const int bx = blockIdx.x; F.vcu = (F.G % 8 == 0) ? (bx % 8) * (F.G / 8) + bx / 8 : bx; }
    unsigned char* ws = args.ws;
    gu32* ctl = (gu32*)(ws + WS_CTL);
    for (int u = F.tid; u < (LDS_BYTES - LDSCTL_OFF) / 4; u += NTHR) ((LAS unsigned*)(F.lds + LDSCTL_OFF))[u] = 0u;
    __syncthreads();
    XcdBarrier bar = xcd_barrier_post((unsigned*)(ctl + CW_BAR), (volatile LAS unsigned*)(F.lds + MISC_OFF) + 8);
    const int lo = args.ph_lo, hi = args.ph_hi;
#define IN(k) (lo <= (k) && (k) < hi)
#ifndef PROBE_REPEAT
#define PROBE_REPEAT 0
#endif
#define REP(c) _Pragma("unroll 1") for (int rep_ = 0; rep_ <= ((PROBE_REPEAT >> (c)) & 1); ++rep_)
#ifndef PROBE_STAMP
#define PROBE_STAMP 0
#endif
#ifndef PROBE_SEL
#define PROBE_SEL(k) 1
#endif
#ifndef PROBE_MULT
#define PROBE_MULT 1
#endif
#if PROBE_STAMP
#define STAMP(k) do { if (F.tid == 0) { const unsigned t_ = (unsigned)__builtin_amdgcn_s_memrealtime(); atomicMax((unsigned*)(ctl + 16384 + 2 * (k)), t_); atomicMax((unsigned*)(ctl + 16385 + 2 * (k)), 0xffffffffu - t_); } } while (0)
#else
#define STAMP(k) do { } while (0)
#endif
#if PROBE_STAMP == 3
    long long clk_prev = clock64(), clk_sum = 0;
#undef STAMP
#define STAMP(k) do { const long long c_ = clock64(); if (PROBE_SEL(k)) clk_sum += c_ - clk_prev; } while (0)
#define STAMP2() do { clk_prev = clock64(); } while (0)
#else
#define STAMP2() do { } while (0)
#endif
#define SEAM(k) do { if (IN(k) && IN((k) + 1)) { STAMP(k); xcd_barrier(bar); STAMP2(); } } while (0)
    bf16* Hb = (bf16*)(ws + WS_H); bf16* Pb = (bf16*)(ws + WS_PROJ); bf16* Ob = (bf16*)(ws + WS_O); bf16* Yb = (bf16*)(ws + WS_Y);
    float* XA = (float*)(ws + WS_XA); float* ystat = (float*)(ws + WS_YSTAT); float* vstat = (float*)(ws + WS_VSTAT);
    const float* vec = (const float*)(ws + WS_VEC);
    float* logf = (float*)(ws + WS_LOGF); float* cum = (float*)(ws + WS_CUM);

    if (IN(0)) { REP(0) { p0_prologue(F, args); __syncthreads(); } } SEAM(0);
    if (IN(1)) { p1_modvec(F, args); } SEAM(1);

#pragma unroll 1
    for (int s = 0; s < 2 * DEPTH; ++s) {
        const int l = s >> 1, half = s & 1, kind = l % 3, jj = l / 3, base = 2 + 7 * l + 4 * half;
        if (IN(base)) {
            const float* xin = (s == 0 || s == 1) ? args.in[0] : (((s - 1) & 1) ? XA : args.out);
            float* xout = (s == 0) ? nullptr : ((s & 1) ? XA : args.out);
            const float* lv = vec + (size_t)l * 12 * DM;
            const float* gsrc = (s == 0) ? nullptr : (half ? lv + 2 * DM : vec + (size_t)(l - 1) * 12 * DM + 5 * DM);
            const float* av = half ? lv + 3 * DM : lv + 0 * DM; const float* sv = half ? lv + 4 * DM : lv + 1 * DM;
            const bool fox = (half == 0 && kind == 0);
            REP(1) norm_phase(F, xin, xout, s == 0 ? nullptr : Yb, ystat, gsrc, av, sv, Hb, fox ? (const float*)(ws + WS_WFG) + (size_t)jj * 16 * DM : nullptr, args.in[12] + jj * 16, logf);
        }
        SEAM(base);
        if (half == 0) {
            if (IN(base + 1)) {
                if (kind == 1) {
                    pg8::Gemm g{Hb, (const bf16*)(ws + WS_WSGUIN), M, SGU_N, DM}; pg8::StaticOrder S; S.init(M, SGU_N, F.G, (int)blockIdx.x);
                    pg8::EpiSguIn E{Pb, SGU_N, vstat};
                    REP(2) pg8::gemm_phase<pg8::EpiSguIn, pg8::StaticOrder, true, true>(F.lds, g, S, E);
                } else {
                    if (kind == 0) fox_scan(F, logf, cum);
                    const int N = kind == 0 ? FOX_N : SWA_N;
                    const bf16* Bt = kind == 0 ? (const bf16*)(ws + WS_WFOXIN + jj * WFOXIN_BYTES) : (const bf16*)(ws + WS_WSWAIN);
                    pg8::Gemm g{Hb, Bt, M, N, DM}; pg8::StaticOrder S; S.init(M, N, F.G, (int)blockIdx.x);
                    pg8::EpiProj E{Pb, N, kind == 0 ? 2048 : 0, FOX_QSCALE, kind == 0 ? (float*)(ws + WS_KNORM) : nullptr};
                    REP(2) pg8::gemm_phase<pg8::EpiProj, pg8::StaticOrder, true, true>(F.lds, g, S, E);
                }
            }
            SEAM(base + 1);
            if (IN(base + 2)) {
                if (kind == 0) { REP(3) fox_attn_phase(F, Pb, cum, (const float*)(ws + WS_KNORM), (unsigned*)(ctl + CW_TICKET + 64 * jj), Ob); }
                else if (kind == 1) REP(4) sgu_phase(F, Pb, vstat, args.in[15], args.in[16], (const bf16*)(ws + WS_WSM), args.in[18], Ob);
                else REP(5) swa_phase(F, Pb, (const float*)(ws + WS_ROPE), args.in[21], Ob);
            }
            SEAM(base + 2);
        } else {
            if (IN(base + 1)) {
                pg8::Gemm g{Hb, (const bf16*)(ws + WS_WGU + l * WGU_BYTES), M, 2 * DFF, DM}; pg8::StaticOrder S; S.init(M, 2 * DFF, F.G, (int)blockIdx.x);
                pg8::EpiSwiglu E{Pb, DFF};
                REP(2) pg8::gemm_phase<pg8::EpiSwiglu, pg8::StaticOrder, true, true>(F.lds, g, S, E);
            }
            SEAM(base + 1);
        }
        { const int ph = half ? base + 2 : base + 3;
          if (IN(ph)) {
              const bf16* A = half ? Pb : Ob; const int K = half ? DFF : DM;
              const bf16* Bt = half ? (const bf16*)(ws + WS_WDN + l * WDN_BYTES) : (kind == 0 ? (const bf16*)(ws + WS_WFOXOUT + jj * WSQ_BYTES) : kind == 1 ? (const bf16*)(ws + WS_WSGUOUT) : (const bf16*)(ws + WS_WSWAOUT));
              pg8::Gemm g{A, Bt, M, DM, K}; pg8::StaticOrder S; S.init(M, DM, F.G, (int)blockIdx.x);
              pg8::EpiOut E{Yb, DM, ystat};
              REP(2) pg8::gemm_phase<pg8::EpiOut, pg8::StaticOrder, true, true>(F.lds, g, S, E);
          }
          SEAM(ph); }
    }
    if (IN(PH_FINAL)) {
        const float* gsrc = vec + (size_t)3 * 12 * DM + 5 * DM;
        REP(1) norm_phase(F, XA, args.out, Yb, ystat, gsrc, nullptr, nullptr, nullptr, nullptr, nullptr, nullptr);
    }
#if PROBE_STAMP == 3
    if (blockIdx.x == 0 && F.tid == 0) { const unsigned long long t0 = __builtin_amdgcn_s_memrealtime(); const unsigned long long ticks = (unsigned long long)clk_sum / 24ull;
        while (__builtin_amdgcn_s_memrealtime() - t0 < ticks) __builtin_amdgcn_s_sleep(32); }
#elif PROBE_STAMP
    STAMP(PH_FINAL); xcd_barrier(bar);
    if (blockIdx.x == 0 && F.tid == 0) {
        unsigned long long total = 0ull;
        for (int k = 0; k <= PH_FINAL; ++k) { const unsigned tmax = __hip_atomic_load((unsigned*)(ctl + 16384 + 2 * k), __ATOMIC_RELAXED, __HIP_MEMORY_SCOPE_AGENT), tmin = 0xffffffffu - __hip_atomic_load((unsigned*)(ctl + 16385 + 2 * k), __ATOMIC_RELAXED, __HIP_MEMORY_SCOPE_AGENT);
            const unsigned tprev = k ? __hip_atomic_load((unsigned*)(ctl + 16384 + 2 * (k - 1)), __ATOMIC_RELAXED, __HIP_MEMORY_SCOPE_AGENT) : tmin;
            if (PROBE_SEL(k)) total += (PROBE_STAMP == 1) ? (unsigned long long)(tmax - tmin) : (unsigned long long)(tmax - tprev); }
        const unsigned long long t0 = __builtin_amdgcn_s_memrealtime();
        while (__builtin_amdgcn_s_memrealtime() - t0 < total * PROBE_MULT) __builtin_amdgcn_s_sleep(32);
    }
#endif
#undef IN
#undef SEAM
}
#if DBG
static void dbg_checks(int phase, const Args& a, hipStream_t stream);
__global__ void dbg_finalize(Args a);
#endif
extern "C" void kernel_launch(void* const* d_in, const int* in_sizes, int n_in, void* d_out, int out_size, void* d_ws, size_t ws_size, hipStream_t stream) {
    static int grid = 0;
    if (grid == 0) {
        if (n_in != 23 || out_size != M * DM || ws_size < WS_END) { fprintf(stderr, "kernel_launch: unexpected shapes (n_in %d, out %d, ws %zu); nothing launched\n", n_in, out_size, ws_size); grid = -1; return; }
        int dev = 0, cus = 0, per_cu = 0;
        if (hipGetDevice(&dev) != hipSuccess || hipDeviceGetAttribute(&cus, hipDeviceAttributeMultiprocessorCount, dev) != hipSuccess) { grid = -1; return; }
        if (hipFuncSetAttribute((const void*)mk_fwd, hipFuncAttributeMaxDynamicSharedMemorySize, LDS_BYTES) != hipSuccess) { fprintf(stderr, "kernel_launch: hipFuncSetAttribute failed\n"); grid = -1; return; }
        if (hipOccupancyMaxActiveBlocksPerMultiprocessor(&per_cu, (const void*)mk_fwd, NTHR, LDS_BYTES) != hipSuccess || per_cu < 1) { fprintf(stderr, "kernel_launch: occupancy query says %d blocks per CU\n", per_cu); }
        (void)hipGetLastError();
        grid = cus;
        if (grid != 256) { fprintf(stderr, "kernel_launch: built for a 256-CU device, found %d CUs; nothing launched\n", cus); grid = -1; return; }
    }
    if (grid < 0) return;
    (void)hipMemsetAsync((char*)d_ws + WS_CTL, 0, CTL_ZERO_BYTES, stream);
    Args a{};
    for (int i = 0; i < 23; ++i) a.in[i] = (const float*)d_in[i];
    a.out = (float*)d_out; a.ws = (unsigned char*)d_ws;
#if DBG
    for (int ph = 0; ph < NPHASE; ++ph) { a.ph_lo = ph; a.ph_hi = ph + 1; hipLaunchKernelGGL(mk_fwd, dim3(grid), dim3(NTHR), LDS_BYTES, stream, a); dbg_checks(ph, a, stream); }
    hipLaunchKernelGGL(dbg_finalize, dim3(1024), dim3(256), 0, stream, a);
#else
    a.ph_lo = 0; a.ph_hi = NPHASE;
    hipLaunchKernelGGL(mk_fwd, dim3(grid), dim3(NTHR), LDS_BYTES, stream, a);
#endif
    const hipError_t le = hipPeekAtLastError();
    if (le != hipSuccess) fprintf(stderr, "kernel_launch: launch failed: %s\n", hipGetErrorName(le));
}
#if DBG
__device__ __forceinline__ void dbg_fail(unsigned char* ws, unsigned code, float val) {
    unsigned* ctl = (unsigned*)(ws + WS_CTL);
    if (atomicCAS(ctl + CW_ERR, 0u, code) == 0u) ctl[CW_ERRV] = __float_as_uint(val);
}
__device__ __forceinline__ float block_sum256(float v, float* sh) {
    const int t = threadIdx.x; sh[t] = v; __syncthreads();
    for (int o = 128; o > 0; o >>= 1) { if (t < o) sh[t] += sh[t + o]; __syncthreads(); }
    const float r = sh[0]; __syncthreads(); return r;
}
__device__ __forceinline__ float block_max256(float v, float* sh) {
    const int t = threadIdx.x; sh[t] = v; __syncthreads();
    for (int o = 128; o > 0; o >>= 1) { if (t < o) sh[t] = fmaxf(sh[t], sh[t + o]); __syncthreads(); }
    const float r = sh[0]; __syncthreads(); return r;
}
__device__ __forceinline__ unsigned hash32(unsigned x) { x ^= x >> 16; x *= 0x7feb352du; x ^= x >> 15; x *= 0x846ca68bu; x ^= x >> 16; return x; }
__device__ __forceinline__ int dbg_row(int i) { return i * 256 + ((i * 37 + 11) & 255); }

struct ChkW { const float* W; const bf16* WT; int ldw, K, N, gu; };
__global__ void chk_weights(Args a, ChkW c, unsigned code) {
    const unsigned i = blockIdx.x * blockDim.x + threadIdx.x; const unsigned h = hash32(i * 2654435761u + code);
    const int n = h % c.N, k = hash32(h) % c.K;
    int col = n; if (c.gu) { const int tile = n >> 8, bj = (n >> 7) & 1, j = n & 127; col = bj * DFF + tile * 128 + j; }
    const float w = c.W[(size_t)k * c.ldw + col], g = bf2f(c.WT[(size_t)n * c.K + k]);
    if (!(fabsf(g - w) <= 0.004f * fabsf(w) + 1e-30f)) dbg_fail(a.ws, code, (float)n);
}
__global__ void chk_tables(Args a, unsigned code) {
    const int i = blockIdx.x * blockDim.x + threadIdx.x;
    const float* wfg = (const float*)(a.ws + WS_WFG); const bf16* wsm = (const bf16*)(a.ws + WS_WSM); const float* rope = (const float*)(a.ws + WS_ROPE);
    { const int j = i / 32768, hd = (i / 2048) % 16, k = i % 2048; if (wfg[i] != a.in[11][((size_t)j * DM + k) * FOX_IN + FOX_N + hd]) dbg_fail(a.ws, code, 1.f); }
    for (int e = i; e < 16 * 128 * 128; e += 65536) { const int t = (e >> 7) & 127, s = e & 127; const float w = s <= t ? a.in[17][e] : 0.f; if (!(fabsf(bf2f(wsm[e]) - w) <= 0.004f * fabsf(w))) dbg_fail(a.ws, code, 2.f); }
    { const int m = i & (M - 1), k = (i >> 14) & 7  ; const int pos = ((const int*)a.in[2])[m]; const float ang = (float)pos * ROPE_INV[k];
      const float c = cosf(ang), s = sinf(ang); if (!(fabsf(rope[m * 16 + k] - c) < 2e-5f && fabsf(rope[m * 16 + 8 + k] - s) < 2e-5f)) dbg_fail(a.ws, code, 3.f); }
}
__global__ void chk_modvec(Args a, unsigned code) {
    const int i = blockIdx.x * blockDim.x + threadIdx.x;
    if (i >= 3072) return;
    const int l = i / 768, b = (i / 384) % 2, slot = (i / 64) % 6, col = ((i % 64) * 32 + (i * 7) % 32) % DM;
    const int part = slot == 0 ? 1 : slot == 1 ? 0 : slot == 2 ? 2 : slot == 3 ? 4 : slot == 4 ? 3 : 5;
    double s = 0.0;
    for (int k = 0; k < DM; ++k) { const double c = (double)a.in[1][b * DM + k]; s += c / (1.0 + exp(-c)) * (double)a.in[3][((size_t)l * DM + k) * 12288 + part * DM + col]; }
    s += (double)a.in[4][l * 12288 + part * DM + col];
    double v;
    if (slot == 0) v = (double)a.in[5][l * DM + col] * (1.0 + s); else if (slot == 1) v = s; else if (slot == 2) v = s * (double)a.in[6][l * DM + col];
    else if (slot == 3) v = (double)a.in[7][l * DM + col] * (1.0 + s); else if (slot == 4) v = s; else v = s * (double)a.in[8][l * DM + col];
    const float got = ((const float*)(a.ws + WS_VEC))[((size_t)(l * 2 + b) * 6 + slot) * DM + col];
    if (!(fabs((double)got - v) <= 1e-3 * fabs(v) + 1e-4)) dbg_fail(a.ws, code, (float)i);
}
struct ChkN { const float* xin; const float* xout; const bf16* y; const float* g; const float* av; const float* sv; const bf16* h; const float* wfox; const float* bf; const float* logf; };
__global__ void chk_norm(Args a, ChkN c, unsigned code) {
    __shared__ float sh[256]; __shared__ float hrow[DM];
    const int m = dbg_row(blockIdx.x), b = m >> 13, t = threadIdx.x; const size_t vo = (size_t)b * 6 * DM;
    float xn[8];
    float q = 0.f;
    if (c.y) { for (int j = 0; j < 8; ++j) { const float yv = bf2f(c.y[(size_t)m * DM + t + 256 * j]); q += yv * yv; } }
    q = block_sum256(q, sh);
    const float rstdy = 1.0f / sqrtf(q / DM + EPS);
    float e2 = 0.f, r2 = 0.f;
    for (int j = 0; j < 8; ++j) { const int col = t + 256 * j; float x = c.xin[(size_t)m * DM + col];
        if (c.y) { x += c.g[vo + col] * bf2f(c.y[(size_t)m * DM + col]) * rstdy; if (c.xout) { const float d = c.xout[(size_t)m * DM + col] - x; e2 += d * d; r2 += x * x; } }
        xn[j] = x; }
    e2 = block_sum256(e2, sh); r2 = block_sum256(r2, sh);
    if (c.y && c.xout && !(e2 <= 1e-4f * r2)) dbg_fail(a.ws, code, sqrtf(e2 / (r2 + 1e-30f)));
    if (!c.h) return;
    float qx = 0.f; for (int j = 0; j < 8; ++j) qx += xn[j] * xn[j];
    qx = block_sum256(qx, sh);
    const float rstdx = 1.0f / sqrtf(qx / DM + EPS);
    e2 = 0.f; r2 = 0.f;
    for (int j = 0; j < 8; ++j) { const int col = t + 256 * j; const float hv = xn[j] * rstdx * c.av[vo + col] + c.sv[vo + col]; hrow[col] = hv; const float d = bf2f(c.h[(size_t)m * DM + col]) - hv; e2 += d * d; r2 += hv * hv; }
    e2 = block_sum256(e2, sh); r2 = block_sum256(r2, sh);
    if (!(e2 <= 1e-4f * r2)) dbg_fail(a.ws, code + 40, sqrtf(e2 / (r2 + 1e-30f)));
    if (!c.wfox) return;
    __syncthreads();
    for (int hd = 0; hd < 16; ++hd) { float p = 0.f; for (int j = 0; j < 8; ++j) { const int k = t + 256 * j; p += hrow[k] * c.wfox[(size_t)k * FOX_IN + FOX_N + hd]; }
        p = block_sum256(p, sh);
        if (t == 0) { const float x = p + c.bf[hd]; const float ls = (float)(-log1p(exp(-(double)x))); const float got = c.logf[(size_t)(b * 16 + hd) * SEQ + (m & (SEQ - 1))];
            if (!(fabsf(got - ls) <= 5e-3f)) dbg_fail(a.ws, code + 80, got - ls); } }
}
struct ChkG { const bf16* A; const float* W; const bf16* out; const float* stat; int K, ldw, N, mode, ldo, qcols; float qscale; int pad; };
static ChkG mkG(const bf16* A, int K, const float* W, int ldw, int N, int mode, const bf16* out, int ldo, int qcols, float qscale, const float* stat) { ChkG c{}; c.A = A; c.W = W; c.out = out; c.stat = stat; c.K = K; c.ldw = ldw; c.N = N; c.mode = mode; c.ldo = ldo; c.qcols = qcols; c.qscale = qscale; c.pad = 0; return c; }
__global__ void chk_gemm(Args a, ChkG c, unsigned code) {
    __shared__ float sh[256]; __shared__ float arow[DFF];
    const int m = dbg_row(blockIdx.x), t = threadIdx.x;
    for (int k = t; k < c.K; k += 256) arow[k] = bf2f(c.A[(size_t)m * c.K + k]);
    __syncthreads();
    float e2 = 0.f, r2 = 0.f, s1 = 0.f, s2 = 0.f, emax = 0.f;
    for (int col = t; col < c.N; col += 256) {
        float d0 = 0.f, d1 = 0.f;
        for (int k = 0; k < c.K; ++k) { d0 += arow[k] * c.W[(size_t)k * c.ldw + col]; if (c.mode == 2) d1 += arow[k] * c.W[(size_t)k * c.ldw + DFF + col]; }
        float ex;
        if (c.mode == 0) ex = d0 * (col < c.qcols ? c.qscale : 1.0f);
        else if (c.mode == 1) ex = 0.5f * d0 * (1.0f + tanhf(0.7978845608028654f * (d0 + 0.044715f * d0 * d0 * d0)));
        else if (c.mode == 2) ex = d0 / (1.0f + expf(-d0)) * d1;
        else ex = d0;
        const float got = bf2f(c.out[(size_t)m * c.ldo + col]), d = got - ex; e2 += d * d; r2 += ex * ex; emax = fmaxf(emax, fabsf(d));
        if (c.mode == 3) s2 += ex * ex;
        if (c.mode == 1 && col >= 2048) { s1 += ex; s2 += ex * ex; }
    }
    e2 = block_sum256(e2, sh); r2 = block_sum256(r2, sh); emax = block_max256(emax, sh); s1 = block_sum256(s1, sh); s2 = block_sum256(s2, sh);
    const float rms = sqrtf(r2 / c.N);
    if (!(e2 <= 4e-4f * r2) || !(emax <= 0.15f * rms + 1e-6f)) dbg_fail(a.ws, code, sqrtf(e2 / (r2 + 1e-30f)));
    if (t == 0 && c.stat) {
        if (c.mode == 3) { float q = 0.f; for (int i = 0; i < 32; ++i) q += c.stat[(size_t)m * 32 + i]; if (!(fabsf(q - s2) <= 0.02f * s2)) dbg_fail(a.ws, code + 40, q / s2); }
        if (c.mode == 1) { float s = 0.f, q = 0.f; for (int i = 0; i < 32; ++i) { s += c.stat[((size_t)m * 32 + i) * 2]; q += c.stat[((size_t)m * 32 + i) * 2 + 1]; }
            if (!(fabsf(q - s2) <= 0.02f * s2) || !(fabsf(s - s1) <= 0.02f * fabsf(s1) + 1.0f)) dbg_fail(a.ws, code + 40, q / s2); }
    }
}
__global__ void chk_scan(Args a, unsigned code) {
    const int i = blockIdx.x * blockDim.x + threadIdx.x; if (i >= 128) return;
    const int bh = i >> 2, which = i & 3, t = which == 0 ? 0 : which == 1 ? 1000 + 13 * bh : which == 2 ? 4096 + bh : 8191;
    const float* lf = (const float*)(a.ws + WS_LOGF) + (size_t)bh * SEQ; double s = 0.0;
    for (int j = 0; j <= t; ++j) s += (double)lf[j];
    const float got = ((const float*)(a.ws + WS_CUM))[(size_t)bh * SEQ + t];
    if (!(fabs((double)got - s) <= 1e-3 + 1e-5 * fabs(s))) dbg_fail(a.ws, code, (float)((double)got - s));
}
__global__ void chk_fox(Args a, unsigned code) {
    __shared__ float sh[256]; __shared__ float sc[SEQ]; __shared__ float qv[FOX_D];
    const int bh = blockIdx.x >> 2, which = blockIdx.x & 3, b = bh >> 4, hd = bh & 15, t = threadIdx.x;
    const int i = which == 0 ? (bh % 3) : which == 1 ? 63 + 64 * (bh % 5) + (bh & 1) : which == 2 ? 3000 + 97 * bh : 8191 - (bh % 7) * 256;
    const bf16* P = (const bf16*)(a.ws + WS_PROJ); const float* cum = (const float*)(a.ws + WS_CUM) + (size_t)bh * SEQ; const size_t rb = (size_t)b * SEQ;
    if (t < FOX_D) qv[t] = bf2f(P[(rb + i) * FOX_N + hd * FOX_D + t]);
    __syncthreads();
    float mx = -INFINITY;
    for (int j = t; j <= i; j += 256) { const bf16* kp = P + (rb + j) * FOX_N + 2048 + hd * FOX_D; float d = 0.f; for (int e = 0; e < FOX_D; ++e) d += qv[e] * bf2f(kp[e]);
        d += (cum[i] - cum[j]) * LOG2E; sc[j] = d; mx = fmaxf(mx, d); }
    mx = block_max256(mx, sh);
    float l = 0.f;
    for (int j = t; j <= i; j += 256) { const float p = exp2f(sc[j] - mx); sc[j] = p; l += p; }
    l = block_sum256(l, sh);
    float e2 = 0.f, r2 = 0.f;
    if (t < FOX_D) { float o = 0.f; for (int j = 0; j <= i; ++j) o += sc[j] * bf2f(P[(rb + j) * FOX_N + 4096 + hd * FOX_D + t]); o /= l;
        const float got = bf2f(((const bf16*)(a.ws + WS_O))[(rb + i) * DM + hd * FOX_D + t]), d = got - o; e2 = d * d; r2 = o * o; }
    e2 = block_sum256(e2, sh); r2 = block_sum256(r2, sh);
    if (!(e2 <= 1e-3f * r2)) dbg_fail(a.ws, code, sqrtf(e2 / (r2 + 1e-30f)) + 10.f * which);
}
__global__ void chk_swa(Args a, unsigned code) {
    __shared__ float qv[64]; __shared__ float sc[128]; __shared__ float red[2];
    const int smp = blockIdx.x, t = threadIdx.x;
    const int b = smp & 1, hq = (smp * 5 + 3) & 31, hk = hq >> 2;
    const int i = (smp < 8) ? smp * 17 : (smp < 16) ? 127 + (smp - 8) * 128 : (smp * 131 + 29) & (SEQ - 1);
    const bf16* P = (const bf16*)(a.ws + WS_PROJ); const int* pos = (const int*)a.in[2]; const size_t rb = (size_t)b * SEQ;
    { const bf16* qp = P + (rb + i) * SWA_N + hq * SWA_D; float v = bf2f(qp[t]);
      if (t < 16) { const int k = t & 7; const float ang = (float)pos[rb + i] * ROPE_INV[k], c = cosf(ang), s = sinf(ang); const float x1 = bf2f(qp[k]), x2 = bf2f(qp[8 + k]); v = (t < 8) ? x1 * c - x2 * s : x2 * c + x1 * s; }
      qv[t] = v; }
    __syncthreads();
    const int blk = i >> 7;
    for (int jj = t; jj < 128; jj += 64) { const int j = i - jj; float d = -INFINITY;
        if (j >= 0 && j >= (blk - 1) * 128) { const bf16* kp = P + (rb + j) * SWA_N + 2048 + hk * SWA_D; d = 0.f;
            for (int e = 0; e < 64; ++e) { float kv = bf2f(kp[e]);
                if (e < 16) { const int k = e & 7; const float ang = (float)pos[rb + j] * ROPE_INV[k], c = cosf(ang), s = sinf(ang); const float x1 = bf2f(kp[k]), x2 = bf2f(kp[8 + k]); kv = (e < 8) ? x1 * c - x2 * s : x2 * c + x1 * s; }
                d += qv[e] * kv; }
            d *= 0.125f; }
        sc[jj] = d; }
    __syncthreads();
    if (t == 0) { float mx = a.in[21][hq]; for (int jj = 0; jj < 128; ++jj) mx = fmaxf(mx, sc[jj]); float l = expf(a.in[21][hq] - mx); for (int jj = 0; jj < 128; ++jj) l += expf(sc[jj] - mx); red[0] = mx; red[1] = l; }
    __syncthreads();
    float o = 0.f;
    for (int jj = 0; jj < 128; ++jj) { const int j = i - jj; if (sc[jj] > -INFINITY) o += expf(sc[jj] - red[0]) * bf2f(P[(rb + j) * SWA_N + 2560 + hk * SWA_D + t]); }
    o /= red[1];
    const float got = bf2f(((const bf16*)(a.ws + WS_O))[(rb + i) * DM + hq * SWA_D + t]);
    float e2 = (got - o) * (got - o), r2 = o * o;
    for (int of = 32; of > 0; of >>= 1) { e2 += __shfl_xor(e2, of); r2 += __shfl_xor(r2, of); }
    if (t == 0 && !(e2 <= 1e-3f * r2)) dbg_fail(a.ws, code, sqrtf(e2 / (r2 + 1e-30f)));
}
__global__ void chk_sgu(Args a, unsigned code) {
    __shared__ float mean[128], rstd[128]; __shared__ float sh[128];
    const int smp = blockIdx.x, d = threadIdx.x;
    const int g = (smp * 7 + 1) & 15, m = (smp < 4) ? smp * 128 + (smp == 0 ? 0 : 127) : (smp * 1031 + 77) & (M - 1), tt = m & 127; const size_t m0 = (size_t)(m - tt);
    const bf16* P = (const bf16*)(a.ws + WS_PROJ);
    for (int s = 0; s <= tt; ++s) { float su = 0.f, sq = 0.f; for (int c = d; c < DM; c += 128) { const float v = bf2f(P[(m0 + s) * SGU_N + 2048 + c]); su += v; sq += v * v; }
        sh[d] = su; __syncthreads(); for (int o = 64; o > 0; o >>= 1) { if (d < o) sh[d] += sh[d + o]; __syncthreads(); } const float mu = sh[0] / DM; __syncthreads();
        sh[d] = sq; __syncthreads(); for (int o = 64; o > 0; o >>= 1) { if (d < o) sh[d] += sh[d + o]; __syncthreads(); } const float var = sh[0] / DM - mu * mu; __syncthreads();
        if (d == 0) { mean[s] = mu; rstd[s] = 1.0f / sqrtf(fmaxf(var, 0.f) + EPS); } }
    __syncthreads();
    float f = 0.f; const int col = g * 128 + d;
    for (int s = 0; s <= tt; ++s) { const float vn = (bf2f(P[(m0 + s) * SGU_N + 2048 + col]) - mean[s]) * rstd[s] * a.in[15][col] + a.in[16][col]; f += a.in[17][((size_t)g * 128 + tt) * 128 + s] * vn; }
    f += a.in[18][g * 128 + tt];
    const float ex = bf2f(P[(size_t)m * SGU_N + col]) * f, got = bf2f(((const bf16*)(a.ws + WS_O))[(size_t)m * DM + col]);
    float e2 = (got - ex) * (got - ex), r2 = ex * ex;
    sh[d] = e2; __syncthreads(); for (int o = 64; o > 0; o >>= 1) { if (d < o) sh[d] += sh[d + o]; __syncthreads(); } e2 = sh[0]; __syncthreads();
    sh[d] = r2; __syncthreads(); for (int o = 64; o > 0; o >>= 1) { if (d < o) sh[d] += sh[d + o]; __syncthreads(); } r2 = sh[0];
    if (d == 0 && !(e2 <= 1e-3f * r2)) dbg_fail(a.ws, code, sqrtf(e2 / (r2 + 1e-30f)));
}
__global__ void dbg_finalize(Args a) {
    const unsigned* ctl = (const unsigned*)(a.ws + WS_CTL); const unsigned code = ctl[CW_ERR], tmo = ctl[CW_TMO] | ctl[CW_BAR + XB_TMO];
#ifdef DBG_REPORT_VALUE
    const float v = code ? 1000.f * fabsf(__uint_as_float(ctl[CW_ERRV])) : 0.f;
#else
    const float v = code ? 1000.f * (float)code : (tmo ? 999000.f : 0.f);
#endif
    if (v != 0.f) for (size_t i = (size_t)blockIdx.x * blockDim.x + threadIdx.x; i < (size_t)M * DM; i += (size_t)gridDim.x * blockDim.x) a.out[i] = v;
}
static void dbg_checks(int ph, const Args& a, hipStream_t st) {
    unsigned char* ws = a.ws; const unsigned code = (unsigned)ph + 1;
    const bf16* Hb = (const bf16*)(ws + WS_H); const bf16* Pb = (const bf16*)(ws + WS_PROJ); const bf16* Ob = (const bf16*)(ws + WS_O); const bf16* Yb = (const bf16*)(ws + WS_Y);
    const float* XA = (const float*)(ws + WS_XA); const float* vec = (const float*)(ws + WS_VEC);
    if (ph == 0) {
        for (int l = 0; l < 4; ++l) { ChkW c{a.in[9] + (size_t)l * DM * 2 * DFF, (const bf16*)(ws + WS_WGU + l * WGU_BYTES), 2 * DFF, DM, 2 * DFF, 1}; hipLaunchKernelGGL(chk_weights, dim3(64), dim3(256), 0, st, a, c, code); }
        for (int l = 0; l < 4; ++l) { ChkW c{a.in[10] + (size_t)l * DFF * DM, (const bf16*)(ws + WS_WDN + l * WDN_BYTES), DM, DFF, DM, 0}; hipLaunchKernelGGL(chk_weights, dim3(64), dim3(256), 0, st, a, c, code); }
        for (int l = 0; l < 2; ++l) { ChkW c{a.in[11] + (size_t)l * DM * FOX_IN, (const bf16*)(ws + WS_WFOXIN + l * WFOXIN_BYTES), FOX_IN, DM, FOX_N, 0}; hipLaunchKernelGGL(chk_weights, dim3(64), dim3(256), 0, st, a, c, code); }
        for (int l = 0; l < 2; ++l) { ChkW c{a.in[13] + (size_t)l * DM * DM, (const bf16*)(ws + WS_WFOXOUT + l * WSQ_BYTES), DM, DM, DM, 0}; hipLaunchKernelGGL(chk_weights, dim3(64), dim3(256), 0, st, a, c, code); }
        { ChkW c{a.in[14], (const bf16*)(ws + WS_WSGUIN), SGU_N, DM, SGU_N, 0}; hipLaunchKernelGGL(chk_weights, dim3(64), dim3(256), 0, st, a, c, code); }
        { ChkW c{a.in[19], (const bf16*)(ws + WS_WSGUOUT), DM, DM, DM, 0}; hipLaunchKernelGGL(chk_weights, dim3(64), dim3(256), 0, st, a, c, code); }
        { ChkW c{a.in[20], (const bf16*)(ws + WS_WSWAIN), SWA_N, DM, SWA_N, 0}; hipLaunchKernelGGL(chk_weights, dim3(64), dim3(256), 0, st, a, c, code); }
        { ChkW c{a.in[22], (const bf16*)(ws + WS_WSWAOUT), DM, DM, DM, 0}; hipLaunchKernelGGL(chk_weights, dim3(64), dim3(256), 0, st, a, c, code); }
        hipLaunchKernelGGL(chk_tables, dim3(256), dim3(256), 0, st, a, code + 40);
        return;
    }
    if (ph == 1) { hipLaunchKernelGGL(chk_modvec, dim3(12), dim3(256), 0, st, a, code); return; }
    if (ph == PH_FINAL) { ChkN c{XA, a.out, Yb, vec + (size_t)3 * 12 * DM + 5 * DM, nullptr, nullptr, nullptr, nullptr, nullptr, nullptr}; hipLaunchKernelGGL(chk_norm, dim3(64), dim3(256), 0, st, a, c, code); return; }
    const int r = ph - 2, l = r / 7, j = r % 7, kind = l % 3, jj = l / 3, half = j >= 4, s = 2 * l + half;
    const float* lv = vec + (size_t)l * 12 * DM;
    if (j == 0 || j == 4) {
        const float* xin = (s == 0 || s == 1) ? a.in[0] : (((s - 1) & 1) ? XA : (const float*)a.out); const float* xout = (s == 0) ? nullptr : ((s & 1) ? XA : (const float*)a.out);
        const float* gsrc = (s == 0) ? nullptr : (half ? lv + 2 * DM : vec + (size_t)(l - 1) * 12 * DM + 5 * DM);
        const bool fox = (!half && kind == 0);
        ChkN c{xin, xout, s == 0 ? nullptr : Yb, gsrc, half ? lv + 3 * DM : lv, half ? lv + 4 * DM : lv + DM, Hb, fox ? a.in[11] + (size_t)jj * DM * FOX_IN : nullptr, a.in[12] + jj * 16, (const float*)(ws + WS_LOGF)};
        hipLaunchKernelGGL(chk_norm, dim3(64), dim3(256), 0, st, a, c, code); return;
    }
    if (j == 1) {
        if (kind == 0) { hipLaunchKernelGGL(chk_scan, dim3(1), dim3(128), 0, st, a, code + 80);
            ChkG c = mkG(Hb, DM, a.in[11] + (size_t)jj * DM * FOX_IN, FOX_IN, FOX_N, 0, Pb, FOX_N, 2048, FOX_QSCALE, nullptr); hipLaunchKernelGGL(chk_gemm, dim3(64), dim3(256), 0, st, a, c, code); }
        else if (kind == 1) { ChkG c = mkG(Hb, DM, a.in[14], SGU_N, SGU_N, 1, Pb, SGU_N, 0, 1.f, (const float*)(ws + WS_VSTAT)); hipLaunchKernelGGL(chk_gemm, dim3(64), dim3(256), 0, st, a, c, code); }
        else { ChkG c = mkG(Hb, DM, a.in[20], SWA_N, SWA_N, 0, Pb, SWA_N, 0, 1.f, nullptr); hipLaunchKernelGGL(chk_gemm, dim3(64), dim3(256), 0, st, a, c, code); }
        return;
    }
    if (j == 2) { if (kind == 0) hipLaunchKernelGGL(chk_fox, dim3(128), dim3(256), 0, st, a, code); else if (kind == 1) hipLaunchKernelGGL(chk_sgu, dim3(48), dim3(128), 0, st, a, code); else hipLaunchKernelGGL(chk_swa, dim3(64), dim3(64), 0, st, a, code); return; }
    if (j == 3) { const float* W = kind == 0 ? a.in[13] + (size_t)jj * DM * DM : kind == 1 ? a.in[19] : a.in[22];
        ChkG c = mkG(Ob, DM, W, DM, DM, 3, Yb, DM, 0, 1.f, (const float*)(ws + WS_YSTAT)); hipLaunchKernelGGL(chk_gemm, dim3(64), dim3(256), 0, st, a, c, code); return; }
    if (j == 5) { ChkG c = mkG(Hb, DM, a.in[9] + (size_t)l * DM * 2 * DFF, 2 * DFF, DFF, 2, Pb, DFF, 0, 1.f, nullptr); hipLaunchKernelGGL(chk_gemm, dim3(64), dim3(256), 0, st, a, c, code); return; }
    if (j == 6) { ChkG c = mkG(Pb, DFF, a.in[10] + (size_t)l * DFF * DM, DM, DM, 3, Yb, DM, 0, 1.f, (const float*)(ws + WS_YSTAT)); hipLaunchKernelGGL(chk_gemm, dim3(64), dim3(256), 0, st, a, c, code); return; }
}
#endif
```

```cpp
#include <hip/hip_runtime.h>
#include <cstdio>
#include <cstdint>
#include <cmath>

#define PROBE_REPEAT 0
#define PROBE_STAMP 0
#define PROBE_SEL(k) 1
#ifndef DBG
#define DBG 0
#endif

namespace pg8 {
#define PG8_LAS __attribute__((address_space(3)))
typedef unsigned short bf16_t;
typedef short bf16x8 __attribute__((ext_vector_type(8)));
typedef float f32x4 __attribute__((ext_vector_type(4)));
typedef unsigned u32x4 __attribute__((ext_vector_type(4)));
constexpr int BM = 256, BK = 64, HALF = 128, HTB = HALF * BK * 2  , STAGE_BYTES = 8 * HTB, NXCD = 8, WGM = 8;

__host__ __device__ __forceinline__ int lds_byte(int r, int c) { const int st = (r >> 4) * 2 + (c >> 5), rr = r & 15, cc = c & 31, ob = rr * 64 + cc * 2; return st * 1024 + (ob ^ (((ob >> 9) & 1) << 5)); }
__host__ __device__ __forceinline__ void stage_rc(int b, int& R, int& C) { const int st = b / 1024, sb = b % 1024, swz = sb ^ (((sb >> 9) & 1) << 5); R = (st >> 1) * 16 + swz / 64; C = (st & 1) * 32 + (swz % 64) / 2; }
__host__ __device__ __forceinline__ int perm32(int rho) { const int n = rho >> 4, i = rho & 15; return 8 * (i >> 2) + 4 * n + (i & 3); }

struct Unit { int pm, pn; };
struct Gemm { const bf16_t* A; const bf16_t* Bt; int M, N, K; };

struct StaticOrder {
    int nM, nN, nwg, G, c;
    __host__ __device__ void init(int M, int N, int G_, int c_) { nM = M / BM; nN = N / BM; nwg = nM * nN; G = G_; c = c_; }
    __host__ __device__ bool next(int i, Unit& u) const {
        const long L = (long)i * G + c; if (L >= nwg) return false;
        int wgid = (int)L; { const int q = nwg / NXCD, r = nwg % NXCD, xcd = wgid % NXCD, off = wgid / NXCD; wgid = (xcd < r ? xcd * (q + 1) : r * (q + 1) + (xcd - r) * q) + off; }
        const int nig = WGM * nN, gid = wgid / nig, fm = gid * WGM, gsz = (nM - fm) < WGM ? (nM - fm) : WGM;
        u.pm = fm + ((wgid % nig) % gsz); u.pn = (wgid % nig) / gsz; return true;
    }
    __device__ __forceinline__ void a_ready(const Unit&) const {}
    __device__ __forceinline__ void done(const Unit&) const {}
};

__device__ __forceinline__ unsigned cvt_pk_bf16(float lo, float hi) { unsigned r; asm volatile("v_cvt_pk_bf16_f32 %0, %1, %2" : "=v"(r) : "v"(lo), "v"(hi)); return r; }
typedef float f32x2 __attribute__((ext_vector_type(2)));
typedef unsigned u32x2 __attribute__((ext_vector_type(2)));
__device__ __forceinline__ float fast_sigmoid(float x) { return __builtin_amdgcn_rcpf(1.0f + __builtin_amdgcn_exp2f(-1.4426950408889634f * x)); }
struct EpiProj {
    static constexpr bool PERM = true, AFTER_DRAIN = false;
    bf16_t* O; int ldc; int qcols; float qscale; float* knorm;
    __device__ __forceinline__ void operator()(const f32x4 (&acc)[2][2][4][2], const Unit& u, int wr, int wc, int fr, int fq) const {
        const int row0 = u.pm * BM + wr * 64 + fr, colt = u.pn * BM, col0 = colt + wc * 32 + 8 * fq;
        const float sc = colt < qcols ? qscale : 1.0f;
#pragma unroll
        for (int ai = 0; ai < 2; ++ai)
#pragma unroll
            for (int m = 0; m < 4; ++m) { bf16_t* rowp = O + (size_t)(row0 + ai * HALF + m * 16) * ldc + col0;
#pragma unroll
                for (int bj = 0; bj < 2; ++bj) { const f32x4 v0 = acc[ai][bj][m][0] * sc, v1 = acc[ai][bj][m][1] * sc;
                    u32x4 w; w.x = cvt_pk_bf16(v0[0], v0[1]); w.y = cvt_pk_bf16(v0[2], v0[3]); w.z = cvt_pk_bf16(v1[0], v1[1]); w.w = cvt_pk_bf16(v1[2], v1[3]);
                    *(u32x4*)(rowp + bj * HALF) = w; } }
        if (knorm && colt >= 2048 && colt < 4096) {
#pragma unroll
            for (int ai = 0; ai < 2; ++ai)
#pragma unroll
                for (int bj = 0; bj < 2; ++bj) { float mx = 0.f;
#pragma unroll
                    for (int m = 0; m < 4; ++m) { const f32x4 v0 = acc[ai][bj][m][0], v1 = acc[ai][bj][m][1];
                        float q = (v0[0] * v0[0] + v0[1] * v0[1]) + (v0[2] * v0[2] + v0[3] * v0[3]) + (v1[0] * v1[0] + v1[1] * v1[1]) + (v1[2] * v1[2] + v1[3] * v1[3]);
                        q += __shfl_xor(q, 16); q += __shfl_xor(q, 32); mx = fmaxf(mx, q); }
                    mx = fmaxf(mx, __shfl_xor(mx, 1)); mx = fmaxf(mx, __shfl_xor(mx, 2)); mx = fmaxf(mx, __shfl_xor(mx, 4)); mx = fmaxf(mx, __shfl_xor(mx, 8));
                    const int rowt = u.pm * BM + ai * HALF + wr * 64, bb = rowt >> 13, tile = (rowt & 8191) >> 6, head = ((colt - 2048) >> 7) + bj;
                    if (fr == 0 && fq == 0) knorm[((size_t)(bb * 16 + head) * 128 + tile) * 4 + wc] = mx; }
        }
    }
};
struct EpiSwiglu {
    static constexpr bool PERM = true, AFTER_DRAIN = false;
    bf16_t* Z; int ldz;
    __device__ __forceinline__ void operator()(const f32x4 (&acc)[2][2][4][2], const Unit& u, int wr, int wc, int fr, int fq) const {
        const int row0 = u.pm * BM + wr * 64 + fr, col0 = u.pn * HALF + wc * 32 + 8 * fq;
#pragma unroll
        for (int ai = 0; ai < 2; ++ai)
#pragma unroll
            for (int m = 0; m < 4; ++m) { bf16_t* rowp = Z + (size_t)(row0 + ai * HALF + m * 16) * ldz + col0;
                f32x4 z0, z1;
#pragma unroll
                for (int i = 0; i < 4; ++i) { const float g0 = acc[ai][0][m][0][i], g1 = acc[ai][0][m][1][i];
                    z0[i] = g0 * fast_sigmoid(g0) * acc[ai][1][m][0][i]; z1[i] = g1 * fast_sigmoid(g1) * acc[ai][1][m][1][i]; }
                u32x4 w; w.x = cvt_pk_bf16(z0[0], z0[1]); w.y = cvt_pk_bf16(z0[2], z0[3]); w.z = cvt_pk_bf16(z1[0], z1[1]); w.w = cvt_pk_bf16(z1[2], z1[3]);
                *(u32x4*)rowp = w; }
    }
};
struct EpiOut {
    static constexpr bool PERM = true, AFTER_DRAIN = false;
    bf16_t* Y; int ldc; float* stat;
    __device__ __forceinline__ void operator()(const f32x4 (&acc)[2][2][4][2], const Unit& u, int wr, int wc, int fr, int fq) const {
        const int row0 = u.pm * BM + wr * 64 + fr, col0 = u.pn * BM + wc * 32 + 8 * fq;
#pragma unroll
        for (int ai = 0; ai < 2; ++ai)
#pragma unroll
            for (int m = 0; m < 4; ++m) { const int row = row0 + ai * HALF + m * 16; bf16_t* rowp = Y + (size_t)row * ldc + col0; float q = 0.f;
#pragma unroll
                for (int bj = 0; bj < 2; ++bj) { const f32x4 v0 = acc[ai][bj][m][0], v1 = acc[ai][bj][m][1];
                    q += (v0[0] * v0[0] + v0[1] * v0[1]) + (v0[2] * v0[2] + v0[3] * v0[3]) + (v1[0] * v1[0] + v1[1] * v1[1]) + (v1[2] * v1[2] + v1[3] * v1[3]);
                    u32x4 w; w.x = cvt_pk_bf16(v0[0], v0[1]); w.y = cvt_pk_bf16(v0[2], v0[3]); w.z = cvt_pk_bf16(v1[0], v1[1]); w.w = cvt_pk_bf16(v1[2], v1[3]);
                    *(u32x4*)(rowp + bj * HALF) = w; }
                q += __shfl_xor(q, 16); q += __shfl_xor(q, 32);
                if (fq == 0) stat[(size_t)row * 32 + 4 * u.pn + wc] = q; }
    }
};
__device__ __forceinline__ float gelu_tanh_f(float x) { const float t = 1.5957691216057308f * (x + 0.044715f * x * x * x); return x * fast_sigmoid(t); }
struct EpiSguIn {
    static constexpr bool PERM = true, AFTER_DRAIN = false;
    bf16_t* O; int ldc; float* stat2;
    __device__ __forceinline__ void operator()(const f32x4 (&acc)[2][2][4][2], const Unit& u, int wr, int wc, int fr, int fq) const {
        const int row0 = u.pm * BM + wr * 64 + fr, col0 = u.pn * BM + wc * 32 + 8 * fq; const bool vhalf = u.pn >= 8;
#pragma unroll
        for (int ai = 0; ai < 2; ++ai)
#pragma unroll
            for (int m = 0; m < 4; ++m) { const int row = row0 + ai * HALF + m * 16; bf16_t* rowp = O + (size_t)row * ldc + col0; float s = 0.f, q = 0.f;
#pragma unroll
                for (int bj = 0; bj < 2; ++bj) { f32x4 v0, v1;
#pragma unroll
                    for (int i = 0; i < 4; ++i) { v0[i] = gelu_tanh_f(acc[ai][bj][m][0][i]); v1[i] = gelu_tanh_f(acc[ai][bj][m][1][i]); }
                    s += (v0[0] + v0[1]) + (v0[2] + v0[3]) + (v1[0] + v1[1]) + (v1[2] + v1[3]);
                    q += (v0[0] * v0[0] + v0[1] * v0[1]) + (v0[2] * v0[2] + v0[3] * v0[3]) + (v1[0] * v1[0] + v1[1] * v1[1]) + (v1[2] * v1[2] + v1[3] * v1[3]);
                    u32x4 w; w.x = cvt_pk_bf16(v0[0], v0[1]); w.y = cvt_pk_bf16(v0[2], v0[3]); w.z = cvt_pk_bf16(v1[0], v1[1]); w.w = cvt_pk_bf16(v1[2], v1[3]);
                    *(u32x4*)(rowp + bj * HALF) = w; }
                if (vhalf) { s += __shfl_xor(s, 16); s += __shfl_xor(s, 32); q += __shfl_xor(q, 16); q += __shfl_xor(q, 32);
                    if (fq == 0) { float* sp = stat2 + ((size_t)row * 32 + 4 * (u.pn - 8) + wc) * 2; sp[0] = s; sp[1] = q; } } }
    }
};
template <class Epi, class Sched, bool ALIGN_EPI = false, bool SP2 = false>
__device__ __forceinline__ void gemm_phase(PG8_LAS unsigned char* lds, const Gemm g, const Sched& S, const Epi& E) {
    int tid_ = threadIdx.x; asm volatile("" : "+v"(tid_));
    const int tid = tid_, wid = __builtin_amdgcn_readfirstlane(tid >> 6), lane = tid & 63, wr = wid >> 2, wc = wid & 3, fr = lane & 15, fq = lane >> 4;
    const int K = g.K, nt = K / BK;
    unsigned voffA[2], voffB[2];
#pragma unroll
    for (int i = 0; i < 2; ++i) { int R, C; stage_rc(tid * 16 + i * 8192, R, C); const int Rb = Epi::PERM ? ((R & ~31) + perm32(R & 31)) : R;
        voffA[i] = (unsigned)(R * K + C) * 2u; voffB[i] = (unsigned)(Rb * K + C) * 2u; }
    const size_t kstep = (size_t)(BK * 2);
    const size_t hstep = (size_t)HALF * K * 2;
    const size_t tstep = 2 * hstep;
    const unsigned ldsw = (unsigned)wid * 1024u;
    const int aoff = lds_byte(wr * 64 + fr, fq * 8), boff = lds_byte(wc * 32 + fr, fq * 8);
#define PG8_SA(b, h) (((b) * 2 + (h)) * HTB)
#define PG8_SB(b, h) ((4 + (b) * 2 + (h)) * HTB)
#define PG8_STAGE(bufoff, gbase, voff) do { _Pragma("unroll") for (int _i = 0; _i < 2; ++_i) \
        __builtin_amdgcn_global_load_lds((const unsigned*)((const char*)(gbase) + (voff)[_i]), (PG8_LAS unsigned*)(lds + (bufoff) + ldsw + _i * 8192), 16, 0, 0); } while (0)
#define PG8_LDA(dst, b, h) do { _Pragma("unroll") for (int m = 0; m < 4; ++m) _Pragma("unroll") for (int k = 0; k < 2; ++k) dst[m][k] = *(const PG8_LAS bf16x8*)(lds + PG8_SA(b, h) + aoff + m * 2048 + k * 1024); } while (0)
#define PG8_LDB(dst, b, h) do { _Pragma("unroll") for (int n = 0; n < 2; ++n) _Pragma("unroll") for (int k = 0; k < 2; ++k) dst[n][k] = *(const PG8_LAS bf16x8*)(lds + PG8_SB(b, h) + boff + n * 2048 + k * 1024); } while (0)
#define PG8_MMA(ai, bj, At, Bt) do { __builtin_amdgcn_s_setprio(1); _Pragma("unroll") for (int m = 0; m < 4; ++m) _Pragma("unroll") for (int n = 0; n < 2; ++n) _Pragma("unroll") for (int k = 0; k < 2; ++k) \
        acc[ai][bj][m][n] = __builtin_amdgcn_mfma_f32_16x16x32_bf16(Bt[n][k], At[m][k], acc[ai][bj][m][n], 0, 0, 0); __builtin_amdgcn_s_setprio(0); } while (0)
#define PG8_WAIT_V(n) asm volatile("s_waitcnt vmcnt(" #n ")" ::: "memory")
#define PG8_WAIT_L(n) asm volatile("s_waitcnt lgkmcnt(" #n ")" ::: "memory")
#define PG8_BAR __builtin_amdgcn_s_barrier()
#define PG8_SCHED __builtin_amdgcn_sched_barrier(0)
    Unit cur, nxt; int ui = 0;
    if (!S.next(0, cur)) return;
    f32x4 acc[2][2][4][2];
#pragma unroll
    for (int a = 0; a < 2; ++a)
#pragma unroll
        for (int b = 0; b < 2; ++b)
#pragma unroll
            for (int m = 0; m < 4; ++m)
#pragma unroll
                for (int n = 0; n < 2; ++n) acc[a][b][m][n] = (f32x4){0.f, 0.f, 0.f, 0.f};
    bf16x8 At[4][2], B0[2][2], B1[2][2];
    const char* cA = (const char*)g.A + (size_t)cur.pm * tstep; const char* cB = (const char*)g.Bt + (size_t)cur.pn * tstep;
    S.a_ready(cur);
    if constexpr (SP2) {
        PG8_STAGE(PG8_SB(0, 0), cB, voffB); PG8_STAGE(PG8_SB(0, 1), cB + hstep, voffB); PG8_STAGE(PG8_SA(0, 0), cA, voffA); PG8_STAGE(PG8_SA(0, 1), cA + hstep, voffA);
        if (wr == 1) PG8_BAR;
        PG8_WAIT_V(2); PG8_BAR;
        PG8_STAGE(PG8_SB(1, 0), cB + kstep, voffB); PG8_STAGE(PG8_SA(1, 0), cA + kstep, voffA); PG8_STAGE(PG8_SB(1, 1), cB + hstep + kstep, voffB);
        PG8_WAIT_V(6); PG8_BAR;
    } else {
        PG8_STAGE(PG8_SB(0, 0), cB, voffB); PG8_STAGE(PG8_SA(0, 0), cA, voffA); PG8_STAGE(PG8_SB(0, 1), cB + hstep, voffB); PG8_STAGE(PG8_SA(0, 1), cA + hstep, voffA);
        if (wr == 1) PG8_BAR;
        PG8_WAIT_V(4); PG8_BAR;
        PG8_STAGE(PG8_SB(1, 0), cB + kstep, voffB); PG8_STAGE(PG8_SA(1, 0), cA + kstep, voffA); PG8_STAGE(PG8_SB(1, 1), cB + hstep + kstep, voffB);
        PG8_WAIT_V(6); PG8_BAR;
    }
    for (;;) {
        const bool has_next = S.next(ui + 1, nxt);
        const char* nA = has_next ? (const char*)g.A + (size_t)nxt.pm * tstep : cA; const char* nB = has_next ? (const char*)g.Bt + (size_t)nxt.pn * tstep : cB;
        for (int t = 0; t < nt; t += 2) {
            const bool last = (t == nt - 2);
            const char* a1 = cA + (size_t)(t + 1) * kstep;
            const char* a2 = last ? nA : cA + (size_t)(t + 2) * kstep; const char* b2 = last ? nB : cB + (size_t)(t + 2) * kstep;
            const char* a3 = a2 + kstep; const char* b3 = b2 + kstep;
            if (last && has_next) S.a_ready(nxt);
            if constexpr (SP2) {
            PG8_LDB(B0, 0, 0); PG8_LDB(B1, 0, 1); PG8_SCHED; PG8_LDA(At, 0, 0); PG8_STAGE(PG8_SA(1, 1), a1 + hstep, voffA);
            PG8_WAIT_V(8); PG8_WAIT_L(0); PG8_BAR; PG8_MMA(0, 0, At, B0); PG8_MMA(0, 1, At, B1); PG8_BAR; PG8_SCHED;
            PG8_LDA(At, 0, 1); PG8_STAGE(PG8_SB(0, 0), b2, voffB); PG8_STAGE(PG8_SB(0, 1), b2 + hstep, voffB); PG8_STAGE(PG8_SA(0, 0), a2, voffA);
            PG8_WAIT_V(8); PG8_WAIT_L(0); PG8_BAR; PG8_MMA(1, 0, At, B0); PG8_MMA(1, 1, At, B1); PG8_BAR; PG8_SCHED;
            PG8_LDB(B0, 1, 0); PG8_LDB(B1, 1, 1); PG8_SCHED; PG8_LDA(At, 1, 0); PG8_STAGE(PG8_SA(0, 1), a2 + hstep, voffA);
            PG8_WAIT_V(8); PG8_WAIT_L(0); PG8_BAR; PG8_MMA(0, 0, At, B0); PG8_MMA(0, 1, At, B1); PG8_BAR; PG8_SCHED;
            PG8_LDA(At, 1, 1); PG8_STAGE(PG8_SB(1, 0), b3, voffB); PG8_STAGE(PG8_SB(1, 1), b3 + hstep, voffB); PG8_STAGE(PG8_SA(1, 0), a3, voffA);
            PG8_WAIT_V(8); PG8_WAIT_L(0); PG8_BAR; PG8_MMA(1, 0, At, B0); PG8_MMA(1, 1, At, B1); PG8_BAR; PG8_SCHED;
            } else {
            PG8_LDB(B0, 0, 0); PG8_SCHED; PG8_LDA(At, 0, 0); PG8_STAGE(PG8_SA(1, 1), a1 + hstep, voffA);
            PG8_WAIT_L(8); PG8_BAR; PG8_WAIT_L(0); PG8_MMA(0, 0, At, B0); PG8_BAR; PG8_SCHED;
            PG8_LDB(B1, 0, 1); PG8_STAGE(PG8_SB(0, 0), b2, voffB);
            PG8_BAR; PG8_WAIT_L(0); PG8_MMA(0, 1, At, B1); PG8_BAR;
            PG8_LDA(At, 0, 1); PG8_STAGE(PG8_SA(0, 0), a2, voffA);
            PG8_BAR; PG8_WAIT_L(0); PG8_MMA(1, 0, At, B0); PG8_BAR; PG8_SCHED;
            PG8_STAGE(PG8_SB(0, 1), b2 + hstep, voffB);
            PG8_WAIT_V(6); PG8_BAR; PG8_MMA(1, 1, At, B1); PG8_BAR;
            PG8_LDB(B0, 1, 0); PG8_SCHED; PG8_LDA(At, 1, 0); PG8_STAGE(PG8_SA(0, 1), a2 + hstep, voffA);
            PG8_WAIT_L(8); PG8_BAR; PG8_WAIT_L(0); PG8_MMA(0, 0, At, B0); PG8_BAR; PG8_SCHED;
            PG8_LDB(B1, 1, 1); PG8_STAGE(PG8_SB(1, 0), b3, voffB);
            PG8_BAR; PG8_WAIT_L(0); PG8_MMA(0, 1, At, B1); PG8_BAR;
            PG8_LDA(At, 1, 1); PG8_STAGE(PG8_SA(1, 0), a3, voffA);
            PG8_BAR; PG8_WAIT_L(0); PG8_MMA(1, 0, At, B0); PG8_BAR; PG8_SCHED;
            PG8_STAGE(PG8_SB(1, 1), b3 + hstep, voffB);
            PG8_WAIT_V(6); PG8_BAR; PG8_MMA(1, 1, At, B1); PG8_BAR;
            }
        }
        if constexpr (ALIGN_EPI) { if (wr == 0) PG8_BAR; }
        if constexpr (!Epi::AFTER_DRAIN) { E(acc, cur, wr, wc, fr, fq); S.done(cur); }
        if (!has_next) break;
#pragma unroll
        for (int a = 0; a < 2; ++a)
#pragma unroll
            for (int b = 0; b < 2; ++b)
#pragma unroll
                for (int m = 0; m < 4; ++m)
#pragma unroll
                    for (int n = 0; n < 2; ++n) acc[a][b][m][n] = (f32x4){0.f, 0.f, 0.f, 0.f};
        cur = nxt; cA = nA; cB = nB; ++ui;
        if constexpr (ALIGN_EPI) { if (wr == 1) PG8_BAR; }
    }
    PG8_WAIT_V(0);
    if constexpr (!ALIGN_EPI) { if (wr == 0) PG8_BAR; }
    PG8_BAR;
    if constexpr (Epi::AFTER_DRAIN) { E.fused(acc, cur, wr, wc, fr, fq, lds, wid, lane); S.done(cur); }
#undef PG8_SA
#undef PG8_SB
#undef PG8_STAGE
#undef PG8_LDA
#undef PG8_LDB
#undef PG8_MMA
#undef PG8_WAIT_V
#undef PG8_WAIT_L
#undef PG8_BAR
#undef PG8_SCHED
}
}
#define GAS __attribute__((address_space(1)))
#define LAS __attribute__((address_space(3)))
typedef unsigned short bf16;
typedef unsigned v4u __attribute__((ext_vector_type(4)));
typedef float f32x4 __attribute__((ext_vector_type(4)));
typedef short bf16x8 __attribute__((ext_vector_type(8)));
typedef GAS unsigned gu32;
typedef GAS unsigned long long gu64;
#define RLX_AGENT __ATOMIC_RELAXED, __HIP_MEMORY_SCOPE_AGENT
#define LDS_WAIT() asm volatile("s_waitcnt lgkmcnt(0)" ::: "memory")
#define VM_WAIT() asm volatile("s_waitcnt vmcnt(0)" ::: "memory")
__device__ __forceinline__ unsigned long long rt() { return __builtin_amdgcn_s_memrealtime(); }
__device__ __forceinline__ unsigned f2bf(float f) { unsigned u = __builtin_bit_cast(unsigned, f); return (u + 0x7fffu + ((u >> 16) & 1u)) >> 16; }
__device__ __forceinline__ unsigned pk2(float lo, float hi) { return f2bf(lo) | (f2bf(hi) << 16); }
#define XB_TMO      128
#define XB_XCNT(j)  (256  + 64 * (j))
#define XB_XSUB(j)  (1280 + 64 * (j))
#define XB_XGEN(j)  (2304 + 64 * (j))
#define XB_TOP      3328
#define XB_TOPGEN   3392
#define XCD_BAR_WORDS 3456
#define XB_SPIN_CAP (1u << 18)

__device__ __forceinline__ unsigned xb_ld(unsigned* p)              { return __hip_atomic_load(p, __ATOMIC_RELAXED, __HIP_MEMORY_SCOPE_AGENT); }
__device__ __forceinline__ unsigned xb_add(unsigned* p, unsigned v) { return __hip_atomic_fetch_add(p, v, __ATOMIC_RELAXED, __HIP_MEMORY_SCOPE_AGENT); }
__device__ __forceinline__ unsigned xb_xcc_id() { return (unsigned)__builtin_amdgcn_s_getreg((3 << 11) | 20) & 0xFu; }
#define XB_SPIN(cond, bar) do { unsigned _sp = 0; while (cond) { __builtin_amdgcn_s_sleep(1); \
    if ((++_sp & 255u) == 0u) { if (xb_ld(&(bar)[XB_TMO])) break; if (_sp > XB_SPIN_CAP) { atomicAdd(&(bar)[XB_TMO], 1u); break; } } } } while (0)

struct XcdBarrier {
    unsigned* bar; unsigned x;
    volatile LAS unsigned* st;
};

__device__ __forceinline__ XcdBarrier xcd_barrier_post(unsigned* bar, volatile LAS unsigned* st) {
    XcdBarrier b; b.bar = bar; b.x = xb_xcc_id(); b.st = st;
    if (threadIdx.x == 0) (void)xb_add(&bar[XB_XCNT(b.x)], 1u);
    return b;
}
__device__ __forceinline__ void xcd_barrier_complete(unsigned* bar, unsigned x, unsigned& nloc, unsigned& nx) {
    const unsigned G = gridDim.x * gridDim.y * gridDim.z;
    unsigned sum, cnt, mine, sp = 0u;
    for (;;) {
        sum = 0u; cnt = 0u; mine = 0u;
#pragma unroll
        for (unsigned j = 0; j < 16; ++j) { const unsigned c = xb_ld(&bar[XB_XCNT(j)]); sum += c; cnt += (c > 0u) ? 1u : 0u; mine = (j == x) ? c : mine; }
        if (sum == G) break;
        __builtin_amdgcn_s_sleep(1);
        if ((++sp & 255u) == 0u) { if (xb_ld(&bar[XB_TMO])) break; if (sp > XB_SPIN_CAP) { atomicAdd(&bar[XB_TMO], 1u); break; } }
    }
    nloc = mine > 0u ? mine : 1u; nx = cnt > 0u ? cnt : 1u;
}

__device__ __forceinline__ void xcd_barrier(const XcdBarrier& b) {
    asm volatile("s_waitcnt vmcnt(0)" ::: "memory");
    __syncthreads();
    if (threadIdx.x == 0) {
        unsigned* bar = b.bar;
        __builtin_amdgcn_s_waitcnt(0);
        unsigned nloc = b.st[0], nx = b.st[1];
        if (nloc == 0u) { xcd_barrier_complete(bar, b.x, nloc, nx); b.st[0] = nloc; b.st[1] = nx; }
        const unsigned old = xb_add(&bar[XB_XSUB(b.x)], 1u);
        const unsigned gen = old / nloc;
        if (old + 1u == (gen + 1u) * nloc) {
            __builtin_amdgcn_fence(__ATOMIC_RELEASE, "agent");
            asm volatile("s_waitcnt vmcnt(0)" ::: "memory");
            const unsigned og = xb_add(&bar[XB_TOP], 1u);
            const unsigned tg = og / nx;
            if (og + 1u == (tg + 1u) * nx) xb_add(&bar[XB_TOPGEN], 1u);
            else XB_SPIN(xb_ld(&bar[XB_TOPGEN]) == tg, bar);
            __builtin_amdgcn_fence(__ATOMIC_ACQUIRE, "agent");
            xb_add(&bar[XB_XGEN(b.x)], 1u);
            asm volatile("s_waitcnt vmcnt(0)" ::: "memory");
        } else {
            XB_SPIN(xb_ld(&bar[XB_XGEN(b.x)]) == gen, bar);
            __builtin_amdgcn_fence(__ATOMIC_ACQUIRE, "agent");
            asm volatile("s_waitcnt vmcnt(0)" ::: "memory");
        }
    }
    __syncthreads();
}
typedef float f32x16 __attribute__((ext_vector_type(16)));
typedef unsigned u32x2 __attribute__((ext_vector_type(2)));
typedef short s16x4 __attribute__((ext_vector_type(4)));
typedef unsigned u32x4 __attribute__((ext_vector_type(4)));
__device__ __forceinline__ float bf2f(unsigned h) { return __builtin_bit_cast(float, h << 16); }

constexpr int NWAVES = 8, NTHR = 512;
constexpr int BATCH = 2, SEQ = 8192, DM = 2048, M = BATCH * SEQ, DEPTH = 4, DFF = 5632;
constexpr int FOX_H = 16, FOX_D = 128, FOX_IN = 6160, FOX_N = 6144;
constexpr int SWA_D = 64, SWA_HQ = 32, SWA_HK = 8, SWA_N = 3072;
constexpr int SGU_N = 4096;
constexpr float EPS = 1e-6f, LOG2E = 1.4426950408889634f;
constexpr float FOX_QSCALE = 0.08838834764831845f * LOG2E;
constexpr float SWA_QSCALE = 0.125f * LOG2E;
constexpr int MOD_KS = 32;

constexpr size_t MiB = 1u << 20;
constexpr size_t WS_CTL = 0, CTL_ZERO_BYTES = 1 * MiB;
constexpr size_t WS_VEC = 1 * MiB;
constexpr size_t WS_ROPE = 2 * MiB;
constexpr size_t WS_WFG = 3 * MiB;
constexpr size_t WS_WSM = 3 * MiB + 512 * 1024;
constexpr size_t WS_LOGF = 4 * MiB;
constexpr size_t WS_CUM = 5 * MiB;
constexpr size_t WS_KNORM = 1 * MiB + 512 * 1024;
constexpr size_t WS_YSTAT = 6 * MiB;
constexpr size_t WS_VSTAT = 8 * MiB;
constexpr size_t WS_MODP = 12 * MiB;
constexpr size_t WS_WGU = 24 * MiB, WGU_BYTES = 44 * MiB;
constexpr size_t WS_WDN = 200 * MiB, WDN_BYTES = 22 * MiB;
constexpr size_t WS_WFOXIN = 288 * MiB, WFOXIN_BYTES = 24 * MiB;
constexpr size_t WS_WFOXOUT = 336 * MiB, WSQ_BYTES = 8 * MiB;
constexpr size_t WS_WSGUIN = 352 * MiB, WS_WSGUOUT = 368 * MiB, WS_WSWAIN = 376 * MiB, WS_WSWAOUT = 388 * MiB;
constexpr size_t WS_H = 396 * MiB;
constexpr size_t WS_PROJ = 460 * MiB;
constexpr size_t WS_O = 652 * MiB;
constexpr size_t WS_Y = 716 * MiB;
constexpr size_t WS_XA = 780 * MiB;
constexpr size_t WS_END = 908 * MiB;
constexpr int CW_TMO = 0, CW_CODE = 1, CW_BAR = 4096, CW_ERR = 8192, CW_ERRV = 8193, CW_NCHK = 8194, CW_TICKET = 8256;

constexpr int RING_BYTES = 131072, LDSCTL_OFF = RING_BYTES, MISC_OFF = LDSCTL_OFF + 320, LDS_BYTES = 147456;

struct Args { const float* in[23]; float* out; unsigned char* ws; int ph_lo, ph_hi; };
static_assert(sizeof(Args) == 25 * 8 + 8, "Args has no padding");

struct Frame {
    LAS unsigned char* lds;
    int tid, lane, wave, vcu, G;
};
__device__ __forceinline__ Frame launder(const Frame& Fi) { Frame F = Fi; asm volatile("" : "+v"(F.tid)); F.lane = F.tid & 63; F.wave = __builtin_amdgcn_readfirstlane(F.tid >> 6); asm volatile("" : "+s"(F.vcu)); return F; }
__device__ __forceinline__ float wave_sum(float v) {
#pragma unroll
    for (int o = 1; o < 64; o <<= 1) v += __shfl_xor(v, o);
    return v;
}
__device__ __forceinline__ float wave_max(float v) {
#pragma unroll
    for (int o = 1; o < 64; o <<= 1) v = fmaxf(v, __shfl_xor(v, o));
    return v;
}

__device__ __forceinline__ void p0_transpose_item(const float* W, int ldw, int K, bf16* WT, int k0, int n0, int c0, LAS float* scr, int lane) {
#pragma unroll 8
    for (int i = 0; i < 32; ++i) { const int kk = 2 * i + (lane >> 5); scr[kk * 33 + (lane & 31)] = W[(size_t)(k0 + kk) * ldw + c0 + (lane & 31)]; }
    LDS_WAIT(); asm volatile("" ::: "memory");
    const int c = lane & 7;
#pragma unroll
    for (int j = 0; j < 4; ++j) { const int n = (lane >> 3) + 8 * j; const LAS float* s = scr + (8 * c) * 33 + n;
        v4u o; o.x = pk2(s[0 * 33], s[1 * 33]); o.y = pk2(s[2 * 33], s[3 * 33]); o.z = pk2(s[4 * 33], s[5 * 33]); o.w = pk2(s[6 * 33], s[7 * 33]);
        *(GAS v4u*)(WT + (size_t)(n0 + n) * K + k0 + 8 * c) = o; }
    LDS_WAIT(); asm volatile("" ::: "memory");
}
constexpr int IT_GU = 32 * 352, IT_DN = 88 * 64, IT_FOXIN = 32 * 192, IT_SQ = 32 * 64, IT_SGUIN = 32 * 128, IT_SWAIN = 32 * 96;
constexpr int IT_TOTAL = 4 * IT_GU + 4 * IT_DN + 2 * IT_FOXIN + 2 * IT_SQ + IT_SGUIN + IT_SQ + IT_SWAIN + IT_SQ;
constexpr int MOD_CHUNKS = 12288 / 256;
constexpr int IT_MOD = DEPTH * MOD_KS * MOD_CHUNKS;
__device__ __forceinline__ void conv_item(const Args& a, int r, LAS float* scr, int lane) {
    unsigned char* ws = a.ws;
    const float* W; int ldw, K, N; bf16* WT; int gu = 0;
    if (r < 4 * IT_GU) { const int l = r / IT_GU; r -= l * IT_GU; W = a.in[9] + (size_t)l * DM * 2 * DFF; ldw = 2 * DFF; K = DM; N = 2 * DFF; WT = (bf16*)(ws + WS_WGU + l * WGU_BYTES); gu = 1; }
    else { r -= 4 * IT_GU;
    if (r < 4 * IT_DN) { const int l = r / IT_DN; r -= l * IT_DN; W = a.in[10] + (size_t)l * DFF * DM; ldw = DM; K = DFF; N = DM; WT = (bf16*)(ws + WS_WDN + l * WDN_BYTES); }
    else { r -= 4 * IT_DN;
    if (r < 2 * IT_FOXIN) { const int l = r / IT_FOXIN; r -= l * IT_FOXIN; W = a.in[11] + (size_t)l * DM * FOX_IN; ldw = FOX_IN; K = DM; N = FOX_N; WT = (bf16*)(ws + WS_WFOXIN + l * WFOXIN_BYTES); }
    else { r -= 2 * IT_FOXIN;
    if (r < 2 * IT_SQ) { const int l = r / IT_SQ; r -= l * IT_SQ; W = a.in[13] + (size_t)l * DM * DM; ldw = DM; K = DM; N = DM; WT = (bf16*)(ws + WS_WFOXOUT + l * WSQ_BYTES); }
    else { r -= 2 * IT_SQ;
    if (r < IT_SGUIN) { W = a.in[14]; ldw = SGU_N; K = DM; N = SGU_N; WT = (bf16*)(ws + WS_WSGUIN); }
    else { r -= IT_SGUIN;
    if (r < IT_SQ) { W = a.in[19]; ldw = DM; K = DM; N = DM; WT = (bf16*)(ws + WS_WSGUOUT); }
    else { r -= IT_SQ;
    if (r < IT_SWAIN) { W = a.in[20]; ldw = SWA_N; K = DM; N = SWA_N; WT = (bf16*)(ws + WS_WSWAIN); }
    else { r -= IT_SWAIN; W = a.in[22]; ldw = DM; K = DM; N = DM; WT = (bf16*)(ws + WS_WSWAOUT); } } } } } } }
    const int nblk = N / 32, kb = r / nblk, nb = r % nblk, n0 = 32 * nb;
    int c0 = n0;
    if (gu) { const int tile = n0 >> 8, bj = (n0 >> 7) & 1, j = n0 & 127; c0 = bj * DFF + tile * 128 + j; }
    p0_transpose_item(W, ldw, K, WT, 64 * kb, n0, c0, scr, lane);
}
__device__ __forceinline__ void mod_item(const Args& a, int r, const LAS float* sc, int lane) {
    const int l = r / (MOD_KS * MOD_CHUNKS), ks = (r / MOD_CHUNKS) % MOD_KS, ch = r % MOD_CHUNKS;
    const float* W = a.in[3] + ((size_t)l * DM + ks * 64) * 12288 + ch * 256 + lane * 4;
    f32x4 a0 = {0.f, 0.f, 0.f, 0.f}, a1 = {0.f, 0.f, 0.f, 0.f};
#pragma unroll 8
    for (int k = 0; k < 64; ++k) { const f32x4 w = *(const f32x4*)(W + (size_t)k * 12288); const float s0 = sc[ks * 64 + k], s1 = sc[DM + ks * 64 + k]; a0 += w * s0; a1 += w * s1; }
    float* P = (float*)(a.ws + WS_MODP) + ((size_t)(l * MOD_KS + ks) * 2) * 12288 + ch * 256 + lane * 4;
    *(f32x4*)P = a0; *(f32x4*)(P + 12288) = a1;
}
__device__ __forceinline__ double sin_poly(double r) { const double r2 = r * r; return r * (1.0 + r2 * (-1.0 / 6 + r2 * (1.0 / 120 + r2 * (-1.0 / 5040 + r2 * (1.0 / 362880 + r2 * (-1.0 / 39916800 + r2 * (1.0 / 6227020800.0 + r2 * (-1.0 / 1307674368000.0)))))))); }
__device__ __forceinline__ double cos_poly(double r) { const double r2 = r * r; return 1.0 + r2 * (-0.5 + r2 * (1.0 / 24 + r2 * (-1.0 / 720 + r2 * (1.0 / 40320 + r2 * (-1.0 / 3628800 + r2 * (1.0 / 479001600.0 + r2 * (-1.0 / 87178291200.0 + r2 * (1.0 / 20922789888000.0)))))))); }
__device__ __forceinline__ void sincos_f32angle(float ang, float& c, float& s) {
    const double x = (double)ang, q = rint(x * 0.6366197723675814);
    const double r = (x - q * 1.5707963267948966) - q * 6.123233995736766e-17;
    const int n = ((int)(long long)q) & 3;
    const double sr = sin_poly(r), cr = cos_poly(r);
    const double ss = (n == 0) ? sr : (n == 1) ? cr : (n == 2) ? -sr : -cr;
    const double cc = (n == 0) ? cr : (n == 1) ? -sr : (n == 2) ? -cr : sr;
    c = (float)cc; s = (float)ss;
}
__constant__ float ROPE_INV[8] = {1.0f, 0.193922743f, 0.0376060307f, 0.00729266461f, 0.00141421356f, 0.000274248188f, 5.3182961e-05f, 1.03133862e-05f};
__device__ __forceinline__ void p0_prologue(const Frame& Fi, const Args& a) {
    Frame F = launder(Fi);
    unsigned char* ws = a.ws;
    LAS float* sc = (LAS float*)(F.lds + 8 * 8704);
    for (int i = F.tid; i < 2 * DM; i += NTHR) { const float v = a.in[1][i]; sc[i] = v / (1.0f + expf(-v)); }
    __syncthreads();
    LAS float* scr = (LAS float*)(F.lds + F.wave * 8704);
    const int gw = F.vcu * NWAVES + F.wave, NGW = F.G * NWAVES;
    for (int it = gw; it < IT_MOD + IT_TOTAL; it += NGW) { if (it < IT_MOD) mod_item(a, it, sc, F.lane); else conv_item(a, it - IT_MOD, scr, F.lane); }
    const int gt = F.vcu * NTHR + F.tid, NGT = F.G * NTHR;
    float* rope = (float*)(ws + WS_ROPE); const int* pos = (const int*)a.in[2];
    for (int i = gt; i < M * 8; i += NGT) { const int m = i >> 3, k = i & 7; const float ang = (float)pos[m] * ROPE_INV[k]; float c, s; sincos_f32angle(ang, c, s); rope[m * 16 + k] = c; rope[m * 16 + 8 + k] = s; }
    float* wfg = (float*)(ws + WS_WFG);
    for (int i = gt; i < 2 * 16 * DM; i += NGT) { const int j = i / (16 * DM), hd = (i / DM) % 16, k = i % DM; wfg[i] = a.in[11][((size_t)j * DM + k) * FOX_IN + FOX_N + hd]; }
    bf16* wsm = (bf16*)(ws + WS_WSM);
    for (int i = gt; i < 16 * 128 * 128; i += NGT) { const int t = (i >> 7) & 127, s = i & 127; wsm[i] = (bf16)(s <= t ? f2bf(a.in[17][i]) : 0u); }
}
__device__ __forceinline__ void p1_modvec(const Frame& Fi, const Args& a) {
    Frame F = launder(Fi);
    const int gt = F.vcu * NTHR + F.tid, NGT = F.G * NTHR;
    const float* modp = (const float*)(a.ws + WS_MODP); float* vec = (float*)(a.ws + WS_VEC);
    for (int i = gt; i < DEPTH * 2 * 6 * DM; i += NGT) {
        const int col = i % DM, part = (i / DM) % 6, b = (i / (6 * DM)) % 2, l = i / (12 * DM);
        float s = 0.f;
        for (int ks = 0; ks < MOD_KS; ++ks) s += modp[((size_t)(l * MOD_KS + ks) * 2 + b) * 12288 + part * DM + col];
        s += a.in[4][l * 12288 + part * DM + col];
        float v; int slot;
        if (part == 0) { v = s; slot = 1; } else if (part == 1) { v = a.in[5][l * DM + col] * (1.0f + s); slot = 0; } else if (part == 2) { v = s * a.in[6][l * DM + col]; slot = 2; }
        else if (part == 3) { v = s; slot = 4; } else if (part == 4) { v = a.in[7][l * DM + col] * (1.0f + s); slot = 3; } else { v = s * a.in[8][l * DM + col]; slot = 5; }
        vec[((size_t)(l * 2 + b) * 6 + slot) * DM + col] = v;
    }
}
__device__ __forceinline__ float log_sigmoidf(float x) { return x < 0.f ? x - log1pf(expf(x)) : -log1pf(expf(-x)); }
template <bool XF32> __device__ __forceinline__ void norm_phase(const Frame& Fi, const float* xif, const bf16* xib, bf16* xob, float* xof, const bf16* y, const float* ystat, const float* gvec, const float* avec, const float* shvec,
                                           bf16* hout, const float* wfg, const float* bfv, float* logf) {
    Frame F = launder(Fi);
    const int lane = F.lane;
    if (wfg) { for (int i = F.tid; i < 16 * DM / 4; i += NTHR) ((LAS f32x4*)F.lds)[i] = ((const f32x4*)wfg)[i]; __syncthreads(); }
    const int gw = F.vcu * NWAVES + F.wave, NGW = F.G * NWAVES;
    int curb = -1; f32x4 av[4][2], sv[4][2], gv[4][2];
#pragma unroll
    for (int j = 0; j < 4; ++j)
#pragma unroll
        for (int e = 0; e < 2; ++e) { av[j][e] = (f32x4){0.f, 0.f, 0.f, 0.f}; sv[j][e] = av[j][e]; gv[j][e] = av[j][e]; }
    u32x4 nb[XF32 ? 1 : 4]; u32x4 ny[4]; float nqs = 0.f;
#pragma unroll
    for (int j = 0; j < 4; ++j) { if (!XF32) nb[XF32 ? 0 : j] = (u32x4){0u, 0u, 0u, 0u}; ny[j] = (u32x4){0u, 0u, 0u, 0u}; }
#define NP_LOAD(mm) do { if (!XF32) { const u32x4* xr_ = (const u32x4*)(xib + (size_t)(mm) * DM); _Pragma("unroll") for (int j = 0; j < 4; ++j) nb[XF32 ? 0 : j] = xr_[64 * j + lane]; } \
        if (y) { const u32x4* yr_ = (const u32x4*)(y + (size_t)(mm) * DM); _Pragma("unroll") for (int j = 0; j < 4; ++j) ny[j] = yr_[64 * j + lane]; nqs = lane < 32 ? ystat[(size_t)(mm) * 32 + lane] : 0.f; } } while (0)
#define NP_UNPACK(dst, w) do { dst[0][0] = bf2f((w)[0] & 0xffffu); dst[0][1] = bf2f((w)[0] >> 16); dst[0][2] = bf2f((w)[1] & 0xffffu); dst[0][3] = bf2f((w)[1] >> 16); \
        dst[1][0] = bf2f((w)[2] & 0xffffu); dst[1][1] = bf2f((w)[2] >> 16); dst[1][2] = bf2f((w)[3] & 0xffffu); dst[1][3] = bf2f((w)[3] >> 16); } while (0)
#define NP_PACK(w, src) do { (w)[0] = pg8::cvt_pk_bf16(src[0][0], src[0][1]); (w)[1] = pg8::cvt_pk_bf16(src[0][2], src[0][3]); (w)[2] = pg8::cvt_pk_bf16(src[1][0], src[1][1]); (w)[3] = pg8::cvt_pk_bf16(src[1][2], src[1][3]); } while (0)
    if (gw < M) NP_LOAD(gw);
    for (int m = gw; m < M; m += NGW) {
        const int b = m >> 13;
        if (b != curb) { curb = b; const size_t vo = (size_t)b * 6 * DM;
#pragma unroll
            for (int j = 0; j < 4; ++j)
#pragma unroll
                for (int e = 0; e < 2; ++e) { const int ci = 128 * j + 2 * lane + e;
                    if (hout) { av[j][e] = ((const f32x4*)(avec + vo))[ci]; sv[j][e] = ((const f32x4*)(shvec + vo))[ci]; } if (y) gv[j][e] = ((const f32x4*)(gvec + vo))[ci]; } }
        f32x4 xv[4][2]; u32x4 yw[4]; float q0 = nqs;
#pragma unroll
        for (int j = 0; j < 4; ++j) {
            if (XF32) { const f32x4* xr = (const f32x4*)(xif + (size_t)m * DM) + 128 * j + 2 * lane; xv[j][0] = xr[0]; xv[j][1] = xr[1]; }
            else { const u32x4 w_ = nb[XF32 ? 0 : j]; NP_UNPACK(xv[j], w_); }
            yw[j] = ny[j]; }
        if (m + NGW < M) NP_LOAD(m + NGW);
        if (y) {
            const float q = wave_sum(q0);
            const float rstdy = 1.0f / sqrtf(q * (1.0f / DM) + EPS);
#pragma unroll
            for (int j = 0; j < 4; ++j) { f32x4 yf[2]; NP_UNPACK(yf, yw[j]); xv[j][0] += gv[j][0] * (yf[0] * rstdy); xv[j][1] += gv[j][1] * (yf[1] * rstdy); }
            if (xob) { u32x4* xo = (u32x4*)(xob + (size_t)m * DM);
#pragma unroll
                for (int j = 0; j < 4; ++j) { u32x4 w; NP_PACK(w, xv[j]); xo[64 * j + lane] = w; NP_UNPACK(xv[j], w); } }
            if (xof) { f32x4* xo = (f32x4*)(xof + (size_t)m * DM);
#pragma unroll
                for (int j = 0; j < 4; ++j) { xo[128 * j + 2 * lane] = xv[j][0]; xo[128 * j + 2 * lane + 1] = xv[j][1]; } }
        }
        if (hout) {
            float q = 0.f;
#pragma unroll
            for (int j = 0; j < 4; ++j)
#pragma unroll
                for (int e = 0; e < 2; ++e) q += (xv[j][e][0] * xv[j][e][0] + xv[j][e][1] * xv[j][e][1]) + (xv[j][e][2] * xv[j][e][2] + xv[j][e][3] * xv[j][e][3]);
            q = wave_sum(q);
            const float rstdx = 1.0f / sqrtf(q * (1.0f / DM) + EPS);
            u32x4* ho = (u32x4*)(hout + (size_t)m * DM);
#pragma unroll
            for (int j = 0; j < 4; ++j) { xv[j][0] = xv[j][0] * rstdx * av[j][0] + sv[j][0]; xv[j][1] = xv[j][1] * rstdx * av[j][1] + sv[j][1]; u32x4 w; NP_PACK(w, xv[j]); ho[64 * j + lane] = w; }
            if (wfg) {
                float mine = 0.f;
#pragma unroll 1
                for (int hd = 0; hd < 16; ++hd) { const LAS f32x4* wr = (const LAS f32x4*)F.lds + hd * (DM / 4); float p = 0.f;
#pragma unroll
                    for (int j = 0; j < 4; ++j)
#pragma unroll
                        for (int e = 0; e < 2; ++e) { const f32x4 w = wr[128 * j + 2 * lane + e]; p += (xv[j][e][0] * w[0] + xv[j][e][1] * w[1]) + (xv[j][e][2] * w[2] + xv[j][e][3] * w[3]); }
                    p = wave_sum(p); if (lane == hd) mine = p; }
                if (lane < 16) logf[(size_t)(b * 16 + lane) * SEQ + (m & (SEQ - 1))] = log_sigmoidf(mine + bfv[lane]);
            }
        }
    }
#undef NP_LOAD
#undef NP_UNPACK
#undef NP_PACK
    if (wfg) __syncthreads();
}
__device__ __forceinline__ void fox_scan(const Frame& Fi, const float* logf, float* cum) {
    Frame F = launder(Fi);
    if (blockIdx.x < 32) {
        const float* src = logf + (size_t)blockIdx.x * SEQ + 16 * F.tid; float* dst = cum + (size_t)blockIdx.x * SEQ + 16 * F.tid;
        f32x4 v[4];
#pragma unroll
        for (int j = 0; j < 4; ++j) v[j] = ((const f32x4*)src)[j];
        double tot = 0.0;
#pragma unroll
        for (int j = 0; j < 4; ++j) { tot += (double)v[j][0]; tot += (double)v[j][1]; tot += (double)v[j][2]; tot += (double)v[j][3]; }
        LAS double* sd = (LAS double*)F.lds;
        sd[F.tid] = tot; __syncthreads();
        if (F.tid == 0) { double run = 0.0; for (int i = 0; i < NTHR; ++i) { const double t = sd[i]; sd[i] = run; run += t; } }
        __syncthreads();
        double run = sd[F.tid];
#pragma unroll
        for (int j = 0; j < 4; ++j) { f32x4 o; run += (double)v[j][0]; o[0] = (float)run; run += (double)v[j][1]; o[1] = (float)run; run += (double)v[j][2]; o[2] = (float)run; run += (double)v[j][3]; o[3] = (float)run; ((f32x4*)dst)[j] = o; }
        __syncthreads();
    }
}
#define MFMA32(a, b, c) __builtin_amdgcn_mfma_f32_32x32x16_bf16((a), (b), (c), 0, 0, 0)
typedef short v4i16_t __attribute__((ext_vector_type(4)));
__device__ __forceinline__ s16x4 lds_tr16(const LAS unsigned char* p) { return __builtin_bit_cast(s16x4, __builtin_amdgcn_ds_read_tr16_b64_v4i16((LAS v4i16_t*)p)); }
__device__ __forceinline__ int crow(int r, int hi) { return (r & 3) + 8 * (r >> 2) + 4 * hi; }
__device__ __forceinline__ bf16x8 pack8(const f32x16& p, int s) {
    u32x4 w; w.x = pg8::cvt_pk_bf16(p[8 * s + 0], p[8 * s + 1]); w.y = pg8::cvt_pk_bf16(p[8 * s + 2], p[8 * s + 3]); w.z = pg8::cvt_pk_bf16(p[8 * s + 4], p[8 * s + 5]); w.w = pg8::cvt_pk_bf16(p[8 * s + 6], p[8 * s + 7]);
    return __builtin_bit_cast(bf16x8, w);
}
__device__ __forceinline__ bf16x8 cat44(s16x4 lo, s16x4 hi) { return (bf16x8){lo[0], lo[1], lo[2], lo[3], hi[0], hi[1], hi[2], hi[3]}; }
#define WG_BAR() do { asm volatile("s_waitcnt vmcnt(0) lgkmcnt(0)" ::: "memory"); __builtin_amdgcn_s_barrier(); asm volatile("" ::: "memory"); } while (0)

constexpr int FA_KROW = 272, FA_VROW = 320, FA_KBUF = 64 * FA_KROW, FA_VBUF = 64 * FA_VROW, FA_K0 = 0, FA_V0 = 2 * FA_KBUF, FA_B0 = FA_V0 + 2 * FA_VBUF, FA_PM0 = FA_B0 + 512, FA_RED0 = FA_PM0 + 512;
constexpr float FA_THR2 = 72.0f;
__device__ __forceinline__ void fox_attn_phase(const Frame& Fi, const bf16* P, const float* cum, const float* knorm, unsigned* ticket, bf16* O) {
    Frame F = launder(Fi);
    const int tid = F.tid, lane = F.lane, wave = F.wave, r32 = lane & 31, hi = lane >> 5;
    LAS unsigned char* lds = F.lds;
    const int srow = tid >> 3, sc16 = (tid & 7) * 16;
    const int trq = (lane & 15) >> 2, trp = lane & 3, trc = (lane >> 4) & 1;
    LAS int* ordv = (LAS int*)(lds + FA_PM0); LAS float* red = (LAS float*)(lds + FA_RED0); LAS int* tk = (LAS int*)(lds + FA_RED0 + 128);
    if (tid < 32) { const float key = cum[(size_t)tid * SEQ + SEQ - 1]; int rank = 0;
        for (int h2 = 0; h2 < 32; ++h2) { const float k2 = cum[(size_t)h2 * SEQ + SEQ - 1]; rank += (k2 > key || (k2 == key && h2 < tid)) ? 1 : 0; }
        ordv[rank] = tid; }
    WG_BAR();
#pragma unroll 1
    for (;;) {
        if (tid == 0) tk[0] = (int)__hip_atomic_fetch_add(ticket, 1u, __ATOMIC_RELAXED, __HIP_MEMORY_SCOPE_AGENT);
        WG_BAR();
        const int tkv = tk[0];
        if (tkv >= 1024) break;
        const int bh = ordv[tkv >> 5], qb = 31 - (tkv & 31), b = bh >> 4, hd = bh & 15;
        const size_t rowbase = (size_t)b * SEQ;
        { float pmx = 0.f;
          if (tid < 4 * qb) { const f32x4 kn = *(const f32x4*)(knorm + ((size_t)bh * 128 + tid) * 4); pmx = (kn[0] + kn[1]) + (kn[2] + kn[3]); }
          pmx = wave_max(pmx); if (lane == 0) red[8 + wave] = pmx; }
        const int q0 = 256 * qb, T0 = 4 * qb + 3, tw = 4 * qb + (wave >> 1);
        const int qrow = q0 + 32 * wave + r32;
        bf16x8 qf[8];
        { const bf16* qp = P + (rowbase + qrow) * FOX_N + hd * FOX_D + 8 * hi;
#pragma unroll
          for (int d0 = 0; d0 < 8; ++d0) qf[d0] = *(const bf16x8*)(qp + 16 * d0); }
        float nq;
        { float q2 = 0.f;
#pragma unroll
          for (int d0 = 0; d0 < 8; ++d0)
#pragma unroll
              for (int j = 0; j < 8; ++j) { const float v = bf2f((unsigned)(unsigned short)qf[d0][j]); q2 += v * v; }
          q2 += __shfl_xor(q2, 32); nq = sqrtf(q2) * 1.001f; }
        const float* cumh = cum + (size_t)bh * SEQ;
        const float Fref = cumh[q0];
        const bf16* Kg = P + rowbase * FOX_N + 2048 + hd * FOX_D + sc16;
        const bf16* Vg = P + rowbase * FOX_N + 4096 + hd * FOX_D + sc16;
        u32x4 kr0, kr1, vr0, vr1; float br = 0.f;
#define FA_LOAD(t) do { const size_t ro = (size_t)(64 * (t) + srow) * FOX_N; kr0 = *(const u32x4*)(Kg + ro); kr1 = *(const u32x4*)(Kg + ro + 8); vr0 = *(const u32x4*)(Vg + ro); vr1 = *(const u32x4*)(Vg + ro + 8); \
            if (tid < 64) br = cumh[64 * (t) + tid]; } while (0)
#define FA_STORE(buf) do { LAS unsigned char* kd = lds + FA_K0 + (buf) * FA_KBUF + srow * FA_KROW + sc16 * 2; *(LAS u32x4*)kd = kr0; *(LAS u32x4*)(kd + 16) = kr1; \
            LAS unsigned char* vd = lds + FA_V0 + (buf) * FA_VBUF + srow * FA_VROW + sc16 * 2; *(LAS u32x4*)vd = vr0; *(LAS u32x4*)(vd + 16) = vr1; \
            if (tid < 64) ((LAS float*)(lds + FA_B0))[(buf) * 64 + tid] = (Fref - br) * LOG2E; } while (0)
        f32x16 o[4];
#pragma unroll
        for (int d = 0; d < 4; ++d)
#pragma unroll
            for (int r = 0; r < 16; ++r) o[d][r] = 0.f;
        float mrun = -INFINITY, lrun = 0.f;
        FA_LOAD(T0); FA_STORE(0); WG_BAR();
        int cur = 0;
        const int tb = 4 * qb; float dstar = 0.f;
#define FA_COND(tt) ((Fref - cumh[64 * (tt) + 63]) * LOG2E + dstar >= -FA_THR2)
        int t = T0;
#pragma unroll 1
        for (;;) {
            const bool nxt = (t > tb) ? true : (t == tb) ? false : (t > 0 && FA_COND(t - 1));
            if (nxt) FA_LOAD(t - 1);
            if (t <= tw) {
                const LAS unsigned char* kb = lds + FA_K0 + cur * FA_KBUF + r32 * FA_KROW + 16 * hi;
                const LAS float* bb = (const LAS float*)(lds + FA_B0) + cur * 64 + 4 * hi;
                f32x16 s0, s1;
#pragma unroll
                for (int g = 0; g < 4; ++g) { const f32x4 b0 = *(const LAS f32x4*)(bb + 8 * g), b1 = *(const LAS f32x4*)(bb + 32 + 8 * g);
#pragma unroll
                    for (int i = 0; i < 4; ++i) { s0[4 * g + i] = b0[i]; s1[4 * g + i] = b1[i]; } }
#pragma unroll
                for (int d0 = 0; d0 < 8; ++d0) { const bf16x8 k0 = *(const LAS bf16x8*)(kb + 32 * d0), k1 = *(const LAS bf16x8*)(kb + 32 * FA_KROW + 32 * d0);
                    s0 = MFMA32(k0, qf[d0], s0); s1 = MFMA32(k1, qf[d0], s1); }
                if (t == tw) {
#pragma unroll
                    for (int r = 0; r < 16; ++r) { const int key = 64 * t + crow(r, hi); if (key > qrow) s0[r] = -INFINITY; if (key + 32 > qrow) s1[r] = -INFINITY; }
                }
                float mx = fmaxf(s0[0], s1[0]);
#pragma unroll
                for (int r = 1; r < 16; ++r) mx = fmaxf(mx, fmaxf(s0[r], s1[r]));
                mx = fmaxf(mx, __shfl_xor(mx, 32));
                const float mnew = fmaxf(mrun, mx), alpha = __builtin_amdgcn_exp2f(mrun - mnew);
                mrun = mnew;
                float ps = 0.f;
#pragma unroll
                for (int r = 0; r < 16; ++r) { s0[r] = __builtin_amdgcn_exp2f(s0[r] - mnew); s1[r] = __builtin_amdgcn_exp2f(s1[r] - mnew); ps += s0[r] + s1[r]; }
                lrun = lrun * alpha + ps;
#pragma unroll
                for (int d = 0; d < 4; ++d)
#pragma unroll
                    for (int r = 0; r < 16; ++r) o[d][r] *= alpha;
                bf16x8 pf[4]; pf[0] = pack8(s0, 0); pf[1] = pack8(s0, 1); pf[2] = pack8(s1, 0); pf[3] = pack8(s1, 1);
                const LAS unsigned char* vb = lds + FA_V0 + cur * FA_VBUF + (4 * hi + trq) * FA_VROW + (16 * trc + 4 * trp) * 2;
#pragma unroll
                for (int ks = 0; ks < 4; ++ks) {
#pragma unroll
                    for (int d = 0; d < 4; ++d) { const s16x4 lo = lds_tr16(vb + 16 * ks * FA_VROW + 64 * d), hh = lds_tr16(vb + (16 * ks + 8) * FA_VROW + 64 * d);
                        o[d] = MFMA32(cat44(lo, hh), pf[ks], o[d]); }
                }
            }
            if (nxt) FA_STORE(cur ^ 1);
            WG_BAR();
            if (nxt) { cur ^= 1; --t; continue; }
            if (t == tb && tb > 0) {
                const float pm2 = fmaxf(fmaxf(fmaxf(red[8], red[9]), fmaxf(red[10], red[11])), fmaxf(fmaxf(red[12], red[13]), fmaxf(red[14], red[15])));
                float val = nq * (sqrtf(pm2) * 1.004f) - mrun; val = wave_max(val);
                if (lane == 0) red[wave] = val;
                WG_BAR();
                dstar = fmaxf(fmaxf(fmaxf(red[0], red[1]), fmaxf(red[2], red[3])), fmaxf(fmaxf(red[4], red[5]), fmaxf(red[6], red[7])));
                if (!FA_COND(tb - 1)) break;
                FA_LOAD(tb - 1); FA_STORE(cur ^ 1); WG_BAR(); cur ^= 1; --t; continue;
            }
            break;
        }
#undef FA_COND
        const float ltot = lrun + __shfl_xor(lrun, 32), inv = 1.0f / ltot;
        bf16* op = O + (rowbase + qrow) * DM + hd * FOX_D + 4 * hi;
#pragma unroll
        for (int d = 0; d < 4; ++d)
#pragma unroll
            for (int g = 0; g < 4; ++g) { u32x2 w; w.x = pg8::cvt_pk_bf16(o[d][4 * g] * inv, o[d][4 * g + 1] * inv); w.y = pg8::cvt_pk_bf16(o[d][4 * g + 2] * inv, o[d][4 * g + 3] * inv);
                *(u32x2*)(op + 32 * d + 8 * g) = w; }
#undef FA_LOAD
#undef FA_STORE
    }
}
constexpr int SW_KROW = 144, SW_VROW = 192, SW_K0 = 0, SW_V0 = 256 * SW_KROW, SW_NU = BATCH * 64 * SWA_HK;
__device__ __forceinline__ void swa_rope8(u32x4& a, u32x4& bq, const float* cs16, bool both, bool second) {
    const f32x4* cs = (const f32x4*)cs16; const f32x4 c0 = cs[0], c1 = cs[1], s0 = cs[2], s1 = cs[3];
    u32x4 n0, n1;
#pragma unroll
    for (int i = 0; i < 4; ++i) { const float c_lo = (i < 2) ? c0[2 * i] : c1[2 * i - 4], c_hi = (i < 2) ? c0[2 * i + 1] : c1[2 * i - 3], s_lo = (i < 2) ? s0[2 * i] : s1[2 * i - 4], s_hi = (i < 2) ? s0[2 * i + 1] : s1[2 * i - 3];
        const float a_lo = bf2f(a[i] & 0xffffu), a_hi = bf2f(a[i] >> 16), b_lo = bf2f(bq[i] & 0xffffu), b_hi = bf2f(bq[i] >> 16);
        n0[i] = pk2(a_lo * c_lo - b_lo * s_lo, a_hi * c_hi - b_hi * s_hi); n1[i] = pk2(b_lo * c_lo + a_lo * s_lo, b_hi * c_hi + a_hi * s_hi); }
    (void)both; (void)second; a = n0; bq = n1;
}
__device__ __forceinline__ void swa_phase(const Frame& Fi, const bf16* P, const float* rope, const float* sinks, bf16* O) {
    Frame F = launder(Fi);
    const int tid = F.tid, lane = F.lane, wave = F.wave, r32 = lane & 31, hi = lane >> 5;
    LAS unsigned char* lds = F.lds;
    const int trq = (lane & 15) >> 2, trp = lane & 3, trc = (lane >> 4) & 1;
    const int srow0 = tid >> 2, spr = tid & 3;
    u32x4 kr[2][2], vr[2][2];
#define SW_LOAD(uu) do { const int hk_ = (uu) & 7, n_ = ((uu) >> 3) & 63, b_ = (uu) >> 9; const size_t blk_ = (size_t)b_ * SEQ + (size_t)n_ * 128; \
        _Pragma("unroll") for (int it = 0; it < 2; ++it) { const int row = srow0 + 128 * it; \
            if (n_ > 0 || it == 1) { const size_t m_ = blk_ - 128 + row; const bf16* kp = P + m_ * SWA_N + 2048 + hk_ * SWA_D + 16 * spr; const bf16* vp = P + m_ * SWA_N + 2560 + hk_ * SWA_D + 16 * spr; \
                kr[it][0] = *(const u32x4*)kp; kr[it][1] = *(const u32x4*)(kp + 8); vr[it][0] = *(const u32x4*)vp; vr[it][1] = *(const u32x4*)(vp + 8); } \
            else { kr[it][0] = (u32x4){0u, 0u, 0u, 0u}; kr[it][1] = kr[it][0]; vr[it][0] = kr[it][0]; vr[it][1] = kr[it][0]; } } } while (0)
    int u = F.vcu;
    if (u < SW_NU) SW_LOAD(u);
#pragma unroll 1
    for (; u < SW_NU; u += F.G) {
        const int hk = u & 7, n = (u >> 3) & 63, b = u >> 9;
        const size_t blk0 = (size_t)b * SEQ + (size_t)n * 128;
#pragma unroll
        for (int it = 0; it < 2; ++it) { const int row = srow0 + 128 * it;
            u32x4 k0 = kr[it][0], k1 = kr[it][1];
            if (spr == 0 && (n > 0 || it == 1)) swa_rope8(k0, k1, rope + (blk0 - 128 + row) * 16, true, false);
            LAS unsigned char* kd = lds + SW_K0 + row * SW_KROW + 32 * spr; *(LAS u32x4*)kd = k0; *(LAS u32x4*)(kd + 16) = k1;
            LAS unsigned char* vd = lds + SW_V0 + row * SW_VROW + 32 * spr; *(LAS u32x4*)vd = vr[it][0]; *(LAS u32x4*)(vd + 16) = vr[it][1]; }
        const int g = wave & 3, hq = hk * 4 + g;
        bf16x8 qf[2][4];
#pragma unroll
        for (int it = 0; it < 2; ++it) { const int rb = (wave >> 2) + 2 * it; const size_t m = blk0 + 32 * rb + r32;
            const bf16* qp = P + m * SWA_N + hq * SWA_D;
            u32x4 x1 = *(const u32x4*)qp, x2 = *(const u32x4*)(qp + 8);
            swa_rope8(x1, x2, rope + m * 16, true, false);
            const u32x4 xs = hi ? x2 : x1; u32x4 w;
#pragma unroll
            for (int i = 0; i < 4; ++i) w[i] = pk2(bf2f(xs[i] & 0xffffu) * SWA_QSCALE, bf2f(xs[i] >> 16) * SWA_QSCALE);
            qf[it][0] = __builtin_bit_cast(bf16x8, w);
#pragma unroll
            for (int d0 = 1; d0 < 4; ++d0) { const u32x4 x = *(const u32x4*)(qp + 16 * d0 + 8 * hi); u32x4 ww;
#pragma unroll
                for (int i = 0; i < 4; ++i) ww[i] = pk2(bf2f(x[i] & 0xffffu) * SWA_QSCALE, bf2f(x[i] >> 16) * SWA_QSCALE);
                qf[it][d0] = __builtin_bit_cast(bf16x8, ww); } }
        WG_BAR();
        { const int un = u + F.G; if (un < SW_NU) SW_LOAD(un); }
        const float sink2 = sinks[hq] * LOG2E;
#pragma unroll 1
        for (int it = 0; it < 2; ++it) {
            const int rb = (wave >> 2) + 2 * it;
            bf16x8 qs[4];
#pragma unroll
            for (int d0 = 0; d0 < 4; ++d0) qs[d0] = it ? qf[1][d0] : qf[0][d0];
            const int qi = 32 * rb + r32; const size_t m = blk0 + qi;
            f32x16 s[5];
#pragma unroll
            for (int j = 0; j < 5; ++j) {
#pragma unroll
                for (int r = 0; r < 16; ++r) s[j][r] = 0.f;
                const LAS unsigned char* kb = lds + SW_K0 + (32 * (rb + j) + r32) * SW_KROW + 16 * hi;
#pragma unroll
                for (int d0 = 0; d0 < 4; ++d0) s[j] = MFMA32(*(const LAS bf16x8*)(kb + 32 * d0), qs[d0], s[j]);
#pragma unroll
                for (int r = 0; r < 16; ++r) { const int kk = 32 * (rb + j) + crow(r, hi), ki = kk - 128, rel = qi - ki; const bool ok = (rel >= 0) && (rel < 128) && (n * 128 + ki >= 0); if (!ok) s[j][r] = -INFINITY; }
            }
            float mx = sink2;
#pragma unroll
            for (int j = 0; j < 5; ++j)
#pragma unroll
                for (int r = 0; r < 16; ++r) mx = fmaxf(mx, s[j][r]);
            mx = fmaxf(mx, __shfl_xor(mx, 32));
            float ps = 0.f;
#pragma unroll
            for (int j = 0; j < 5; ++j)
#pragma unroll
                for (int r = 0; r < 16; ++r) { s[j][r] = __builtin_amdgcn_exp2f(s[j][r] - mx); ps += s[j][r]; }
            ps += __shfl_xor(ps, 32);
            const float inv = 1.0f / (ps + __builtin_amdgcn_exp2f(sink2 - mx));
            f32x16 o[2];
#pragma unroll
            for (int d = 0; d < 2; ++d)
#pragma unroll
                for (int r = 0; r < 16; ++r) o[d][r] = 0.f;
            const LAS unsigned char* vb = lds + SW_V0 + (32 * rb + 4 * hi + trq) * SW_VROW + (16 * trc + 4 * trp) * 2;
#pragma unroll
            for (int j = 0; j < 5; ++j)
#pragma unroll
                for (int ks = 0; ks < 2; ++ks) { const bf16x8 pf = pack8(s[j], ks);
#pragma unroll
                    for (int d = 0; d < 2; ++d) { const s16x4 lo = lds_tr16(vb + (32 * j + 16 * ks) * SW_VROW + 64 * d), hh = lds_tr16(vb + (32 * j + 16 * ks + 8) * SW_VROW + 64 * d);
                        o[d] = MFMA32(cat44(lo, hh), pf, o[d]); } }
            bf16* op = O + m * DM + hq * SWA_D + 4 * hi;
#pragma unroll
            for (int d = 0; d < 2; ++d)
#pragma unroll
                for (int gq = 0; gq < 4; ++gq) { u32x2 w; w.x = pg8::cvt_pk_bf16(o[d][4 * gq] * inv, o[d][4 * gq + 1] * inv); w.y = pg8::cvt_pk_bf16(o[d][4 * gq + 2] * inv, o[d][4 * gq + 3] * inv);
                    *(u32x2*)(op + 32 * d + 8 * gq) = w; }
        }
        WG_BAR();
    }
#undef SW_LOAD
}
constexpr int SG_VROW = 320, SG_VBUF = 128 * SG_VROW, SG_V0 = 0, SG_ST = 2 * SG_VBUF, SG_LN = SG_ST + 1024;
__device__ __forceinline__ void sgu_phase(const Frame& Fi, const bf16* P, const float* vstat, const float* lng, const float* lnb, const bf16* wsm, const float* bs, bf16* O) {
    Frame F = launder(Fi);
    const int tid = F.tid, lane = F.lane, wave = F.wave, r32 = lane & 31, hi = lane >> 5;
    LAS unsigned char* lds = F.lds;
    const int trq = (lane & 15) >> 2, trp = lane & 3, trc = (lane >> 4) & 1;
    LAS float* rst = (LAS float*)(lds + SG_ST);
    LAS float* lnl = (LAS float*)(lds + SG_LN);
    const int srow = tid >> 4, sc8 = (tid & 15) * 8;
#pragma unroll 1
    for (int u = F.vcu; u < BATCH * 64 * 2; u += F.G) {
        const int gh = u & 1, ch = (u >> 1) & 63, b = u >> 7, c0 = gh * 1024;
        const size_t m0 = (size_t)b * SEQ + (size_t)ch * 128;
        u32x4 vld[4];
#define SG_LOAD(gi_) do { _Pragma("unroll") for (int it = 0; it < 4; ++it) vld[it] = *(const u32x4*)(P + (m0 + srow + 32 * it) * SGU_N + 2048 + c0 + (gi_) * 128 + sc8); } while (0)
        SG_LOAD(0);
        if (tid < 128) { const float* sp = vstat + (m0 + tid) * 64; float s = 0.f, q = 0.f;
#pragma unroll 8
            for (int i = 0; i < 32; ++i) { s += sp[2 * i]; q += sp[2 * i + 1]; }
            const float mean = s * (1.0f / DM), var = fmaxf(q * (1.0f / DM) - mean * mean, 0.f);
            rst[2 * tid] = mean; rst[2 * tid + 1] = 1.0f / sqrtf(var + EPS); }
        if (tid < 256) *(LAS f32x4*)(lnl + 4 * tid) = *(const f32x4*)(lng + c0 + 4 * tid); else *(LAS f32x4*)(lnl + 1024 + 4 * (tid - 256)) = *(const f32x4*)(lnb + c0 + 4 * (tid - 256));
        WG_BAR();
        const int tb = wave & 3, nks = 2 * tb + 2;
#pragma unroll 1
        for (int gi = 0; gi < 8; ++gi) {
            const int g = 8 * gh + gi; LAS unsigned char* vbuf = lds + SG_V0 + (gi & 1) * SG_VBUF;
#pragma unroll
            for (int it = 0; it < 4; ++it) { const int row = srow + 32 * it; const u32x4 x = vld[it];
                const f32x4 g0 = *(const LAS f32x4*)(lnl + gi * 128 + sc8), g1 = *(const LAS f32x4*)(lnl + gi * 128 + sc8 + 4), b0 = *(const LAS f32x4*)(lnl + 1024 + gi * 128 + sc8), b1 = *(const LAS f32x4*)(lnl + 1024 + gi * 128 + sc8 + 4);
                const float mean = rst[2 * row], rstd = rst[2 * row + 1]; u32x4 w;
#pragma unroll
                for (int i = 0; i < 4; ++i) { const float ga = (i < 2) ? g0[2 * i] : g1[2 * i - 4], gb = (i < 2) ? g0[2 * i + 1] : g1[2 * i - 3], ba = (i < 2) ? b0[2 * i] : b1[2 * i - 4], bb = (i < 2) ? b0[2 * i + 1] : b1[2 * i - 3];
                    w[i] = pk2((bf2f(x[i] & 0xffffu) - mean) * rstd * ga + ba, (bf2f(x[i] >> 16) - mean) * rstd * gb + bb); }
                *(LAS u32x4*)(vbuf + row * SG_VROW + sc8 * 2) = w; }
            WG_BAR();
            if (gi < 7) SG_LOAD(gi + 1);
            const bf16* wrow = wsm + ((size_t)g * 128 + 32 * tb + r32) * 128 + 8 * hi;
            bf16x8 wf[8];
#pragma unroll
            for (int ks = 0; ks < 8; ++ks) if (ks < nks) wf[ks] = *(const bf16x8*)(wrow + 16 * ks);
            const int t = 32 * tb + r32; const float bias = bs[g * 128 + t];
            u32x2 uu[2][4];
#pragma unroll
            for (int it = 0; it < 2; ++it) { const bf16* up = P + (m0 + t) * SGU_N + g * 128 + 32 * ((wave >> 2) + 2 * it) + 4 * hi;
#pragma unroll
                for (int gq = 0; gq < 4; ++gq) uu[it][gq] = *(const u32x2*)(up + 8 * gq); }
#pragma unroll
            for (int it = 0; it < 2; ++it) { const int db = (wave >> 2) + 2 * it;
                f32x16 acc;
#pragma unroll
                for (int r = 0; r < 16; ++r) acc[r] = 0.f;
                const LAS unsigned char* vb = vbuf + (8 * hi + trq) * SG_VROW + (32 * db + 16 * trc + 4 * trp) * 2;
#pragma unroll
                for (int ks = 0; ks < 8; ++ks) if (ks < nks) { const s16x4 lo = lds_tr16(vb + 16 * ks * SG_VROW), hh = lds_tr16(vb + (16 * ks + 4) * SG_VROW); acc = MFMA32(cat44(lo, hh), wf[ks], acc); }
                bf16* op = O + (m0 + t) * DM + g * 128 + 32 * db + 4 * hi;
#pragma unroll
                for (int gq = 0; gq < 4; ++gq) { const u32x2 ux = uu[it][gq]; u32x2 w;
                    w.x = pg8::cvt_pk_bf16(bf2f(ux.x & 0xffffu) * (acc[4 * gq] + bias), bf2f(ux.x >> 16) * (acc[4 * gq + 1] + bias));
                    w.y = pg8::cvt_pk_bf16(bf2f(ux.y & 0xffffu) * (acc[4 * gq + 2] + bias), bf2f(ux.y >> 16) * (acc[4 * gq + 3] + bias));
                    *(u32x2*)(op + 8 * gq) = w; } }
        }
        WG_BAR();
#undef SG_LOAD
    }
}
constexpr int NPHASE = 31, PH_FINAL = 30;
__global__ void __launch_bounds__(NTHR, 2) mk_fwd(Args args) {
    extern __shared__ __attribute__((aligned(16))) unsigned char lds_raw[];
    Frame F;
    F.lds = (LAS unsigned char*)lds_raw;
    F.tid = threadIdx.x; F.lane = F.tid & 63; F.wave = __builtin_amdgcn_readfirstlane(F.tid >> 6);
    F.G = gridDim.x; { const int bx = blockIdx.x; F.vcu = (F.G % 8 == 0) ? (bx % 8) * (F.G / 8) + bx / 8 : bx; }
    unsigned char* ws = args.ws;
    gu32* ctl = (gu32*)(ws + WS_CTL);
    for (int u = F.tid; u < (LDS_BYTES - LDSCTL_OFF) / 4; u += NTHR) ((LAS unsigned*)(F.lds + LDSCTL_OFF))[u] = 0u;
    __syncthreads();
    XcdBarrier bar = xcd_barrier_post((unsigned*)(ctl + CW_BAR), (volatile LAS unsigned*)(F.lds + MISC_OFF) + 8);
    const int lo = args.ph_lo, hi = args.ph_hi;
#define IN(k) (lo <= (k) && (k) < hi)
#ifndef PROBE_REPEAT
#define PROBE_REPEAT 0
#endif
#define REP(c) _Pragma("unroll 1") for (int rep_ = 0; rep_ <= ((PROBE_REPEAT >> (c)) & 1); ++rep_)
#ifndef PROBE_STAMP
#define PROBE_STAMP 0
#endif
#ifndef PROBE_SEL
#define PROBE_SEL(k) 1
#endif
#ifndef PROBE_MULT
#define PROBE_MULT 1
#endif
#if PROBE_STAMP
#define STAMP(k) do { if (F.tid == 0) { const unsigned t_ = (unsigned)__builtin_amdgcn_s_memrealtime(); atomicMax((unsigned*)(ctl + 16384 + 2 * (k)), t_); atomicMax((unsigned*)(ctl + 16385 + 2 * (k)), 0xffffffffu - t_); } } while (0)
#else
#define STAMP(k) do { } while (0)
#endif
#if PROBE_STAMP == 3
    long long clk_prev = clock64(), clk_sum = 0;
#undef STAMP
#define STAMP(k) do { const long long c_ = clock64(); if (PROBE_SEL(k)) clk_sum += c_ - clk_prev; } while (0)
#define STAMP2() do { clk_prev = clock64(); } while (0)
#else
#define STAMP2() do { } while (0)
#endif
#define SEAM(k) do { if (IN(k) && IN((k) + 1)) { STAMP(k); xcd_barrier(bar); STAMP2(); } } while (0)
    bf16* Hb = (bf16*)(ws + WS_H); bf16* Pb = (bf16*)(ws + WS_PROJ); bf16* Ob = (bf16*)(ws + WS_O); bf16* Yb = (bf16*)(ws + WS_Y);
    bf16* XB = (bf16*)(ws + WS_XA);
    float* ystat = (float*)(ws + WS_YSTAT); float* vstat = (float*)(ws + WS_VSTAT);
    const float* vec = (const float*)(ws + WS_VEC);
    float* logf = (float*)(ws + WS_LOGF); float* cum = (float*)(ws + WS_CUM);

    if (IN(0)) { REP(0) { p0_prologue(F, args); __syncthreads(); } } SEAM(0);
    if (IN(1)) { p1_modvec(F, args); } SEAM(1);

#pragma unroll 1
    for (int s = 0; s < 2 * DEPTH; ++s) {
        const int l = s >> 1, half = s & 1, kind = l % 3, jj = l / 3, base = 2 + 7 * l + 4 * half;
        if (IN(base)) {
            const float* xif = (s <= 1) ? args.in[0] : nullptr; const bf16* xib = (s <= 1) ? nullptr : XB + (size_t)((s - 1) & 1) * M * DM;
            bf16* xob = (s == 0) ? nullptr : XB + (size_t)(s & 1) * M * DM;
            const float* lv = vec + (size_t)l * 12 * DM;
            const float* gsrc = (s == 0) ? nullptr : (half ? lv + 2 * DM : vec + (size_t)(l - 1) * 12 * DM + 5 * DM);
            const float* av = half ? lv + 3 * DM : lv + 0 * DM; const float* sv = half ? lv + 4 * DM : lv + 1 * DM;
            const bool fox = (half == 0 && kind == 0);
            const float* wfgp = fox ? (const float*)(ws + WS_WFG) + (size_t)jj * 16 * DM : nullptr;
            if (s <= 1) { REP(1) norm_phase<true>(F, xif, xib, xob, nullptr, s == 0 ? nullptr : Yb, ystat, gsrc, av, sv, Hb, wfgp, args.in[12] + jj * 16, logf); }
            else { REP(1) norm_phase<false>(F, xif, xib, xob, nullptr, Yb, ystat, gsrc, av, sv, Hb, wfgp, args.in[12] + jj * 16, logf); }
        }
        SEAM(base);
        if (half == 0) {
            if (IN(base + 1)) {
                if (kind == 1) {
                    pg8::Gemm g{Hb, (const bf16*)(ws + WS_WSGUIN), M, SGU_N, DM}; pg8::StaticOrder S; S.init(M, SGU_N, F.G, (int)blockIdx.x);
                    pg8::EpiSguIn E{Pb, SGU_N, vstat};
                    REP(2) pg8::gemm_phase<pg8::EpiSguIn, pg8::StaticOrder, true, true>(F.lds, g, S, E);
                } else {
                    if (kind == 0) fox_scan(F, logf, cum);
                    const int N = kind == 0 ? FOX_N : SWA_N;
                    const bf16* Bt = kind == 0 ? (const bf16*)(ws + WS_WFOXIN + jj * WFOXIN_BYTES) : (const bf16*)(ws + WS_WSWAIN);
                    pg8::Gemm g{Hb, Bt, M, N, DM}; pg8::StaticOrder S; S.init(M, N, F.G, (int)blockIdx.x);
                    pg8::EpiProj E{Pb, N, kind == 0 ? 2048 : 0, FOX_QSCALE, kind == 0 ? (float*)(ws + WS_KNORM) : nullptr};
                    REP(2) pg8::gemm_phase<pg8::EpiProj, pg8::StaticOrder, true, true>(F.lds, g, S, E);
                }
            }
            SEAM(base + 1);
            if (IN(base + 2)) {
                if (kind == 0) { REP(3) fox_attn_phase(F, Pb, cum, (const float*)(ws + WS_KNORM), (unsigned*)(ctl + CW_TICKET + 64 * jj), Ob); }
                else if (kind == 1) REP(4) sgu_phase(F, Pb, vstat, args.in[15], args.in[16], (const bf16*)(ws + WS_WSM), args.in[18], Ob);
                else REP(5) swa_phase(F, Pb, (const float*)(ws + WS_ROPE), args.in[21], Ob);
            }
            SEAM(base + 2);
        } else {
            if (IN(base + 1)) {
                pg8::Gemm g{Hb, (const bf16*)(ws + WS_WGU + l * WGU_BYTES), M, 2 * DFF, DM}; pg8::StaticOrder S; S.init(M, 2 * DFF, F.G, (int)blockIdx.x);
                pg8::EpiSwiglu E{Pb, DFF};
                REP(2) pg8::gemm_phase<pg8::EpiSwiglu, pg8::StaticOrder, true, true>(F.lds, g, S, E);
            }
            SEAM(base + 1);
        }
        { const int ph = half ? base + 2 : base + 3;
          if (IN(ph)) {
              const bf16* A = half ? Pb : Ob; const int K = half ? DFF : DM;
              const bf16* Bt = half ? (const bf16*)(ws + WS_WDN + l * WDN_BYTES) : (kind == 0 ? (const bf16*)(ws + WS_WFOXOUT + jj * WSQ_BYTES) : kind == 1 ? (const bf16*)(ws + WS_WSGUOUT) : (const bf16*)(ws + WS_WSWAOUT));
              pg8::Gemm g{A, Bt, M, DM, K}; pg8::StaticOrder S; S.init(M, DM, F.G, (int)blockIdx.x);
              pg8::EpiOut E{Yb, DM, ystat};
              REP(2) pg8::gemm_phase<pg8::EpiOut, pg8::StaticOrder, true, true>(F.lds, g, S, E);
          }
          SEAM(ph); }
    }
    if (IN(PH_FINAL)) {
        const float* gsrc = vec + (size_t)3 * 12 * DM + 5 * DM;
        REP(1) norm_phase<false>(F, nullptr, XB + (size_t)M * DM, nullptr, args.out, Yb, ystat, gsrc, nullptr, nullptr, nullptr, nullptr, nullptr, nullptr);
    }
#if PROBE_STAMP == 3
    if (blockIdx.x == 0 && F.tid == 0) { const unsigned long long t0 = __builtin_amdgcn_s_memrealtime(); const unsigned long long ticks = (unsigned long long)clk_sum / 24ull;
        while (__builtin_amdgcn_s_memrealtime() - t0 < ticks) __builtin_amdgcn_s_sleep(32); }
#elif PROBE_STAMP
    STAMP(PH_FINAL); xcd_barrier(bar);
    if (blockIdx.x == 0 && F.tid == 0) {
        unsigned long long total = 0ull;
        for (int k = 0; k <= PH_FINAL; ++k) { const unsigned tmax = __hip_atomic_load((unsigned*)(ctl + 16384 + 2 * k), __ATOMIC_RELAXED, __HIP_MEMORY_SCOPE_AGENT), tmin = 0xffffffffu - __hip_atomic_load((unsigned*)(ctl + 16385 + 2 * k), __ATOMIC_RELAXED, __HIP_MEMORY_SCOPE_AGENT);
            const unsigned tprev = k ? __hip_atomic_load((unsigned*)(ctl + 16384 + 2 * (k - 1)), __ATOMIC_RELAXED, __HIP_MEMORY_SCOPE_AGENT) : tmin;
            if (PROBE_SEL(k)) total += (PROBE_STAMP == 1) ? (unsigned long long)(tmax - tmin) : (unsigned long long)(tmax - tprev); }
        const unsigned long long t0 = __builtin_amdgcn_s_memrealtime();
        while (__builtin_amdgcn_s_memrealtime() - t0 < total * PROBE_MULT) __builtin_amdgcn_s_sleep(32);
    }
#endif
#undef IN
#undef SEAM
}
#if DBG
static void dbg_checks(int phase, const Args& a, hipStream_t stream);
__global__ void dbg_finalize(Args a);
#endif
extern "C" void kernel_launch(void* const* d_in, const int* in_sizes, int n_in, void* d_out, int out_size, void* d_ws, size_t ws_size, hipStream_t stream) {
    static int grid = 0;
    if (grid == 0) {
        if (n_in != 23 || out_size != M * DM || ws_size < WS_END) { fprintf(stderr, "kernel_launch: unexpected shapes (n_in %d, out %d, ws %zu); nothing launched\n", n_in, out_size, ws_size); grid = -1; return; }
        int dev = 0, cus = 0, per_cu = 0;
        if (hipGetDevice(&dev) != hipSuccess || hipDeviceGetAttribute(&cus, hipDeviceAttributeMultiprocessorCount, dev) != hipSuccess) { grid = -1; return; }
        if (hipFuncSetAttribute((const void*)mk_fwd, hipFuncAttributeMaxDynamicSharedMemorySize, LDS_BYTES) != hipSuccess) { fprintf(stderr, "kernel_launch: hipFuncSetAttribute failed\n"); grid = -1; return; }
        if (hipOccupancyMaxActiveBlocksPerMultiprocessor(&per_cu, (const void*)mk_fwd, NTHR, LDS_BYTES) != hipSuccess || per_cu < 1) { fprintf(stderr, "kernel_launch: occupancy query says %d blocks per CU\n", per_cu); }
        (void)hipGetLastError();
        grid = cus;
        if (grid != 256) { fprintf(stderr, "kernel_launch: built for a 256-CU device, found %d CUs; nothing launched\n", cus); grid = -1; return; }
    }
    if (grid < 0) return;
    (void)hipMemsetAsync((char*)d_ws + WS_CTL, 0, CTL_ZERO_BYTES, stream);
    Args a{};
    for (int i = 0; i < 23; ++i) a.in[i] = (const float*)d_in[i];
    a.out = (float*)d_out; a.ws = (unsigned char*)d_ws;
#if DBG
    for (int ph = 0; ph < NPHASE; ++ph) { a.ph_lo = ph; a.ph_hi = ph + 1; hipLaunchKernelGGL(mk_fwd, dim3(grid), dim3(NTHR), LDS_BYTES, stream, a); dbg_checks(ph, a, stream); }
    hipLaunchKernelGGL(dbg_finalize, dim3(1024), dim3(256), 0, stream, a);
#else
    a.ph_lo = 0; a.ph_hi = NPHASE;
    hipLaunchKernelGGL(mk_fwd, dim3(grid), dim3(NTHR), LDS_BYTES, stream, a);
#endif
    const hipError_t le = hipPeekAtLastError();
    if (le != hipSuccess) fprintf(stderr, "kernel_launch: launch failed: %s\n", hipGetErrorName(le));
}
#if DBG
__device__ __forceinline__ void dbg_fail(unsigned char* ws, unsigned code, float val) {
    unsigned* ctl = (unsigned*)(ws + WS_CTL);
    if (atomicCAS(ctl + CW_ERR, 0u, code) == 0u) ctl[CW_ERRV] = __float_as_uint(val);
}
__device__ __forceinline__ float block_sum256(float v, float* sh) {
    const int t = threadIdx.x; sh[t] = v; __syncthreads();
    for (int o = 128; o > 0; o >>= 1) { if (t < o) sh[t] += sh[t + o]; __syncthreads(); }
    const float r = sh[0]; __syncthreads(); return r;
}
__device__ __forceinline__ float block_max256(float v, float* sh) {
    const int t = threadIdx.x; sh[t] = v; __syncthreads();
    for (int o = 128; o > 0; o >>= 1) { if (t < o) sh[t] = fmaxf(sh[t], sh[t + o]); __syncthreads(); }
    const float r = sh[0]; __syncthreads(); return r;
}
__device__ __forceinline__ unsigned hash32(unsigned x) { x ^= x >> 16; x *= 0x7feb352du; x ^= x >> 15; x *= 0x846ca68bu; x ^= x >> 16; return x; }
__device__ __forceinline__ int dbg_row(int i) { return i * 256 + ((i * 37 + 11) & 255); }

struct ChkW { const float* W; const bf16* WT; int ldw, K, N, gu; };
__global__ void chk_weights(Args a, ChkW c, unsigned code) {
    const unsigned i = blockIdx.x * blockDim.x + threadIdx.x; const unsigned h = hash32(i * 2654435761u + code);
    const int n = h % c.N, k = hash32(h) % c.K;
    int col = n; if (c.gu) { const int tile = n >> 8, bj = (n >> 7) & 1, j = n & 127; col = bj * DFF + tile * 128 + j; }
    const float w = c.W[(size_t)k * c.ldw + col], g = bf2f(c.WT[(size_t)n * c.K + k]);
    if (!(fabsf(g - w) <= 0.004f * fabsf(w) + 1e-30f)) dbg_fail(a.ws, code, (float)n);
}
__global__ void chk_tables(Args a, unsigned code) {
    const int i = blockIdx.x * blockDim.x + threadIdx.x;
    const float* wfg = (const float*)(a.ws + WS_WFG); const bf16* wsm = (const bf16*)(a.ws + WS_WSM); const float* rope = (const float*)(a.ws + WS_ROPE);
    { const int j = i / 32768, hd = (i / 2048) % 16, k = i % 2048; if (wfg[i] != a.in[11][((size_t)j * DM + k) * FOX_IN + FOX_N + hd]) dbg_fail(a.ws, code, 1.f); }
    for (int e = i; e < 16 * 128 * 128; e += 65536) { const int t = (e >> 7) & 127, s = e & 127; const float w = s <= t ? a.in[17][e] : 0.f; if (!(fabsf(bf2f(wsm[e]) - w) <= 0.004f * fabsf(w))) dbg_fail(a.ws, code, 2.f); }
    { const int m = i & (M - 1), k = (i >> 14) & 7  ; const int pos = ((const int*)a.in[2])[m]; const float ang = (float)pos * ROPE_INV[k];
      const float c = cosf(ang), s = sinf(ang); if (!(fabsf(rope[m * 16 + k] - c) < 2e-5f && fabsf(rope[m * 16 + 8 + k] - s) < 2e-5f)) dbg_fail(a.ws, code, 3.f); }
}
__global__ void chk_modvec(Args a, unsigned code) {
    const int i = blockIdx.x * blockDim.x + threadIdx.x;
    if (i >= 3072) return;
    const int l = i / 768, b = (i / 384) % 2, slot = (i / 64) % 6, col = ((i % 64) * 32 + (i * 7) % 32) % DM;
    const int part = slot == 0 ? 1 : slot == 1 ? 0 : slot == 2 ? 2 : slot == 3 ? 4 : slot == 4 ? 3 : 5;
    double s = 0.0;
    for (int k = 0; k < DM; ++k) { const double c = (double)a.in[1][b * DM + k]; s += c / (1.0 + exp(-c)) * (double)a.in[3][((size_t)l * DM + k) * 12288 + part * DM + col]; }
    s += (double)a.in[4][l * 12288 + part * DM + col];
    double v;
    if (slot == 0) v = (double)a.in[5][l * DM + col] * (1.0 + s); else if (slot == 1) v = s; else if (slot == 2) v = s * (double)a.in[6][l * DM + col];
    else if (slot == 3) v = (double)a.in[7][l * DM + col] * (1.0 + s); else if (slot == 4) v = s; else v = s * (double)a.in[8][l * DM + col];
    const float got = ((const float*)(a.ws + WS_VEC))[((size_t)(l * 2 + b) * 6 + slot) * DM + col];
    if (!(fabs((double)got - v) <= 1e-3 * fabs(v) + 1e-4)) dbg_fail(a.ws, code, (float)i);
}
struct ChkN { const float* xin; const float* xout; const bf16* y; const float* g; const float* av; const float* sv; const bf16* h; const float* wfox; const float* bf; const float* logf; };
__global__ void chk_norm(Args a, ChkN c, unsigned code) {
    __shared__ float sh[256]; __shared__ float hrow[DM];
    const int m = dbg_row(blockIdx.x), b = m >> 13, t = threadIdx.x; const size_t vo = (size_t)b * 6 * DM;
    float xn[8];
    float q = 0.f;
    if (c.y) { for (int j = 0; j < 8; ++j) { const float yv = bf2f(c.y[(size_t)m * DM + t + 256 * j]); q += yv * yv; } }
    q = block_sum256(q, sh);
    const float rstdy = 1.0f / sqrtf(q / DM + EPS);
    float e2 = 0.f, r2 = 0.f;
    for (int j = 0; j < 8; ++j) { const int col = t + 256 * j; float x = c.xin[(size_t)m * DM + col];
        if (c.y) { x += c.g[vo + col] * bf2f(c.y[(size_t)m * DM + col]) * rstdy; if (c.xout) { const float d = c.xout[(size_t)m * DM + col] - x; e2 += d * d; r2 += x * x; } }
        xn[j] = x; }
    e2 = block_sum256(e2, sh); r2 = block_sum256(r2, sh);
    if (c.y && c.xout && !(e2 <= 1e-4f * r2)) dbg_fail(a.ws, code, sqrtf(e2 / (r2 + 1e-30f)));
    if (!c.h) return;
    float qx = 0.f; for (int j = 0; j < 8; ++j) qx += xn[j] * xn[j];
    qx = block_sum256(qx, sh);
    const float rstdx = 1.0f / sqrtf(qx / DM + EPS);
    e2 = 0.f; r2 = 0.f;
    for (int j = 0; j < 8; ++j) { const int col = t + 256 * j; const float hv = xn[j] * rstdx * c.av[vo + col] + c.sv[vo + col]; hrow[col] = hv; const float d = bf2f(c.h[(size_t)m * DM + col]) - hv; e2 += d * d; r2 += hv * hv; }
    e2 = block_sum256(e2, sh); r2 = block_sum256(r2, sh);
    if (!(e2 <= 1e-4f * r2)) dbg_fail(a.ws, code + 40, sqrtf(e2 / (r2 + 1e-30f)));
    if (!c.wfox) return;
    __syncthreads();
    for (int hd = 0; hd < 16; ++hd) { float p = 0.f; for (int j = 0; j < 8; ++j) { const int k = t + 256 * j; p += hrow[k] * c.wfox[(size_t)k * FOX_IN + FOX_N + hd]; }
        p = block_sum256(p, sh);
        if (t == 0) { const float x = p + c.bf[hd]; const float ls = (float)(-log1p(exp(-(double)x))); const float got = c.logf[(size_t)(b * 16 + hd) * SEQ + (m & (SEQ - 1))];
            if (!(fabsf(got - ls) <= 5e-3f)) dbg_fail(a.ws, code + 80, got - ls); } }
}
struct ChkG { const bf16* A; const float* W; const bf16* out; const float* stat; int K, ldw, N, mode, ldo, qcols; float qscale; int pad; };
static ChkG mkG(const bf16* A, int K, const float* W, int ldw, int N, int mode, const bf16* out, int ldo, int qcols, float qscale, const float* stat) { ChkG c{}; c.A = A; c.W = W; c.out = out; c.stat = stat; c.K = K; c.ldw = ldw; c.N = N; c.mode = mode; c.ldo = ldo; c.qcols = qcols; c.qscale = qscale; c.pad = 0; return c; }
__global__ void chk_gemm(Args a, ChkG c, unsigned code) {
    __shared__ float sh[256]; __shared__ float arow[DFF];
    const int m = dbg_row(blockIdx.x), t = threadIdx.x;
    for (int k = t; k < c.K; k += 256) arow[k] = bf2f(c.A[(size_t)m * c.K + k]);
    __syncthreads();
    float e2 = 0.f, r2 = 0.f, s1 = 0.f, s2 = 0.f, emax = 0.f;
    for (int col = t; col < c.N; col += 256) {
        float d0 = 0.f, d1 = 0.f;
        for (int k = 0; k < c.K; ++k) { d0 += arow[k] * c.W[(size_t)k * c.ldw + col]; if (c.mode == 2) d1 += arow[k] * c.W[(size_t)k * c.ldw + DFF + col]; }
        float ex;
        if (c.mode == 0) ex = d0 * (col < c.qcols ? c.qscale : 1.0f);
        else if (c.mode == 1) ex = 0.5f * d0 * (1.0f + tanhf(0.7978845608028654f * (d0 + 0.044715f * d0 * d0 * d0)));
        else if (c.mode == 2) ex = d0 / (1.0f + expf(-d0)) * d1;
        else ex = d0;
        const float got = bf2f(c.out[(size_t)m * c.ldo + col]), d = got - ex; e2 += d * d; r2 += ex * ex; emax = fmaxf(emax, fabsf(d));
        if (c.mode == 3) s2 += ex * ex;
        if (c.mode == 1 && col >= 2048) { s1 += ex; s2 += ex * ex; }
    }
    e2 = block_sum256(e2, sh); r2 = block_sum256(r2, sh); emax = block_max256(emax, sh); s1 = block_sum256(s1, sh); s2 = block_sum256(s2, sh);
    const float rms = sqrtf(r2 / c.N);
    if (!(e2 <= 4e-4f * r2) || !(emax <= 0.15f * rms + 1e-6f)) dbg_fail(a.ws, code, sqrtf(e2 / (r2 + 1e-30f)));
    if (t == 0 && c.stat) {
        if (c.mode == 3) { float q = 0.f; for (int i = 0; i < 32; ++i) q += c.stat[(size_t)m * 32 + i]; if (!(fabsf(q - s2) <= 0.02f * s2)) dbg_fail(a.ws, code + 40, q / s2); }
        if (c.mode == 1) { float s = 0.f, q = 0.f; for (int i = 0; i < 32; ++i) { s += c.stat[((size_t)m * 32 + i) * 2]; q += c.stat[((size_t)m * 32 + i) * 2 + 1]; }
            if (!(fabsf(q - s2) <= 0.02f * s2) || !(fabsf(s - s1) <= 0.02f * fabsf(s1) + 1.0f)) dbg_fail(a.ws, code + 40, q / s2); }
    }
}
__global__ void chk_scan(Args a, unsigned code) {
    const int i = blockIdx.x * blockDim.x + threadIdx.x; if (i >= 128) return;
    const int bh = i >> 2, which = i & 3, t = which == 0 ? 0 : which == 1 ? 1000 + 13 * bh : which == 2 ? 4096 + bh : 8191;
    const float* lf = (const float*)(a.ws + WS_LOGF) + (size_t)bh * SEQ; double s = 0.0;
    for (int j = 0; j <= t; ++j) s += (double)lf[j];
    const float got = ((const float*)(a.ws + WS_CUM))[(size_t)bh * SEQ + t];
    if (!(fabs((double)got - s) <= 1e-3 + 1e-5 * fabs(s))) dbg_fail(a.ws, code, (float)((double)got - s));
}
__global__ void chk_fox(Args a, unsigned code) {
    __shared__ float sh[256]; __shared__ float sc[SEQ]; __shared__ float qv[FOX_D];
    const int bh = blockIdx.x >> 2, which = blockIdx.x & 3, b = bh >> 4, hd = bh & 15, t = threadIdx.x;
    const int i = which == 0 ? (bh % 3) : which == 1 ? 63 + 64 * (bh % 5) + (bh & 1) : which == 2 ? 3000 + 97 * bh : 8191 - (bh % 7) * 256;
    const bf16* P = (const bf16*)(a.ws + WS_PROJ); const float* cum = (const float*)(a.ws + WS_CUM) + (size_t)bh * SEQ; const size_t rb = (size_t)b * SEQ;
    if (t < FOX_D) qv[t] = bf2f(P[(rb + i) * FOX_N + hd * FOX_D + t]);
    __syncthreads();
    float mx = -INFINITY;
    for (int j = t; j <= i; j += 256) { const bf16* kp = P + (rb + j) * FOX_N + 2048 + hd * FOX_D; float d = 0.f; for (int e = 0; e < FOX_D; ++e) d += qv[e] * bf2f(kp[e]);
        d += (cum[i] - cum[j]) * LOG2E; sc[j] = d; mx = fmaxf(mx, d); }
    mx = block_max256(mx, sh);
    float l = 0.f;
    for (int j = t; j <= i; j += 256) { const float p = exp2f(sc[j] - mx); sc[j] = p; l += p; }
    l = block_sum256(l, sh);
    float e2 = 0.f, r2 = 0.f;
    if (t < FOX_D) { float o = 0.f; for (int j = 0; j <= i; ++j) o += sc[j] * bf2f(P[(rb + j) * FOX_N + 4096 + hd * FOX_D + t]); o /= l;
        const float got = bf2f(((const bf16*)(a.ws + WS_O))[(rb + i) * DM + hd * FOX_D + t]), d = got - o; e2 = d * d; r2 = o * o; }
    e2 = block_sum256(e2, sh); r2 = block_sum256(r2, sh);
    if (!(e2 <= 1e-3f * r2)) dbg_fail(a.ws, code, sqrtf(e2 / (r2 + 1e-30f)) + 10.f * which);
}
__global__ void chk_swa(Args a, unsigned code) {
    __shared__ float qv[64]; __shared__ float sc[128]; __shared__ float red[2];
    const int smp = blockIdx.x, t = threadIdx.x;
    const int b = smp & 1, hq = (smp * 5 + 3) & 31, hk = hq >> 2;
    const int i = (smp < 8) ? smp * 17 : (smp < 16) ? 127 + (smp - 8) * 128 : (smp * 131 + 29) & (SEQ - 1);
    const bf16* P = (const bf16*)(a.ws + WS_PROJ); const int* pos = (const int*)a.in[2]; const size_t rb = (size_t)b * SEQ;
    { const bf16* qp = P + (rb + i) * SWA_N + hq * SWA_D; float v = bf2f(qp[t]);
      if (t < 16) { const int k = t & 7; const float ang = (float)pos[rb + i] * ROPE_INV[k], c = cosf(ang), s = sinf(ang); const float x1 = bf2f(qp[k]), x2 = bf2f(qp[8 + k]); v = (t < 8) ? x1 * c - x2 * s : x2 * c + x1 * s; }
      qv[t] = v; }
    __syncthreads();
    const int blk = i >> 7;
    for (int jj = t; jj < 128; jj += 64) { const int j = i - jj; float d = -INFINITY;
        if (j >= 0 && j >= (blk - 1) * 128) { const bf16* kp = P + (rb + j) * SWA_N + 2048 + hk * SWA_D; d = 0.f;
            for (int e = 0; e < 64; ++e) { float kv = bf2f(kp[e]);
                if (e < 16) { const int k = e & 7; const float ang = (float)pos[rb + j] * ROPE_INV[k], c = cosf(ang), s = sinf(ang); const float x1 = bf2f(kp[k]), x2 = bf2f(kp[8 + k]); kv = (e < 8) ? x1 * c - x2 * s : x2 * c + x1 * s; }
                d += qv[e] * kv; }
            d *= 0.125f; }
        sc[jj] = d; }
    __syncthreads();
    if (t == 0) { float mx = a.in[21][hq]; for (int jj = 0; jj < 128; ++jj) mx = fmaxf(mx, sc[jj]); float l = expf(a.in[21][hq] - mx); for (int jj = 0; jj < 128; ++jj) l += expf(sc[jj] - mx); red[0] = mx; red[1] = l; }
    __syncthreads();
    float o = 0.f;
    for (int jj = 0; jj < 128; ++jj) { const int j = i - jj; if (sc[jj] > -INFINITY) o += expf(sc[jj] - red[0]) * bf2f(P[(rb + j) * SWA_N + 2560 + hk * SWA_D + t]); }
    o /= red[1];
    const float got = bf2f(((const bf16*)(a.ws + WS_O))[(rb + i) * DM + hq * SWA_D + t]);
    float e2 = (got - o) * (got - o), r2 = o * o;
    for (int of = 32; of > 0; of >>= 1) { e2 += __shfl_xor(e2, of); r2 += __shfl_xor(r2, of); }
    if (t == 0 && !(e2 <= 1e-3f * r2)) dbg_fail(a.ws, code, sqrtf(e2 / (r2 + 1e-30f)));
}
__global__ void chk_sgu(Args a, unsigned code) {
    __shared__ float mean[128], rstd[128]; __shared__ float sh[128];
    const int smp = blockIdx.x, d = threadIdx.x;
    const int g = (smp * 7 + 1) & 15, m = (smp < 4) ? smp * 128 + (smp == 0 ? 0 : 127) : (smp * 1031 + 77) & (M - 1), tt = m & 127; const size_t m0 = (size_t)(m - tt);
    const bf16* P = (const bf16*)(a.ws + WS_PROJ);
    for (int s = 0; s <= tt; ++s) { float su = 0.f, sq = 0.f; for (int c = d; c < DM; c += 128) { const float v = bf2f(P[(m0 + s) * SGU_N + 2048 + c]); su += v; sq += v * v; }
        sh[d] = su; __syncthreads(); for (int o = 64; o > 0; o >>= 1) { if (d < o) sh[d] += sh[d + o]; __syncthreads(); } const float mu = sh[0] / DM; __syncthreads();
        sh[d] = sq; __syncthreads(); for (int o = 64; o > 0; o >>= 1) { if (d < o) sh[d] += sh[d + o]; __syncthreads(); } const float var = sh[0] / DM - mu * mu; __syncthreads();
        if (d == 0) { mean[s] = mu; rstd[s] = 1.0f / sqrtf(fmaxf(var, 0.f) + EPS); } }
    __syncthreads();
    float f = 0.f; const int col = g * 128 + d;
    for (int s = 0; s <= tt; ++s) { const float vn = (bf2f(P[(m0 + s) * SGU_N + 2048 + col]) - mean[s]) * rstd[s] * a.in[15][col] + a.in[16][col]; f += a.in[17][((size_t)g * 128 + tt) * 128 + s] * vn; }
    f += a.in[18][g * 128 + tt];
    const float ex = bf2f(P[(size_t)m * SGU_N + col]) * f, got = bf2f(((const bf16*)(a.ws + WS_O))[(size_t)m * DM + col]);
    float e2 = (got - ex) * (got - ex), r2 = ex * ex;
    sh[d] = e2; __syncthreads(); for (int o = 64; o > 0; o >>= 1) { if (d < o) sh[d] += sh[d + o]; __syncthreads(); } e2 = sh[0]; __syncthreads();
    sh[d] = r2; __syncthreads(); for (int o = 64; o > 0; o >>= 1) { if (d < o) sh[d] += sh[d + o]; __syncthreads(); } r2 = sh[0];
    if (d == 0 && !(e2 <= 1e-3f * r2)) dbg_fail(a.ws, code, sqrtf(e2 / (r2 + 1e-30f)));
}
__global__ void dbg_finalize(Args a) {
    const unsigned* ctl = (const unsigned*)(a.ws + WS_CTL); const unsigned code = ctl[CW_ERR], tmo = ctl[CW_TMO] | ctl[CW_BAR + XB_TMO];
#ifdef DBG_REPORT_VALUE
    const float v = code ? 1000.f * fabsf(__uint_as_float(ctl[CW_ERRV])) : 0.f;
#else
    const float v = code ? 1000.f * (float)code : (tmo ? 999000.f : 0.f);
#endif
    if (v != 0.f) for (size_t i = (size_t)blockIdx.x * blockDim.x + threadIdx.x; i < (size_t)M * DM; i += (size_t)gridDim.x * blockDim.x) a.out[i] = v;
}
static void dbg_checks(int ph, const Args& a, hipStream_t st) {
    unsigned char* ws = a.ws; const unsigned code = (unsigned)ph + 1;
    const bf16* Hb = (const bf16*)(ws + WS_H); const bf16* Pb = (const bf16*)(ws + WS_PROJ); const bf16* Ob = (const bf16*)(ws + WS_O); const bf16* Yb = (const bf16*)(ws + WS_Y);
    const float* XA = (const float*)(ws + WS_XA); const float* vec = (const float*)(ws + WS_VEC);
    if (ph == 0) {
        for (int l = 0; l < 4; ++l) { ChkW c{a.in[9] + (size_t)l * DM * 2 * DFF, (const bf16*)(ws + WS_WGU + l * WGU_BYTES), 2 * DFF, DM, 2 * DFF, 1}; hipLaunchKernelGGL(chk_weights, dim3(64), dim3(256), 0, st, a, c, code); }
        for (int l = 0; l < 4; ++l) { ChkW c{a.in[10] + (size_t)l * DFF * DM, (const bf16*)(ws + WS_WDN + l * WDN_BYTES), DM, DFF, DM, 0}; hipLaunchKernelGGL(chk_weights, dim3(64), dim3(256), 0, st, a, c, code); }
        for (int l = 0; l < 2; ++l) { ChkW c{a.in[11] + (size_t)l * DM * FOX_IN, (const bf16*)(ws + WS_WFOXIN + l * WFOXIN_BYTES), FOX_IN, DM, FOX_N, 0}; hipLaunchKernelGGL(chk_weights, dim3(64), dim3(256), 0, st, a, c, code); }
        for (int l = 0; l < 2; ++l) { ChkW c{a.in[13] + (size_t)l * DM * DM, (const bf16*)(ws + WS_WFOXOUT + l * WSQ_BYTES), DM, DM, DM, 0}; hipLaunchKernelGGL(chk_weights, dim3(64), dim3(256), 0, st, a, c, code); }
        { ChkW c{a.in[14], (const bf16*)(ws + WS_WSGUIN), SGU_N, DM, SGU_N, 0}; hipLaunchKernelGGL(chk_weights, dim3(64), dim3(256), 0, st, a, c, code); }
        { ChkW c{a.in[19], (const bf16*)(ws + WS_WSGUOUT), DM, DM, DM, 0}; hipLaunchKernelGGL(chk_weights, dim3(64), dim3(256), 0, st, a, c, code); }
        { ChkW c{a.in[20], (const bf16*)(ws + WS_WSWAIN), SWA_N, DM, SWA_N, 0}; hipLaunchKernelGGL(chk_weights, dim3(64), dim3(256), 0, st, a, c, code); }
        { ChkW c{a.in[22], (const bf16*)(ws + WS_WSWAOUT), DM, DM, DM, 0}; hipLaunchKernelGGL(chk_weights, dim3(64), dim3(256), 0, st, a, c, code); }
        hipLaunchKernelGGL(chk_tables, dim3(256), dim3(256), 0, st, a, code + 40);
        return;
    }
    if (ph == 1) { hipLaunchKernelGGL(chk_modvec, dim3(12), dim3(256), 0, st, a, code); return; }
    if (ph == PH_FINAL) { ChkN c{XA, a.out, Yb, vec + (size_t)3 * 12 * DM + 5 * DM, nullptr, nullptr, nullptr, nullptr, nullptr, nullptr}; hipLaunchKernelGGL(chk_norm, dim3(64), dim3(256), 0, st, a, c, code); return; }
    const int r = ph - 2, l = r / 7, j = r % 7, kind = l % 3, jj = l / 3, half = j >= 4, s = 2 * l + half;
    const float* lv = vec + (size_t)l * 12 * DM;
    if (j == 0 || j == 4) {
        const float* xin = (s == 0 || s == 1) ? a.in[0] : (((s - 1) & 1) ? XA : (const float*)a.out); const float* xout = (s == 0) ? nullptr : ((s & 1) ? XA : (const float*)a.out);
        const float* gsrc = (s == 0) ? nullptr : (half ? lv + 2 * DM : vec + (size_t)(l - 1) * 12 * DM + 5 * DM);
        const bool fox = (!half && kind == 0);
        ChkN c{xin, xout, s == 0 ? nullptr : Yb, gsrc, half ? lv + 3 * DM : lv, half ? lv + 4 * DM : lv + DM, Hb, fox ? a.in[11] + (size_t)jj * DM * FOX_IN : nullptr, a.in[12] + jj * 16, (const float*)(ws + WS_LOGF)};
        hipLaunchKernelGGL(chk_norm, dim3(64), dim3(256), 0, st, a, c, code); return;
    }
    if (j == 1) {
        if (kind == 0) { hipLaunchKernelGGL(chk_scan, dim3(1), dim3(128), 0, st, a, code + 80);
            ChkG c = mkG(Hb, DM, a.in[11] + (size_t)jj * DM * FOX_IN, FOX_IN, FOX_N, 0, Pb, FOX_N, 2048, FOX_QSCALE, nullptr); hipLaunchKernelGGL(chk_gemm, dim3(64), dim3(256), 0, st, a, c, code); }
        else if (kind == 1) { ChkG c = mkG(Hb, DM, a.in[14], SGU_N, SGU_N, 1, Pb, SGU_N, 0, 1.f, (const float*)(ws + WS_VSTAT)); hipLaunchKernelGGL(chk_gemm, dim3(64), dim3(256), 0, st, a, c, code); }
        else { ChkG c = mkG(Hb, DM, a.in[20], SWA_N, SWA_N, 0, Pb, SWA_N, 0, 1.f, nullptr); hipLaunchKernelGGL(chk_gemm, dim3(64), dim3(256), 0, st, a, c, code); }
        return;
    }
    if (j == 2) { if (kind == 0) hipLaunchKernelGGL(chk_fox, dim3(128), dim3(256), 0, st, a, code); else if (kind == 1) hipLaunchKernelGGL(chk_sgu, dim3(48), dim3(128), 0, st, a, code); else hipLaunchKernelGGL(chk_swa, dim3(64), dim3(64), 0, st, a, code); return; }
    if (j == 3) { const float* W = kind == 0 ? a.in[13] + (size_t)jj * DM * DM : kind == 1 ? a.in[19] : a.in[22];
        ChkG c = mkG(Ob, DM, W, DM, DM, 3, Yb, DM, 0, 1.f, (const float*)(ws + WS_YSTAT)); hipLaunchKernelGGL(chk_gemm, dim3(64), dim3(256), 0, st, a, c, code); return; }
    if (j == 5) { ChkG c = mkG(Hb, DM, a.in[9] + (size_t)l * DM * 2 * DFF, 2 * DFF, DFF, 2, Pb, DFF, 0, 1.f, nullptr); hipLaunchKernelGGL(chk_gemm, dim3(64), dim3(256), 0, st, a, c, code); return; }
    if (j == 6) { ChkG c = mkG(Pb, DFF, a.in[10] + (size_t)l * DFF * DM, DM, DM, 3, Yb, DM, 0, 1.f, (const float*)(ws + WS_YSTAT)); hipLaunchKernelGGL(chk_gemm, dim3(64), dim3(256), 0, st, a, c, code); return; }
}
#endif
```
